# Optimizing an MI355X kernel written in HIP

```python
import jax, jax.numpy as jnp
from jax import lax
import numpy as np

D_MODEL = 1024
BATCH = 4
SEQ = 4096
DEPTH = 4

N_MIXERS = 4
RMS_EPS = 1e-6
LN_EPS = 1e-5

MLA_HEADS = 16
MLA_Q_RANK = 384
MLA_KV_RANK = 256
MLA_NOPE = 64
MLA_ROPE = 32
MLA_V = 64
ROPE_BASE = 10000.0
Q_BLOCK = 128

LRU_WIDTH = D_MODEL
LRU_HEADS = 8
LRU_HEAD_DIM = LRU_WIDTH // LRU_HEADS
CONV_WIDTH = 4
LRU_C = 8.0

POOL_WINDOWS = (2, 4, 8, 16)
POOL_GROUP = D_MODEL // len(POOL_WINDOWS)

GMLP_WIDTH = D_MODEL
GMLP_GROUPS = 4
GMLP_GROUP_DIM = GMLP_WIDTH // GMLP_GROUPS
GMLP_CHUNK = 128

D_FF = 3584
N_EXPERTS = 8
TOP_K = 2
MOE_BLOCK = 256

kernel_name = "hybrid_interleaved_mla_rglru_pool_gmlp_moe"


def _count(m, period):
    return len(range(m, DEPTH, period))


def rmsnorm(x, g):
    xf = x.astype(jnp.float32)
    y = xf * lax.rsqrt(jnp.mean(xf * xf, axis=-1, keepdims=True) + RMS_EPS)
    return (y * g.astype(jnp.float32)).astype(x.dtype)


def layernorm(x, g, b):
    xf = x.astype(jnp.float32)
    mu = jnp.mean(xf, axis=-1, keepdims=True)
    var = jnp.mean(jnp.square(xf - mu), axis=-1, keepdims=True)
    y = (xf - mu) * lax.rsqrt(var + LN_EPS)
    return (y * g.astype(jnp.float32) + b.astype(jnp.float32)).astype(x.dtype)


def apply_rope(x, cos, sin):
    half = x.shape[-1] // 2
    x1 = x[..., :half].astype(jnp.float32)
    x2 = x[..., half:].astype(jnp.float32)
    return jnp.concatenate([x1 * cos - x2 * sin, x2 * cos + x1 * sin], axis=-1).astype(x.dtype)


def mla_mixer(h, positions, w_in, q_norm, kv_norm, w_uq, w_ukv, w_o):
    B, S, _ = h.shape
    lat = h @ w_in
    c_q, c_kv, k_rope = jnp.split(lat, [MLA_Q_RANK, MLA_Q_RANK + MLA_KV_RANK], axis=-1)
    c_q = rmsnorm(c_q, q_norm)
    c_kv = rmsnorm(c_kv, kv_norm)
    q = (c_q @ w_uq).reshape(B, S, MLA_HEADS, MLA_NOPE + MLA_ROPE)
    q_nope, q_rope = q[..., :MLA_NOPE], q[..., MLA_NOPE:]
    kv = (c_kv @ w_ukv).reshape(B, S, MLA_HEADS, MLA_NOPE + MLA_V)
    k_nope, v = kv[..., :MLA_NOPE], kv[..., MLA_NOPE:]
    half = MLA_ROPE // 2
    inv_freq = ROPE_BASE ** (-jnp.arange(half, dtype=jnp.float32) / half)
    ang = positions.astype(jnp.float32)[..., None] * inv_freq
    cos, sin = jnp.cos(ang), jnp.sin(ang)
    q_rope = apply_rope(q_rope, cos[:, :, None, :], sin[:, :, None, :])
    k_rope = apply_rope(k_rope, cos, sin)
    scale = (MLA_NOPE + MLA_ROPE) ** -0.5
    nb = S // Q_BLOCK
    qn = q_nope.reshape(B, nb, Q_BLOCK, MLA_HEADS, MLA_NOPE).transpose(1, 0, 2, 3, 4)
    qr = q_rope.reshape(B, nb, Q_BLOCK, MLA_HEADS, MLA_ROPE).transpose(1, 0, 2, 3, 4)
    key_pos = jnp.arange(S)

    def block(args):
        qn_b, qr_b, b_idx = args
        s = (jnp.einsum('bqhd,bkhd->bhqk', qn_b, k_nope)
             + jnp.einsum('bqhr,bkr->bhqk', qr_b, k_rope)).astype(jnp.float32) * scale
        q_pos = b_idx * Q_BLOCK + jnp.arange(Q_BLOCK)
        mask = key_pos[None, :] <= q_pos[:, None]
        s = jnp.where(mask, s, -jnp.inf)
        p = jax.nn.softmax(s, axis=-1).astype(v.dtype)
        return jnp.einsum('bhqk,bkhd->bqhd', p, v)

    o = lax.map(block, (qn, qr, jnp.arange(nb)))
    o = o.transpose(1, 0, 2, 3, 4).reshape(B, S, MLA_HEADS * MLA_V)
    return o @ w_o


def rglru_mixer(h, w_in, conv_w, conv_b, w_a, b_a, w_x, b_x, lam, w_out):
    B, S, _ = h.shape
    gate_br, x_br = jnp.split(h @ w_in, 2, axis=-1)
    gate_br = jax.nn.gelu(gate_br)
    xc = lax.conv_general_dilated(
        x_br, conv_w.reshape(CONV_WIDTH, 1, LRU_WIDTH).astype(x_br.dtype),
        window_strides=(1,), padding=[(CONV_WIDTH - 1, 0)],
        dimension_numbers=('NWC', 'WIO', 'NWC'), feature_group_count=LRU_WIDTH) + conv_b
    xh = xc.reshape(B, S, LRU_HEADS, LRU_HEAD_DIM)
    r = jax.nn.sigmoid((jnp.einsum('bshi,hij->bshj', xh, w_a).reshape(B, S, LRU_WIDTH) + b_a).astype(jnp.float32))
    i_g = jax.nn.sigmoid((jnp.einsum('bshi,hij->bshj', xh, w_x).reshape(B, S, LRU_WIDTH) + b_x).astype(jnp.float32))
    log_a = -LRU_C * r * jax.nn.softplus(-lam.astype(jnp.float32))
    a = jnp.exp(log_a)
    mult = jnp.sqrt(-jnp.expm1(2.0 * log_a))
    b = mult * (i_g * xc.astype(jnp.float32))

    def combine(left, right):
        a_l, b_l = left
        a_r, b_r = right
        return a_l * a_r, a_r * b_l + b_r

    _, hs = lax.associative_scan(combine, (a, b), axis=1)
    y = hs.astype(h.dtype) * gate_br
    return y @ w_out


def pool_mixer(h, w_grp, scale):
    B, S, D = h.shape
    hf = h.astype(jnp.float32)
    cs = jnp.pad(jnp.cumsum(hf, axis=1), ((0, 0), (1, 0), (0, 0)))
    t = jnp.arange(S)
    groups = []
    for g, w in enumerate(POOL_WINDOWS):
        c = cs[..., g * POOL_GROUP:(g + 1) * POOL_GROUP]
        upper = c[:, 1:]
        lower = jnp.pad(c[:, :S + 1 - w], ((0, 0), (w - 1, 0), (0, 0)))
        count = jnp.minimum(t + 1, w).astype(jnp.float32)[None, :, None]
        groups.append((upper - lower) / count - hf[..., g * POOL_GROUP:(g + 1) * POOL_GROUP])
    pooled = jnp.stack(groups, axis=2).astype(h.dtype)
    out = jnp.einsum('bsgc,gcd->bsgd', pooled, w_grp).reshape(B, S, D)
    return out * scale


def gmlp_mixer(h, w_in, ln_g, ln_b, w_s, b_s, w_out):
    B, S, _ = h.shape
    z = jax.nn.gelu(h @ w_in)
    u, v = jnp.split(z, 2, axis=-1)
    v = layernorm(v, ln_g, ln_b)
    nc = S // GMLP_CHUNK
    vg = v.reshape(B, nc, GMLP_CHUNK, GMLP_GROUPS, GMLP_GROUP_DIM)
    causal = jnp.tril(jnp.ones((GMLP_CHUNK, GMLP_CHUNK), dtype=bool))
    ws = jnp.where(causal[None], w_s, jnp.zeros_like(w_s))
    v2 = jnp.einsum('gts,bnsgc->bntgc', ws, vg) + b_s.T[:, :, None]
    v2 = v2.reshape(B, S, GMLP_WIDTH)
    return (u * v2) @ w_out


def swiglu(h, w_gate, w_up, w_down):
    return (jax.nn.silu(h @ w_gate) * (h @ w_up)) @ w_down


def moe_swiglu(h, w_router, w_gate, w_up, w_down):
    B, S, D = h.shape
    T = B * S
    A = T * TOP_K
    xt = h.reshape(T, D)
    logits = (xt @ w_router).astype(jnp.float32)
    top_val, top_idx = lax.top_k(logits, TOP_K)
    gates = jax.nn.softmax(top_val, axis=-1)
    exp_flat = top_idx.reshape(A)
    tok_flat = jnp.arange(A, dtype=jnp.int32) // TOP_K
    gate_flat = gates.reshape(A)
    order = jnp.argsort(exp_flat)
    exp_sorted = exp_flat[order]
    tok_sorted = tok_flat[order]
    gate_sorted = gate_flat[order]
    sizes = jnp.bincount(exp_flat, length=N_EXPERTS)
    starts = jnp.cumsum(sizes) - sizes
    padded = (sizes + MOE_BLOCK - 1) // MOE_BLOCK * MOE_BLOCK
    pad_end = jnp.cumsum(padded)
    pad_start = pad_end - padded
    dest = pad_start[exp_sorted] + (jnp.arange(A) - starts[exp_sorted])
    n_blocks = -(-(A + N_EXPERTS * (MOE_BLOCK - 1)) // MOE_BLOCK)
    P = n_blocks * MOE_BLOCK
    buf = jnp.zeros((P, D), h.dtype).at[dest].set(xt[tok_sorted])
    block_start = jnp.arange(n_blocks) * MOE_BLOCK
    block_expert = jnp.minimum(jnp.sum(pad_end[None, :] <= block_start[:, None], axis=1), N_EXPERTS - 1)

    def expert_block(args):
        xb, e = args
        return swiglu(xb, w_gate[e], w_up[e], w_down[e])

    out = lax.map(expert_block, (buf.reshape(n_blocks, MOE_BLOCK, D), block_expert)).reshape(P, D)
    contrib = out[dest] * gate_sorted[:, None].astype(out.dtype)
    y = jnp.zeros((T, D), h.dtype).at[tok_sorted].add(contrib)
    return y.reshape(B, S, D)


def setup_inputs(seed: int = 0) -> dict:
    key = jax.random.key(seed)
    ks = iter(jax.random.split(key, 40))

    def nrm(shape, fan_in):
        return jax.random.normal(next(ks), shape, jnp.float32) * fan_in ** -0.5

    def gain(shape):
        return 1.0 + 0.02 * jax.random.normal(next(ks), shape, jnp.float32)

    def bias(shape):
        return 0.02 * jax.random.normal(next(ks), shape, jnp.float32)

    n_mla, n_lru, n_pool, n_gmlp = (_count(m, N_MIXERS) for m in range(N_MIXERS))
    n_dense, n_moe = _count(0, 2), _count(1, 2)
    D = D_MODEL
    x = jax.random.normal(next(ks), (BATCH, SEQ, D), jnp.float32)
    positions = jnp.broadcast_to(jnp.arange(SEQ, dtype=jnp.int32)[None, :], (BATCH, SEQ))
    inp = {
        "x": x,
        "positions": positions,
        "norm_mix": gain((DEPTH, D)),
        "norm_ffn": gain((DEPTH, D)),
        "norm_final": gain((D,)),
        "mla_w_in": nrm((n_mla, D, MLA_Q_RANK + MLA_KV_RANK + MLA_ROPE), D),
        "mla_q_norm": gain((n_mla, MLA_Q_RANK)),
        "mla_kv_norm": gain((n_mla, MLA_KV_RANK)),
        "mla_w_uq": nrm((n_mla, MLA_Q_RANK, MLA_HEADS * (MLA_NOPE + MLA_ROPE)), MLA_Q_RANK),
        "mla_w_ukv": nrm((n_mla, MLA_KV_RANK, MLA_HEADS * (MLA_NOPE + MLA_V)), MLA_KV_RANK),
        "mla_w_o": nrm((n_mla, MLA_HEADS * MLA_V, D), MLA_HEADS * MLA_V),
        "lru_w_in": nrm((n_lru, D, 2 * LRU_WIDTH), D),
        "lru_conv_w": nrm((n_lru, CONV_WIDTH, LRU_WIDTH), CONV_WIDTH),
        "lru_conv_b": bias((n_lru, LRU_WIDTH)),
        "lru_w_a": nrm((n_lru, LRU_HEADS, LRU_HEAD_DIM, LRU_HEAD_DIM), LRU_HEAD_DIM),
        "lru_b_a": bias((n_lru, LRU_WIDTH)),
        "lru_w_x": nrm((n_lru, LRU_HEADS, LRU_HEAD_DIM, LRU_HEAD_DIM), LRU_HEAD_DIM),
        "lru_b_x": bias((n_lru, LRU_WIDTH)),
    }
    u = jax.random.uniform(next(ks), (n_lru, LRU_WIDTH), jnp.float32, 0.9, 0.999)
    a0 = u ** (1.0 / LRU_C)
    inp["lru_lam"] = jnp.log(a0) - jnp.log1p(-a0)
    inp.update({
        "lru_w_out": nrm((n_lru, LRU_WIDTH, D), LRU_WIDTH),
        "pool_w_grp": nrm((n_pool, len(POOL_WINDOWS), POOL_GROUP, POOL_GROUP), POOL_GROUP),
        "pool_scale": gain((n_pool, D)),
        "gmlp_w_in": nrm((n_gmlp, D, 2 * GMLP_WIDTH), D),
        "gmlp_ln_g": gain((n_gmlp, GMLP_WIDTH)),
        "gmlp_ln_b": bias((n_gmlp, GMLP_WIDTH)),
        "gmlp_w_s": nrm((n_gmlp, GMLP_GROUPS, GMLP_CHUNK, GMLP_CHUNK), GMLP_CHUNK),
        "gmlp_b_s": gain((n_gmlp, GMLP_GROUPS, GMLP_CHUNK)),
        "gmlp_w_out": nrm((n_gmlp, GMLP_WIDTH, D), GMLP_WIDTH),
        "ffn_w_gate": nrm((n_dense, D, D_FF), D),
        "ffn_w_up": nrm((n_dense, D, D_FF), D),
        "ffn_w_down": nrm((n_dense, D_FF, D), D_FF),
        "moe_w_router": nrm((n_moe, D, N_EXPERTS), D),
        "moe_w_gate": nrm((n_moe, N_EXPERTS, D, D_FF), D),
        "moe_w_up": nrm((n_moe, N_EXPERTS, D, D_FF), D),
        "moe_w_down": nrm((n_moe, N_EXPERTS, D_FF, D), D_FF),
    })
    return inp


def reference(x, positions, norm_mix, norm_ffn, norm_final,
              mla_w_in, mla_q_norm, mla_kv_norm, mla_w_uq, mla_w_ukv, mla_w_o,
              lru_w_in, lru_conv_w, lru_conv_b, lru_w_a, lru_b_a, lru_w_x, lru_b_x, lru_lam, lru_w_out,
              pool_w_grp, pool_scale,
              gmlp_w_in, gmlp_ln_g, gmlp_ln_b, gmlp_w_s, gmlp_b_s, gmlp_w_out,
              ffn_w_gate, ffn_w_up, ffn_w_down,
              moe_w_router, moe_w_gate, moe_w_up, moe_w_down):
    h = x
    for i in range(DEPTH):
        m, j = i % N_MIXERS, i // N_MIXERS
        hn = rmsnorm(h, norm_mix[i])
        if m == 0:
            mix = mla_mixer(hn, positions, mla_w_in[j], mla_q_norm[j], mla_kv_norm[j],
                            mla_w_uq[j], mla_w_ukv[j], mla_w_o[j])
        elif m == 1:
            mix = rglru_mixer(hn, lru_w_in[j], lru_conv_w[j], lru_conv_b[j], lru_w_a[j], lru_b_a[j],
                              lru_w_x[j], lru_b_x[j], lru_lam[j], lru_w_out[j])
        elif m == 2:
            mix = pool_mixer(hn, pool_w_grp[j], pool_scale[j])
        else:
            mix = gmlp_mixer(hn, gmlp_w_in[j], gmlp_ln_g[j], gmlp_ln_b[j], gmlp_w_s[j],
                             gmlp_b_s[j], gmlp_w_out[j])
        h = h + mix
        hn = rmsnorm(h, norm_ffn[i])
        k = i // 2
        if i % 2 == 0:
            h = h + swiglu(hn, ffn_w_gate[k], ffn_w_up[k], ffn_w_down[k])
        else:
            h = h + moe_swiglu(hn, moe_w_router[k], moe_w_gate[k], moe_w_up[k], moe_w_down[k])
    return rmsnorm(h, norm_final)
```

```cpp
#include <hip/hip_runtime.h>
#include <cstdio>
#include <cstdint>
#include <cmath>
namespace nv {
constexpr int D = 1024, NB = 4, S = 4096, M = NB * S, FF = 3584, NE = 8;
constexpr float RMS_EPS = 1e-6f, LN_EPS = 1e-5f;

__device__ __forceinline__ float blk_sum256(float v, float* red) {
    const int t = threadIdx.x; red[t] = v; __syncthreads();
    for (int o = 128; o > 0; o >>= 1) { if (t < o) red[t] += red[t + o]; __syncthreads(); }
    const float r = red[0]; __syncthreads(); return r;
}
__global__ void __launch_bounds__(256) k_rmsnorm(const float* x, int ldx, const float* g, float* y, int ldy, int cols) {
    __shared__ float red[256];
    const int r = blockIdx.x; const float* xr = x + (size_t)r * ldx; float s = 0.f;
    for (int c = threadIdx.x; c < cols; c += 256) s += xr[c] * xr[c];
    const float tot = blk_sum256(s, red); const float rs = 1.0f / sqrtf(tot / (float)cols + RMS_EPS);
    for (int c = threadIdx.x; c < cols; c += 256) y[(size_t)r * ldy + c] = xr[c] * rs * g[c];
}
__global__ void __launch_bounds__(256) k_layernorm_inplace(float* x, int ldx, const float* g, const float* b, int cols) {
    __shared__ float red[256];
    const int r = blockIdx.x; float* xr = x + (size_t)r * ldx; float s = 0.f;
    for (int c = threadIdx.x; c < cols; c += 256) s += xr[c];
    const float mu = blk_sum256(s, red) / (float)cols; float q = 0.f;
    for (int c = threadIdx.x; c < cols; c += 256) { const float d = xr[c] - mu; q += d * d; }
    const float var = blk_sum256(q, red) / (float)cols; const float rs = 1.0f / sqrtf(var + LN_EPS);
    for (int c = threadIdx.x; c < cols; c += 256) xr[c] = (xr[c] - mu) * rs * g[c] + b[c];
}
struct NGemm { const float* A; const float* B; float* C; int M, N, K, lda, ldb, ldc; const int* ridx; const int* cnt; int acc, pad; long long sA, sB, sC; };
__global__ void __launch_bounds__(256) k_gemm(NGemm p) {
    __shared__ float As[16][65]; __shared__ float Bs[16][64];
    const int tid = threadIdx.x, bz = blockIdx.z;
    const float* A = p.A + (size_t)bz * p.sA; const float* B = p.B + (size_t)bz * p.sB; float* C = p.C + (size_t)bz * p.sC;
    const int Mr = p.cnt ? *p.cnt : p.M;
    const int m0 = blockIdx.y * 64, n0 = blockIdx.x * 64; if (m0 >= Mr) return;
    const int tx = tid & 15, ty = tid >> 4;
    float acc[4][4];
#pragma unroll
    for (int i = 0; i < 4; ++i)
#pragma unroll
        for (int j = 0; j < 4; ++j) acc[i][j] = 0.f;
    for (int k0 = 0; k0 < p.K; k0 += 16) {
#pragma unroll
        for (int i = 0; i < 4; ++i) { const int e = tid + i * 256, r = e >> 4, kk = e & 15, gr = m0 + r; float v = 0.f;
            if (gr < Mr) { const int ar = p.ridx ? p.ridx[gr] : gr; v = A[(size_t)ar * p.lda + k0 + kk]; } As[kk][r] = v; }
#pragma unroll
        for (int i = 0; i < 4; ++i) { const int e = tid + i * 256, kk = e >> 6, c = e & 63; Bs[kk][c] = B[(size_t)(k0 + kk) * p.ldb + n0 + c]; }
        __syncthreads();
#pragma unroll
        for (int kk = 0; kk < 16; ++kk) { float a[4], b[4];
#pragma unroll
            for (int i = 0; i < 4; ++i) { a[i] = As[kk][ty * 4 + i]; b[i] = Bs[kk][tx * 4 + i]; }
#pragma unroll
            for (int i = 0; i < 4; ++i)
#pragma unroll
                for (int j = 0; j < 4; ++j) acc[i][j] += a[i] * b[j]; }
        __syncthreads();
    }
#pragma unroll
    for (int i = 0; i < 4; ++i) { const int gr = m0 + ty * 4 + i; if (gr < Mr) {
#pragma unroll
        for (int j = 0; j < 4; ++j) { float* c = C + (size_t)gr * p.ldc + n0 + tx * 4 + j; *c = p.acc ? (*c + acc[i][j]) : acc[i][j]; } } }
}
static void gemm(hipStream_t st, const float* A, int lda, const float* B, int ldb, float* C, int ldc, int Mm, int N, int K, int acc = 0,
                 const int* ridx = nullptr, const int* cnt = nullptr, int batch = 1, long long sA = 0, long long sB = 0, long long sC = 0) {
    NGemm p{}; p.A = A; p.B = B; p.C = C; p.M = Mm; p.N = N; p.K = K; p.lda = lda; p.ldb = ldb; p.ldc = ldc; p.ridx = ridx; p.cnt = cnt; p.acc = acc; p.sA = sA; p.sB = sB; p.sC = sC;
    hipLaunchKernelGGL(k_gemm, dim3(N / 64, (Mm + 63) / 64, batch), dim3(256), 0, st, p);
}
__device__ __forceinline__ float gelu_tanh(float x) { const float u = 0.7978845608028654f * (x + 0.044715f * x * x * x); return 0.5f * x * (1.0f + tanhf(u)); }
__device__ __forceinline__ float sigmoidf_(float x) { return 1.0f / (1.0f + expf(-x)); }
__device__ __forceinline__ float siluf_(float x) { return x / (1.0f + expf(-x)); }

__global__ void __launch_bounds__(256) k_rope(float* q, const float* lat, float* krope, const int* pos) {
    const int idx = blockIdx.x * 256 + threadIdx.x;
    if (idx >= M * 17 * 16) return;
    const int j = idx & 15, u = (idx >> 4) % 17, r = idx / (17 * 16);
    const float inv = powf(10000.0f, -(float)j / 16.0f); const float ang = (float)pos[r] * inv; const float c = cosf(ang), s = sinf(ang);
    if (u < 16) { float* p = q + (size_t)r * 1536 + u * 96 + 64; const float x1 = p[j], x2 = p[j + 16]; p[j] = x1 * c - x2 * s; p[j + 16] = x2 * c + x1 * s; }
    else { const float* p = lat + (size_t)r * 672 + 640; const float x1 = p[j], x2 = p[j + 16]; krope[(size_t)r * 32 + j] = x1 * c - x2 * s; krope[(size_t)r * 32 + j + 16] = x2 * c + x1 * s; }
}
__global__ void __launch_bounds__(64) k_attn(const float* q, const float* kv, const float* krope, float* o) {
    __shared__ float Ks[64][96]; __shared__ float Vs[64][64];
    const int qt = blockIdx.x, h = blockIdx.y, b = blockIdx.z, tid = threadIdx.x, t = qt * 64 + tid;
    const size_t rb = (size_t)b * S;
    float qv[96], ov[64];
    const float scale = 0.10206207261596575f;
#pragma unroll
    for (int d = 0; d < 96; ++d) qv[d] = q[(rb + t) * 1536 + h * 96 + d] * scale;
#pragma unroll
    for (int d = 0; d < 64; ++d) ov[d] = 0.f;
    float m = -INFINITY, l = 0.f;
    for (int kt = 0; kt <= qt; ++kt) {
        for (int idx = tid; idx < 64 * 96; idx += 64) { const int j = idx / 96, d = idx % 96; const size_t kr = rb + kt * 64 + j;
            Ks[j][d] = d < 64 ? kv[kr * 2048 + h * 128 + d] : krope[kr * 32 + d - 64]; }
        for (int idx = tid; idx < 64 * 64; idx += 64) { const int j = idx >> 6, d = idx & 63; Vs[j][d] = kv[(rb + kt * 64 + j) * 2048 + h * 128 + 64 + d]; }
        __syncthreads();
        for (int j = 0; j < 64; ++j) { const int key = kt * 64 + j;
            if (key <= t) { float s = 0.f;
#pragma unroll
                for (int d = 0; d < 96; ++d) s += qv[d] * Ks[j][d];
                const float mn = fmaxf(m, s), corr = expf(m - mn), pj = expf(s - mn); l = l * corr + pj;
#pragma unroll
                for (int d = 0; d < 64; ++d) ov[d] = ov[d] * corr + pj * Vs[j][d];
                m = mn; } }
        __syncthreads();
    }
    const float il = 1.0f / l;
#pragma unroll
    for (int d = 0; d < 64; ++d) o[(rb + t) * 1024 + h * 64 + d] = ov[d] * il;
}
__global__ void __launch_bounds__(256) k_add(float* h, const float* a, size_t n) { const size_t i = (size_t)blockIdx.x * 256 + threadIdx.x; if (i < n) h[i] += a[i]; }
__global__ void __launch_bounds__(256) k_add2(float* h, const float* x, const float* a, size_t n) { const size_t i = (size_t)blockIdx.x * 256 + threadIdx.x; if (i < n) h[i] = x[i] + a[i]; }
__global__ void __launch_bounds__(256) k_silu_mul(float* g, const float* u, size_t n) { const size_t i = (size_t)blockIdx.x * 256 + threadIdx.x; if (i < n) g[i] = siluf_(g[i]) * u[i]; }

__global__ void __launch_bounds__(256) k_lru_pre(float* gx, const float* cw, const float* cb, float* xc) {
    const size_t i = (size_t)blockIdx.x * 256 + threadIdx.x; if (i >= (size_t)M * D) return;
    const int c = (int)(i % D); const size_t r = i / D; const int t = (int)(r % S);
    float acc = cb[c];
#pragma unroll
    for (int j = 0; j < 4; ++j) { const int tt = t - 3 + j; if (tt >= 0) acc += cw[j * D + c] * gx[(r - 3 + j) * 2048 + 1024 + c]; }
    xc[i] = acc; gx[r * 2048 + c] = gelu_tanh(gx[r * 2048 + c]);
}
__global__ void __launch_bounds__(256) k_lru_gates(float* rpre, float* ipre, const float* xc, const float* ba, const float* bx, const float* lam) {
    const size_t i = (size_t)blockIdx.x * 256 + threadIdx.x; if (i >= (size_t)M * D) return;
    const int c = (int)(i % D);
    const float r = sigmoidf_(rpre[i] + ba[c]), ig = sigmoidf_(ipre[i] + bx[c]);
    const float sp = log1pf(expf(-lam[c])); const float log_a = -8.0f * r * sp; const float a = expf(log_a); const float mult = sqrtf(-expm1f(2.0f * log_a));
    rpre[i] = a; ipre[i] = mult * (ig * xc[i]);
}
__global__ void __launch_bounds__(256) k_lru_scan(const float* a, const float* b, const float* gx, float* y) {
    const int i = blockIdx.x * 256 + threadIdx.x; if (i >= NB * D) return;
    const int c = i % D, bb = i / D; float hst = 0.f;
    for (int t = 0; t < S; ++t) { const size_t r = (size_t)bb * S + t; hst = a[r * D + c] * hst + b[r * D + c]; y[r * D + c] = hst * gx[r * 2048 + c]; }
}
__global__ void __launch_bounds__(64) k_router(const float* hn, const float* wr, int* cnt, int* list, float* glist) {
    const int tok = blockIdx.x, lane = threadIdx.x; float s[8];
#pragma unroll
    for (int e = 0; e < 8; ++e) s[e] = 0.f;
    for (int c = lane; c < D; c += 64) { const float x = hn[(size_t)tok * D + c];
#pragma unroll
        for (int e = 0; e < 8; ++e) s[e] += x * wr[c * 8 + e]; }
#pragma unroll
    for (int e = 0; e < 8; ++e) for (int o = 32; o > 0; o >>= 1) s[e] += __shfl_xor(s[e], o);
    if (lane == 0) { int e1 = 0; float v1 = s[0];
#pragma unroll
        for (int e = 1; e < 8; ++e) if (s[e] > v1) { v1 = s[e]; e1 = e; }
        int e2 = -1; float v2 = -INFINITY;
#pragma unroll
        for (int e = 0; e < 8; ++e) if (e != e1 && s[e] > v2) { v2 = s[e]; e2 = e; }
        const float g1 = 1.0f / (1.0f + expf(v2 - v1)), g2 = 1.0f - g1;
        const int s1 = atomicAdd(&cnt[e1], 1); list[e1 * M + s1] = tok; glist[e1 * M + s1] = g1;
        const int s2 = atomicAdd(&cnt[e2], 1); list[e2 * M + s2] = tok; glist[e2 * M + s2] = g2; }
}
__global__ void __launch_bounds__(256) k_moe_scatter(float* y, const float* oacc, const int* list, const float* glist, const int* cnt) {
    const size_t i = (size_t)blockIdx.x * 256 + threadIdx.x; const int r = (int)(i / D), c = (int)(i % D); if (r >= *cnt) return;
    y[(size_t)list[r] * D + c] += glist[r] * oacc[i];
}
__global__ void __launch_bounds__(256) k_pool(const float* hn, float* pooled) {
    const size_t i = (size_t)blockIdx.x * 256 + threadIdx.x; if (i >= (size_t)M * D) return;
    const int c = (int)(i % D); const size_t r = i / D; const int t = (int)(r % S); const int w = 2 << (c >> 8);
    const int n = t + 1 < w ? t + 1 : w; float s = 0.f;
    for (int k = 0; k < n; ++k) s += hn[(r - k) * D + c];
    pooled[i] = s / (float)n - hn[i];
}
__global__ void __launch_bounds__(256) k_add_scaled(float* h, const float* a, const float* sc, size_t n) { const size_t i = (size_t)blockIdx.x * 256 + threadIdx.x; if (i < n) h[i] += a[i] * sc[i % D]; }
__global__ void __launch_bounds__(256) k_gelu_inplace(float* z, size_t n) { const size_t i = (size_t)blockIdx.x * 256 + threadIdx.x; if (i < n) z[i] = gelu_tanh(z[i]); }
__global__ void __launch_bounds__(256) k_gmlp_gate(const float* z, const float* ws, const float* bs, float* uv) {
    const size_t i = (size_t)blockIdx.x * 256 + threadIdx.x; if (i >= (size_t)M * D) return;
    const int c = (int)(i % D); const size_t r = i / D; const int t = (int)(r % 128); const size_t r0 = r - t; const int g = c >> 8;
    float acc = bs[g * 128 + t];
    for (int s = 0; s <= t; ++s) acc += ws[(g * 128 + t) * 128 + s] * z[(r0 + s) * 2048 + 1024 + c];
    uv[i] = z[r * 2048 + c] * acc;
}

struct Bufs { float *h, *hn, *t0, *t1, *t2, *t3, *small; int* ibuf; };
static inline dim3 g1(size_t n) { return dim3((unsigned)((n + 255) / 256)); }

static void dense_ffn(hipStream_t st, const Bufs& b, const float* nf, const float* wg, const float* wu, const float* wd) {
    hipLaunchKernelGGL(k_rmsnorm, dim3(M), dim3(256), 0, st, b.h, D, nf, b.hn, D, D);
    float* gb = b.t2; float* ub = b.t2 + (size_t)M * 512;
    for (int c0 = 0; c0 < FF; c0 += 512) {
        gemm(st, b.hn, D, wg + c0, FF, gb, 512, M, 512, D);
        gemm(st, b.hn, D, wu + c0, FF, ub, 512, M, 512, D);
        hipLaunchKernelGGL(k_silu_mul, g1((size_t)M * 512), dim3(256), 0, st, gb, ub, (size_t)M * 512);
        gemm(st, gb, 512, wd + (size_t)c0 * D, D, b.t1, D, M, D, 512, c0 > 0);
    }
    hipLaunchKernelGGL(k_add, g1((size_t)M * D), dim3(256), 0, st, b.h, b.t1, (size_t)M * D);
}
static void moe_ffn(hipStream_t st, const Bufs& b, const float* nf, const float* wr, const float* wg, const float* wu, const float* wd) {
    hipLaunchKernelGGL(k_rmsnorm, dim3(M), dim3(256), 0, st, b.h, D, nf, b.hn, D, D);
    int* cnt = b.ibuf; int* list = b.ibuf + 64; float* glist = b.small;
    (void)hipMemsetAsync(cnt, 0, 64 * sizeof(int), st);
    (void)hipMemsetAsync(b.t1, 0, (size_t)M * D * 4, st);
    hipLaunchKernelGGL(k_router, dim3(M), dim3(64), 0, st, b.hn, wr, cnt, list, glist);
    float* gb = b.t2; float* ub = b.t2 + (size_t)M * 512;
    for (int e = 0; e < NE; ++e) {
        const float* wge = wg + (size_t)e * D * FF; const float* wue = wu + (size_t)e * D * FF; const float* wde = wd + (size_t)e * FF * D;
        for (int c0 = 0; c0 < FF; c0 += 512) {
            gemm(st, b.hn, D, wge + c0, FF, gb, 512, M, 512, D, 0, list + e * M, cnt + e);
            gemm(st, b.hn, D, wue + c0, FF, ub, 512, M, 512, D, 0, list + e * M, cnt + e);
            hipLaunchKernelGGL(k_silu_mul, g1((size_t)M * 512), dim3(256), 0, st, gb, ub, (size_t)M * 512);
            gemm(st, gb, 512, wde + (size_t)c0 * D, D, b.t0, D, M, D, 512, c0 > 0, nullptr, cnt + e);
        }
        hipLaunchKernelGGL(k_moe_scatter, g1((size_t)M * D), dim3(256), 0, st, b.t1, b.t0, list + e * M, glist + e * M, cnt + e);
    }
    hipLaunchKernelGGL(k_add, g1((size_t)M * D), dim3(256), 0, st, b.h, b.t1, (size_t)M * D);
}
static void forward(hipStream_t st, void* const* in, const Bufs& b, int l0, int l1, float* out) {
    const float* x = (const float*)in[0]; const int* pos = (const int*)in[1];
    const float* norm_mix = (const float*)in[2]; const float* norm_ffn = (const float*)in[3]; const float* norm_final = (const float*)in[4];
    const size_t MD = (size_t)M * D;
    for (int L = l0; L < l1; ++L) {
        if (L == 0) {
            hipLaunchKernelGGL(k_rmsnorm, dim3(M), dim3(256), 0, st, x, D, norm_mix, b.hn, D, D);
            float* lat = b.t0; float* cq = b.t1; float* ckv = b.t1 + (size_t)M * 384; float* q = b.t2; float* kv = b.t3; float* krope = b.small;
            gemm(st, b.hn, D, (const float*)in[5], 672, lat, 672, M, 672 - 32, D);
            gemm(st, b.hn, D, (const float*)in[5] + 608, 672, lat + 608, 672, M, 64, D);
            hipLaunchKernelGGL(k_rmsnorm, dim3(M), dim3(256), 0, st, lat, 672, (const float*)in[6], cq, 384, 384);
            hipLaunchKernelGGL(k_rmsnorm, dim3(M), dim3(256), 0, st, lat + 384, 672, (const float*)in[7], ckv, 256, 256);
            gemm(st, cq, 384, (const float*)in[8], 1536, q, 1536, M, 1536, 384);
            gemm(st, ckv, 256, (const float*)in[9], 2048, kv, 2048, M, 2048, 256);
            hipLaunchKernelGGL(k_rope, g1((size_t)M * 17 * 16), dim3(256), 0, st, q, lat, krope, pos);
            float* o = b.hn;
            hipLaunchKernelGGL(k_attn, dim3(S / 64, 16, NB), dim3(64), 0, st, q, kv, krope, o);
            gemm(st, o, D, (const float*)in[10], D, b.t1, D, M, D, D);
            hipLaunchKernelGGL(k_add2, g1(MD), dim3(256), 0, st, b.h, x, b.t1, MD);
            dense_ffn(st, b, norm_ffn + 0 * D, (const float*)in[28], (const float*)in[29], (const float*)in[30]);
        } else if (L == 1) {
            hipLaunchKernelGGL(k_rmsnorm, dim3(M), dim3(256), 0, st, b.h, D, norm_mix + 1 * D, b.hn, D, D);
            float* gx = b.t3; float* xc = b.t0; float* rp = b.t1; float* ip = b.t2;
            gemm(st, b.hn, D, (const float*)in[11], 2048, gx, 2048, M, 2048, D);
            hipLaunchKernelGGL(k_lru_pre, g1(MD), dim3(256), 0, st, gx, (const float*)in[12], (const float*)in[13], xc);
            gemm(st, xc, D, (const float*)in[14], 128, rp, D, M, 128, 128, 0, nullptr, nullptr, 8, 128, 128 * 128, 128);
            gemm(st, xc, D, (const float*)in[16], 128, ip, D, M, 128, 128, 0, nullptr, nullptr, 8, 128, 128 * 128, 128);
            hipLaunchKernelGGL(k_lru_gates, g1(MD), dim3(256), 0, st, rp, ip, xc, (const float*)in[15], (const float*)in[17], (const float*)in[18]);
            hipLaunchKernelGGL(k_lru_scan, g1((size_t)NB * D), dim3(256), 0, st, rp, ip, gx, b.t0);
            gemm(st, b.t0, D, (const float*)in[19], D, b.t1, D, M, D, D);
            hipLaunchKernelGGL(k_add, g1(MD), dim3(256), 0, st, b.h, b.t1, MD);
            moe_ffn(st, b, norm_ffn + 1 * D, (const float*)in[31], (const float*)in[32], (const float*)in[33], (const float*)in[34]);
        } else if (L == 2) {
            hipLaunchKernelGGL(k_rmsnorm, dim3(M), dim3(256), 0, st, b.h, D, norm_mix + 2 * D, b.hn, D, D);
            hipLaunchKernelGGL(k_pool, g1(MD), dim3(256), 0, st, b.hn, b.t0);
            gemm(st, b.t0, D, (const float*)in[20], 256, b.t1, D, M, 256, 256, 0, nullptr, nullptr, 4, 256, 256 * 256, 256);
            hipLaunchKernelGGL(k_add_scaled, g1(MD), dim3(256), 0, st, b.h, b.t1, (const float*)in[21], MD);
            dense_ffn(st, b, norm_ffn + 2 * D, (const float*)in[28] + (size_t)D * FF, (const float*)in[29] + (size_t)D * FF, (const float*)in[30] + (size_t)FF * D);
        } else {
            hipLaunchKernelGGL(k_rmsnorm, dim3(M), dim3(256), 0, st, b.h, D, norm_mix + 3 * D, b.hn, D, D);
            float* z = b.t3;
            gemm(st, b.hn, D, (const float*)in[22], 2048, z, 2048, M, 2048, D);
            hipLaunchKernelGGL(k_gelu_inplace, g1((size_t)M * 2048), dim3(256), 0, st, z, (size_t)M * 2048);
            hipLaunchKernelGGL(k_layernorm_inplace, dim3(M), dim3(256), 0, st, z + 1024, 2048, (const float*)in[23], (const float*)in[24], D);
            hipLaunchKernelGGL(k_gmlp_gate, g1(MD), dim3(256), 0, st, z, (const float*)in[25], (const float*)in[26], b.t0);
            gemm(st, b.t0, D, (const float*)in[27], D, b.t1, D, M, D, D);
            hipLaunchKernelGGL(k_add, g1(MD), dim3(256), 0, st, b.h, b.t1, MD);
            moe_ffn(st, b, norm_ffn + 3 * D, (const float*)in[31] + (size_t)D * NE, (const float*)in[32] + (size_t)NE * D * FF, (const float*)in[33] + (size_t)NE * D * FF, (const float*)in[34] + (size_t)NE * FF * D);
        }
    }
    if (out) hipLaunchKernelGGL(k_rmsnorm, dim3(M), dim3(256), 0, st, b.h, D, norm_final, out, D, D);
}
}
extern "C" void kernel_launch(void* const* d_in, const int* in_sizes, int n_in, void* d_out, int out_size, void* d_ws, size_t ws_size, hipStream_t stream) {
    (void)in_sizes; (void)n_in; (void)out_size; (void)ws_size;
    const size_t MB = 1u << 20; char* w = (char*)d_ws;
    nv::Bufs b{};
    b.h = (float*)(w + 0 * MB); b.hn = (float*)(w + 64 * MB); b.t0 = (float*)(w + 128 * MB); b.t1 = (float*)(w + 192 * MB);
    b.t2 = (float*)(w + 256 * MB); b.t3 = (float*)(w + 352 * MB); b.small = (float*)(w + 480 * MB); b.ibuf = (int*)(w + 484 * MB);
    nv::forward(stream, d_in, b, 0, 4, (float*)d_out);
}
```

```cpp
#include <hip/hip_runtime.h>
#include <cstdio>
#include <cstdint>
#include <cmath>
namespace fk {
#define LAS __attribute__((address_space(3)))
#define GAS __attribute__((address_space(1)))
typedef unsigned short bf16_t;
typedef short bf16x8 __attribute__((ext_vector_type(8)));
typedef short s16x4 __attribute__((ext_vector_type(4)));
typedef float f32x4 __attribute__((ext_vector_type(4)));
typedef float f32x2 __attribute__((ext_vector_type(2)));
typedef float f32x16 __attribute__((ext_vector_type(16)));
typedef unsigned u32x4 __attribute__((ext_vector_type(4)));
typedef unsigned u32x2 __attribute__((ext_vector_type(2)));
typedef __bf16 bf16x2_t __attribute__((ext_vector_type(2)));

constexpr int D = 1024, NB = 4, S = 4096, M = NB * S, FF = 3584, NE = 8, NH = 16;
constexpr int MOE_MAXP = 136, MOE_MAXROWS = MOE_MAXP * 256;
constexpr float RMS_EPS = 1e-6f, LN_EPS = 1e-5f;
constexpr int NWAVES = 8, NTHR = 512;
constexpr int LDS_BYTES = 147456, MISC_OFF = LDS_BYTES - 256;

constexpr size_t MiB = 1u << 20;
#ifndef FAST_BASE_MIB
#define FAST_BASE_MIB 0
#endif
constexpr size_t FB = (size_t)FAST_BASE_MIB * MiB;
constexpr size_t WS_CTL = FB, CTL_ZERO_BYTES = 1 * MiB;
constexpr size_t WS_SSQ = FB + 1 * MiB;
constexpr size_t WS_SLOT24 = FB + 2 * MiB;
constexpr size_t WS_ROPE = FB + 4 * MiB;
constexpr size_t WS_SP8 = FB + 6 * MiB;
constexpr size_t WS_ROUTW = FB + 6 * MiB + 65536;
constexpr size_t WS_WGBASE = FB + 6 * MiB + 262144;
constexpr size_t WS_RSTD = FB + 6 * MiB + 524288;
constexpr size_t WS_TOKINFO = FB + 7 * MiB;
constexpr size_t WS_TOKG = FB + 7 * MiB + 262144;
constexpr size_t WS_DEST = FB + 7 * MiB + 393216;
constexpr size_t WS_TOKWG = FB + 7 * MiB + 524288;
constexpr size_t WS_ROWSCALE = FB + 8 * MiB;
constexpr size_t WS_ROWGATE = FB + 8 * MiB + 262144;
constexpr size_t WS_CARRY = FB + 9 * MiB;
constexpr size_t WS_HB = FB + 12 * MiB;
constexpr size_t WS_W = FB + 44 * MiB;
constexpr size_t W_MLA_IN = WS_W, W_UQ = WS_W + 1572864, W_UKV = W_UQ + 1179648, W_O = W_UKV + 1048576, W_LRU_IN = W_O + 2 * MiB, W_LRU_G = W_LRU_IN + 4 * MiB,
                 W_LRU_OUT = W_LRU_G + 1 * MiB, W_POOL = W_LRU_OUT + 2 * MiB, W_GM_IN = W_POOL + 524288, W_GM_S = W_GM_IN + 4 * MiB, W_GM_OUT = W_GM_S + 131072;
constexpr size_t W_FFN = WS_W + 20 * MiB;
constexpr size_t W_MOE = WS_W + 62 * MiB;
constexpr size_t WS_BIG = FB + 442 * MiB;
static_assert(W_GM_OUT + 2 * MiB <= W_FFN, "weight map");
constexpr size_t B_LAT = WS_BIG, B_Q = WS_BIG + 24 * MiB, B_KB = WS_BIG + 72 * MiB, B_VB = WS_BIG + 120 * MiB, B_OB = WS_BIG + 152 * MiB;
constexpr size_t B_ACT = WS_BIG;
constexpr size_t B_GATEB = WS_BIG, B_XBR = WS_BIG + 32 * MiB, B_XCB = WS_BIG + 64 * MiB, B_AF = WS_BIG + 96 * MiB, B_BF = WS_BIG + 160 * MiB, B_YB = WS_BIG + 224 * MiB;
constexpr size_t B_XG = WS_BIG, B_OUTM = WS_BIG, B_ACTM = WS_BIG + 68 * MiB;
constexpr size_t B_POOLED = WS_BIG;
constexpr size_t B_UB = WS_BIG, B_VB2 = WS_BIG + 32 * MiB, B_UVB = WS_BIG + 64 * MiB;
constexpr size_t WS_END = WS_BIG + 306 * MiB;
constexpr int CW_TMO = 0, CW_BAR = 4096, CW_MOECNT = 16384;

__device__ __forceinline__ unsigned pk2(float lo, float hi) { f32x2 v = {lo, hi}; bf16x2_t b = __builtin_convertvector(v, bf16x2_t); return __builtin_bit_cast(unsigned, b); }
__device__ __forceinline__ float bf2f(unsigned short b) { return __uint_as_float((unsigned)b << 16); }
__device__ __forceinline__ float bflo(unsigned w) { return __uint_as_float(w << 16); }
__device__ __forceinline__ float bfhi(unsigned w) { return __uint_as_float(w & 0xffff0000u); }
__device__ __forceinline__ float fast_exp2(float x) { return __builtin_amdgcn_exp2f(x); }
__device__ __forceinline__ float fast_rcp(float x) { return __builtin_amdgcn_rcpf(x); }
__device__ __forceinline__ float sigmoid_f(float x) { return fast_rcp(1.0f + fast_exp2(-1.4426950408889634f * x)); }
__device__ __forceinline__ float silu_f(float x) { return x * sigmoid_f(x); }
__device__ __forceinline__ float gelu_tanh_f(float x) { const float u = 0.7978845608028654f * (x + 0.044715f * x * x * x); return x * sigmoid_f(2.0f * u); }
__device__ __forceinline__ float wave_sum(float v) {
#pragma unroll
    for (int o = 1; o < 64; o <<= 1) v += __shfl_xor(v, o);
    return v;
}
__device__ __forceinline__ float hsum4(f32x4 a) { return (a.x + a.y) + (a.z + a.w); }
__device__ __forceinline__ float rstd16(const float* ssq, int row) {
    const f32x4* p = (const f32x4*)(ssq + (size_t)row * 16); const f32x4 a = p[0], b = p[1], c = p[2], d = p[3];
    const float s = (hsum4(a) + hsum4(b)) + (hsum4(c) + hsum4(d)); return 1.0f / sqrtf(s * (1.0f / 1024.0f) + RMS_EPS);
}

#define XB_TMO      128
#define XB_XCNT(j)  (256  + 64 * (j))
#define XB_XSUB(j)  (1280 + 64 * (j))
#define XB_XGEN(j)  (2304 + 64 * (j))
#define XB_TOP      3328
#define XB_TOPGEN   3392
#define XCD_BAR_WORDS 3456
#define XB_SPIN_CAP (1u << 18)
__device__ __forceinline__ unsigned xb_ld(unsigned* p)              { return __hip_atomic_load(p, __ATOMIC_RELAXED, __HIP_MEMORY_SCOPE_AGENT); }
__device__ __forceinline__ unsigned xb_add(unsigned* p, unsigned v) { return __hip_atomic_fetch_add(p, v, __ATOMIC_RELAXED, __HIP_MEMORY_SCOPE_AGENT); }
__device__ __forceinline__ unsigned xb_xcc_id() { return (unsigned)__builtin_amdgcn_s_getreg((3 << 11) | 20) & 0xFu; }
#define XB_SPIN(cond, bar) do { unsigned _sp = 0; while (cond) { __builtin_amdgcn_s_sleep(1); \
    if ((++_sp & 255u) == 0u) { if (xb_ld(&(bar)[XB_TMO])) break; if (_sp > XB_SPIN_CAP) { atomicAdd(&(bar)[XB_TMO], 1u); break; } } } } while (0)
struct XcdBarrier { unsigned* bar; unsigned x; volatile LAS unsigned* st; };
__device__ __forceinline__ XcdBarrier xcd_barrier_post(unsigned* bar, volatile LAS unsigned* st) {
    XcdBarrier b; b.bar = bar; b.x = xb_xcc_id(); b.st = st;
    if (threadIdx.x == 0) (void)xb_add(&bar[XB_XCNT(b.x)], 1u);
    return b;
}
__device__ __forceinline__ void xcd_barrier_complete(unsigned* bar, unsigned x, unsigned& nloc, unsigned& nx) {
    const unsigned G = gridDim.x * gridDim.y * gridDim.z;
    unsigned sum, cnt, mine, sp = 0u;
    for (;;) {
        sum = 0u; cnt = 0u; mine = 0u;
#pragma unroll
        for (unsigned j = 0; j < 16; ++j) { const unsigned c = xb_ld(&bar[XB_XCNT(j)]); sum += c; cnt += (c > 0u) ? 1u : 0u; mine = (j == x) ? c : mine; }
        if (sum == G) break;
        __builtin_amdgcn_s_sleep(1);
        if ((++sp & 255u) == 0u) { if (xb_ld(&bar[XB_TMO])) break; if (sp > XB_SPIN_CAP) { atomicAdd(&bar[XB_TMO], 1u); break; } }
    }
    nloc = mine > 0u ? mine : 1u; nx = cnt > 0u ? cnt : 1u;
}
__device__ __forceinline__ void xcd_barrier(const XcdBarrier& b) {
    asm volatile("s_waitcnt vmcnt(0)" ::: "memory");
    __syncthreads();
    if (threadIdx.x == 0) {
        unsigned* bar = b.bar;
        __builtin_amdgcn_s_waitcnt(0);
        unsigned nloc = b.st[0], nx = b.st[1];
        if (nloc == 0u) { xcd_barrier_complete(bar, b.x, nloc, nx); b.st[0] = nloc; b.st[1] = nx; }
        const unsigned old = xb_add(&bar[XB_XSUB(b.x)], 1u);
        const unsigned gen = old / nloc;
        if (old + 1u == (gen + 1u) * nloc) {
            __builtin_amdgcn_fence(__ATOMIC_RELEASE, "agent");
            asm volatile("s_waitcnt vmcnt(0)" ::: "memory");
            const unsigned og = xb_add(&bar[XB_TOP], 1u);
            const unsigned tg = og / nx;
            if (og + 1u == (tg + 1u) * nx) xb_add(&bar[XB_TOPGEN], 1u);
            else XB_SPIN(xb_ld(&bar[XB_TOPGEN]) == tg, bar);
            __builtin_amdgcn_fence(__ATOMIC_ACQUIRE, "agent");
            xb_add(&bar[XB_XGEN(b.x)], 1u);
            asm volatile("s_waitcnt vmcnt(0)" ::: "memory");
        } else {
            XB_SPIN(xb_ld(&bar[XB_XGEN(b.x)]) == gen, bar);
            __builtin_amdgcn_fence(__ATOMIC_ACQUIRE, "agent");
            asm volatile("s_waitcnt vmcnt(0)" ::: "memory");
        }
    }
    __syncthreads();
}

constexpr int BM = 256, BK = 64, HALF = 128, HTB = HALF * BK * 2, STAGE_BYTES = 8 * HTB, NXCD = 8, WGM = 8;
__device__ __forceinline__ int lds_byte(int r, int c) { const int st = (r >> 4) * 2 + (c >> 5), rr = r & 15, cc = c & 31, ob = rr * 64 + cc * 2; return st * 1024 + (ob ^ (((ob >> 9) & 1) << 5)); }
__device__ __forceinline__ void stage_rc(int b, int& R, int& C) { const int st = b / 1024, sb = b % 1024, swz = sb ^ (((sb >> 9) & 1) << 5); R = (st >> 1) * 16 + swz / 64; C = (st & 1) * 32 + (swz % 64) / 2; }
__device__ __forceinline__ int perm32(int rho) { const int n = rho >> 4, i = rho & 15; return 8 * (i >> 2) + 4 * n + (i & 3); }

__device__ __forceinline__ const char* uni_ptr(const char* p) { const unsigned long long v = (unsigned long long)p; const unsigned lo = __builtin_amdgcn_readfirstlane((unsigned)v), hi = __builtin_amdgcn_readfirstlane((unsigned)(v >> 32)); return (const char*)(((unsigned long long)hi << 32) | lo); }
struct GUnit { int pm, pn; const char* A; const char* B; int ex; };
__device__ __forceinline__ bool tile_order(int i, int G, int c, int nM, int nN, int& pm, int& pn) {
    const int nwg = nM * nN; const long L = (long)i * G + c; if (L >= nwg) return false;
    int wgid = (int)L; { const int q = nwg / NXCD, r = nwg % NXCD, xcd = wgid % NXCD, off = wgid / NXCD; wgid = (xcd < r ? xcd * (q + 1) : r * (q + 1) + (xcd - r) * q) + off; }
    const int nig = WGM * nN, gid = wgid / nig, fm = gid * WGM, gsz = (nM - fm) < WGM ? (nM - fm) : WGM;
    pm = fm + ((wgid % nig) % gsz); pn = (wgid % nig) / gsz; return true;
}
struct DenseSched {
    int nM, nN, G, c; const char* A; const char* B; size_t astep, bstep;
    __device__ __forceinline__ bool next(int i, GUnit& u) const { if (!tile_order(i, G, c, nM, nN, u.pm, u.pn)) return false; u.A = A + (size_t)u.pm * astep; u.B = B + (size_t)u.pn * bstep; u.ex = 0; return true; }
};
struct GroupSched {
    int nM, nN, G, c; const char* A; const char* B; size_t astep, bstep; int acol_bytes, acol_shift;
    __device__ __forceinline__ bool next(int i, GUnit& u) const { if (!tile_order(i, G, c, nM, nN, u.pm, u.pn)) return false;
        u.A = A + (size_t)u.pm * astep + (size_t)(u.pn >> acol_shift) * acol_bytes; u.B = B + (size_t)u.pn * bstep; u.ex = 0; return true; }
};
struct MoeSched {
    int nM, nN, G, c; const char* A; const char* B; size_t astep, bstep, estep; int pend[NE];
    __device__ __forceinline__ bool next(int i, GUnit& u) const { if (!tile_order(i, G, c, nM, nN, u.pm, u.pn)) return false;
        int e = 0;
#pragma unroll
        for (int k = 0; k < NE - 1; ++k) e += (u.pm >= pend[k]) ? 1 : 0;
        u.ex = e; u.A = A + (size_t)u.pm * astep; u.B = B + (size_t)e * estep + (size_t)u.pn * bstep; return true; }
};

template <class Epi, class Sched>
__device__ __forceinline__ void gemm_phase(LAS unsigned char* lds, const int lda, const int ldb, const int K, const Sched& S, const Epi& E) {
    const int tid = threadIdx.x, wid = __builtin_amdgcn_readfirstlane(tid >> 6), lane = tid & 63, wr = wid >> 2, wc = wid & 3, fr = lane & 15, fq = lane >> 4;
    const int nt = K / BK;
    unsigned voffA[2], voffB[2];
#pragma unroll
    for (int i = 0; i < 2; ++i) { int R, C; stage_rc(tid * 16 + i * 8192, R, C); const int Rb = Epi::PERM ? ((R & ~31) + perm32(R & 31)) : R;
        voffA[i] = (unsigned)(R * lda + C) * 2u; voffB[i] = (unsigned)(Rb * ldb + C) * 2u; }
    const size_t kstep = (size_t)(BK * 2);
    const size_t hstepA = (size_t)HALF * lda * 2, hstepB = (size_t)HALF * ldb * 2;
    const unsigned ldsw = (unsigned)wid * 1024u;
    const int aoff = lds_byte(wr * 64 + fr, fq * 8), boff = lds_byte(wc * 32 + fr, fq * 8);
#define PG8_SA(b, h) (((b) * 2 + (h)) * HTB)
#define PG8_SB(b, h) ((4 + (b) * 2 + (h)) * HTB)
#define PG8_STAGE(bufoff, gbase, voff) do { _Pragma("unroll") for (int _i = 0; _i < 2; ++_i) \
        __builtin_amdgcn_global_load_lds((const unsigned*)((const char*)(gbase) + (voff)[_i]), (LAS unsigned*)(lds + (bufoff) + ldsw + _i * 8192), 16, 0, 0); } while (0)
#define PG8_LDA(dst, b, h) do { _Pragma("unroll") for (int m = 0; m < 4; ++m) _Pragma("unroll") for (int k = 0; k < 2; ++k) dst[m][k] = *(const LAS bf16x8*)(lds + PG8_SA(b, h) + aoff + m * 2048 + k * 1024); } while (0)
#define PG8_LDB(dst, b, h) do { _Pragma("unroll") for (int n = 0; n < 2; ++n) _Pragma("unroll") for (int k = 0; k < 2; ++k) dst[n][k] = *(const LAS bf16x8*)(lds + PG8_SB(b, h) + boff + n * 2048 + k * 1024); } while (0)
#define PG8_MMA(ai, bj, At, Bt) do { __builtin_amdgcn_s_setprio(1); _Pragma("unroll") for (int m = 0; m < 4; ++m) _Pragma("unroll") for (int n = 0; n < 2; ++n) _Pragma("unroll") for (int k = 0; k < 2; ++k) \
        acc[ai][bj][m][n] = __builtin_amdgcn_mfma_f32_16x16x32_bf16(Bt[n][k], At[m][k], acc[ai][bj][m][n], 0, 0, 0); __builtin_amdgcn_s_setprio(0); } while (0)
#define PG8_WAIT_V(n) asm volatile("s_waitcnt vmcnt(" #n ")" ::: "memory")
#define PG8_WAIT_L(n) asm volatile("s_waitcnt lgkmcnt(" #n ")" ::: "memory")
#define PG8_BAR __builtin_amdgcn_s_barrier()
#define PG8_SCHED __builtin_amdgcn_sched_barrier(0)
    GUnit cur, nxt; int ui = 0;
    if (!S.next(0, cur)) return;
    f32x4 acc[2][2][4][2];
#pragma unroll
    for (int a = 0; a < 2; ++a)
#pragma unroll
        for (int b = 0; b < 2; ++b)
#pragma unroll
            for (int m = 0; m < 4; ++m)
#pragma unroll
                for (int n = 0; n < 2; ++n) acc[a][b][m][n] = (f32x4){0.f, 0.f, 0.f, 0.f};
    bf16x8 At[4][2], B0[2][2], B1[2][2];
    const char* cA = uni_ptr(cur.A); const char* cB = uni_ptr(cur.B);
    PG8_STAGE(PG8_SB(0, 0), cB, voffB); PG8_STAGE(PG8_SB(0, 1), cB + hstepB, voffB); PG8_STAGE(PG8_SA(0, 0), cA, voffA); PG8_STAGE(PG8_SA(0, 1), cA + hstepA, voffA);
    if (wr == 1) PG8_BAR;
    PG8_WAIT_V(2); PG8_BAR;
    PG8_STAGE(PG8_SB(1, 0), cB + kstep, voffB); PG8_STAGE(PG8_SA(1, 0), cA + kstep, voffA); PG8_STAGE(PG8_SB(1, 1), cB + hstepB + kstep, voffB);
    PG8_WAIT_V(6); PG8_BAR;
    for (;;) {
        const bool has_next = S.next(ui + 1, nxt);
        const char* nA = has_next ? uni_ptr(nxt.A) : cA; const char* nB = has_next ? uni_ptr(nxt.B) : cB;
#pragma clang loop unroll(disable)
        for (int t = 0; t < nt; t += 2) {
            const bool last = (t == nt - 2);
            const char* a1 = cA + (size_t)(t + 1) * kstep;
            const char* a2 = last ? nA : cA + (size_t)(t + 2) * kstep; const char* b2 = last ? nB : cB + (size_t)(t + 2) * kstep;
            const char* a3 = a2 + kstep; const char* b3 = b2 + kstep;
            PG8_LDB(B0, 0, 0); PG8_LDB(B1, 0, 1); PG8_SCHED; PG8_LDA(At, 0, 0); PG8_STAGE(PG8_SA(1, 1), a1 + hstepA, voffA);
            PG8_WAIT_V(8); PG8_WAIT_L(0); PG8_BAR; PG8_MMA(0, 0, At, B0); PG8_MMA(0, 1, At, B1); PG8_BAR; PG8_SCHED;
            PG8_LDA(At, 0, 1); PG8_STAGE(PG8_SB(0, 0), b2, voffB); PG8_STAGE(PG8_SB(0, 1), b2 + hstepB, voffB); PG8_STAGE(PG8_SA(0, 0), a2, voffA);
            PG8_WAIT_V(8); PG8_WAIT_L(0); PG8_BAR; PG8_MMA(1, 0, At, B0); PG8_MMA(1, 1, At, B1); PG8_BAR; PG8_SCHED;
            PG8_LDB(B0, 1, 0); PG8_LDB(B1, 1, 1); PG8_SCHED; PG8_LDA(At, 1, 0); PG8_STAGE(PG8_SA(0, 1), a2 + hstepA, voffA);
            PG8_WAIT_V(8); PG8_WAIT_L(0); PG8_BAR; PG8_MMA(0, 0, At, B0); PG8_MMA(0, 1, At, B1); PG8_BAR; PG8_SCHED;
            PG8_LDA(At, 1, 1); PG8_STAGE(PG8_SB(1, 0), b3, voffB); PG8_STAGE(PG8_SB(1, 1), b3 + hstepB, voffB); PG8_STAGE(PG8_SA(1, 0), a3, voffA);
            PG8_WAIT_V(8); PG8_WAIT_L(0); PG8_BAR; PG8_MMA(1, 0, At, B0); PG8_MMA(1, 1, At, B1); PG8_BAR; PG8_SCHED;
        }
        if (wr == 0) PG8_BAR;
        E(acc, cur, wr, wc, fr, fq);
        if (!has_next) break;
#pragma unroll
        for (int a = 0; a < 2; ++a)
#pragma unroll
            for (int b = 0; b < 2; ++b)
#pragma unroll
                for (int m = 0; m < 4; ++m)
#pragma unroll
                    for (int n = 0; n < 2; ++n) acc[a][b][m][n] = (f32x4){0.f, 0.f, 0.f, 0.f};
        cur = nxt; cA = nA; cB = nB; ++ui;
        if (wr == 1) PG8_BAR;
    }
    PG8_WAIT_V(0);
    PG8_BAR;
#undef PG8_SA
#undef PG8_SB
#undef PG8_STAGE
#undef PG8_LDA
#undef PG8_LDB
#undef PG8_MMA
#undef PG8_WAIT_V
#undef PG8_WAIT_L
#undef PG8_BAR
#undef PG8_SCHED
}
typedef f32x4 AccT[2][2][4][2];
__device__ __forceinline__ void st_bf16x8(bf16_t* p, f32x4 v0, f32x4 v1) { u32x4 w; w.x = pk2(v0[0], v0[1]); w.y = pk2(v0[2], v0[3]); w.z = pk2(v1[0], v1[1]); w.w = pk2(v1[2], v1[3]); *(u32x4*)p = w; }
__device__ __forceinline__ void st_bf16x4(bf16_t* p, f32x4 v) { u32x2 w; w.x = pk2(v[0], v[1]); w.y = pk2(v[2], v[3]); *(u32x2*)p = w; }
__device__ __forceinline__ float sumsq4(f32x4 v) { return (v[0] * v[0] + v[1] * v[1]) + (v[2] * v[2] + v[3] * v[3]); }
__device__ __forceinline__ float red_fq(float s) { s += __shfl_xor(s, 16); s += __shfl_xor(s, 32); return s; }
__device__ __forceinline__ void rope_rot(f32x4& x1, f32x4& x2, const float* cs  ) {
    const f32x4 t0 = *(const f32x4*)cs, t1 = *(const f32x4*)(cs + 4);
    const f32x4 c = {t0[0], t0[2], t1[0], t1[2]}, s = {t0[1], t0[3], t1[1], t1[3]};
    const f32x4 y1 = x1 * c - x2 * s, y2 = x2 * c + x1 * s; x1 = y1; x2 = y2;
}

struct EpiLat {
    static constexpr bool PERM = true;
    bf16_t* lat; float* slot24; const float* ssq; bf16_t* kb; const float* rope;
    __device__ __forceinline__ void operator()(const AccT& acc, const GUnit& u, int wr, int wc, int fr, int fq) const {
#pragma unroll
        for (int ai = 0; ai < 2; ++ai)
#pragma unroll
            for (int m = 0; m < 4; ++m) { const int row = u.pm * BM + ai * HALF + wr * 64 + m * 16 + fr; const float rs = rstd16(ssq, row);
#pragma unroll
                for (int bj = 0; bj < 2; ++bj) { const int cb = u.pn * BM + bj * HALF + wc * 32;
                    f32x4 v0 = acc[ai][bj][m][0] * rs, v1 = acc[ai][bj][m][1] * rs;
                    if (cb < 640) { st_bf16x8(lat + (size_t)row * 768 + cb + 8 * fq, v0, v1);
                        const float ss = red_fq(sumsq4(v0) + sumsq4(v1)); if (fq == 0) slot24[(size_t)row * 24 + u.pn * 8 + bj * 4 + wc] = ss; }
                    else if (cb == 640) { rope_rot(v0, v1, rope + (size_t)row * 32 + 8 * fq);
                        u32x4 w; w.x = pk2(v0[0], v0[1]); w.y = pk2(v0[2], v0[3]); w.z = pk2(v1[0], v1[1]); w.w = pk2(v1[2], v1[3]);
                        bf16_t* kp = kb + (size_t)row * 1536 + 64 + 8 * fq;
#pragma unroll
                        for (int hh = 0; hh < NH; ++hh) *(u32x4*)(kp + hh * 96) = w; } } }
    }
};
struct EpiQ {
    static constexpr bool PERM = true;
    bf16_t* q; const float* slot24; const float* rope;
    __device__ __forceinline__ void operator()(const AccT& acc, const GUnit& u, int wr, int wc, int fr, int fq) const {
#pragma unroll
        for (int ai = 0; ai < 2; ++ai)
#pragma unroll
            for (int m = 0; m < 4; ++m) { const int row = u.pm * BM + ai * HALF + wr * 64 + m * 16 + fr;
                const f32x4* sp = (const f32x4*)(slot24 + (size_t)row * 24); const float ss = (hsum4(sp[0]) + hsum4(sp[1])) + hsum4(sp[2]);
                const float rs = 1.0f / sqrtf(ss * (1.0f / 384.0f) + RMS_EPS);
#pragma unroll
                for (int bj = 0; bj < 2; ++bj) { const int cb = u.pn * BM + bj * HALF + wc * 32; const int gb = cb >> 5;
                    f32x4 v0 = acc[ai][bj][m][0] * rs, v1 = acc[ai][bj][m][1] * rs;
                    if (gb % 3 == 2) rope_rot(v0, v1, rope + (size_t)row * 32 + 8 * fq);
                    st_bf16x8(q + (size_t)row * 1536 + cb + 8 * fq, v0, v1); } }
    }
};
struct EpiKV {
    static constexpr bool PERM = true;
    bf16_t* kb; bf16_t* vb; const float* slot24;
    __device__ __forceinline__ void operator()(const AccT& acc, const GUnit& u, int wr, int wc, int fr, int fq) const {
#pragma unroll
        for (int ai = 0; ai < 2; ++ai)
#pragma unroll
            for (int m = 0; m < 4; ++m) { const int row = u.pm * BM + ai * HALF + wr * 64 + m * 16 + fr;
                const f32x4* sp = (const f32x4*)(slot24 + (size_t)row * 24 + 12); const float ss = hsum4(sp[0]) + hsum4(sp[1]);
                const float rs = 1.0f / sqrtf(ss * (1.0f / 256.0f) + RMS_EPS);
#pragma unroll
                for (int bj = 0; bj < 2; ++bj) { const int head = u.pn * 2 + bj;
                    const f32x4 v0 = acc[ai][bj][m][0] * rs, v1 = acc[ai][bj][m][1] * rs;
                    bf16_t* p = (wc < 2) ? kb + (size_t)row * 1536 + head * 96 + wc * 32 + 8 * fq : vb + (size_t)row * 1024 + head * 64 + (wc - 2) * 32 + 8 * fq;
                    st_bf16x8(p, v0, v1); } }
    }
};
struct EpiRes {
    static constexpr bool PERM = false;
    const float* base; float* h; bf16_t* hb; float* ssq; const float* colscale;
    __device__ __forceinline__ void operator()(const AccT& acc, const GUnit& u, int wr, int wc, int fr, int fq) const {
#pragma unroll
        for (int ai = 0; ai < 2; ++ai)
#pragma unroll
            for (int m = 0; m < 4; ++m) { const int row = u.pm * BM + ai * HALF + wr * 64 + m * 16 + fr; float ss = 0.f;
#pragma unroll
                for (int bj = 0; bj < 2; ++bj)
#pragma unroll
                    for (int n = 0; n < 2; ++n) { const int col = u.pn * BM + bj * HALF + wc * 32 + n * 16 + 4 * fq; const size_t off = (size_t)row * D + col;
                        f32x4 a = acc[ai][bj][m][n]; if (colscale) a = a * *(const f32x4*)(colscale + col);
                        const f32x4 o = *(const f32x4*)(base + off) + a; *(f32x4*)(h + off) = o; st_bf16x4(hb + off, o); ss += sumsq4(o); }
                ss = red_fq(ss); if (fq == 0) ssq[(size_t)row * 16 + u.pn * 4 + wc] = ss; }
    }
};
template <bool MOE> struct EpiSwiglu {
    static constexpr bool PERM = true;
    bf16_t* act; const float* rowsrc;
    __device__ __forceinline__ void operator()(const AccT& acc, const GUnit& u, int wr, int wc, int fr, int fq) const {
#pragma unroll
        for (int ai = 0; ai < 2; ++ai)
#pragma unroll
            for (int m = 0; m < 4; ++m) { const int row = u.pm * BM + ai * HALF + wr * 64 + m * 16 + fr; const float rs = MOE ? rowsrc[row] : rstd16(rowsrc, row);
                f32x4 o[2];
#pragma unroll
                for (int n = 0; n < 2; ++n) { const f32x4 g = acc[ai][0][m][n] * rs, up = acc[ai][1][m][n] * rs;
#pragma unroll
                    for (int i = 0; i < 4; ++i) o[n][i] = silu_f(g[i]) * up[i]; }
                st_bf16x8(act + (size_t)row * FF + u.pn * HALF + wc * 32 + 8 * fq, o[0], o[1]); }
    }
};
struct EpiMoeDown {
    static constexpr bool PERM = true;
    bf16_t* out; const float* rowgate;
    __device__ __forceinline__ void operator()(const AccT& acc, const GUnit& u, int wr, int wc, int fr, int fq) const {
#pragma unroll
        for (int ai = 0; ai < 2; ++ai)
#pragma unroll
            for (int m = 0; m < 4; ++m) { const int row = u.pm * BM + ai * HALF + wr * 64 + m * 16 + fr; const float g = rowgate[row];
#pragma unroll
                for (int bj = 0; bj < 2; ++bj) st_bf16x8(out + (size_t)row * D + u.pn * BM + bj * HALF + wc * 32 + 8 * fq, acc[ai][bj][m][0] * g, acc[ai][bj][m][1] * g); }
    }
};
template <bool GELU0, bool GELU1> struct EpiSplit2 {
    static constexpr bool PERM = true;
    bf16_t* o0; bf16_t* o1; const float* ssq;
    __device__ __forceinline__ void operator()(const AccT& acc, const GUnit& u, int wr, int wc, int fr, int fq) const {
        const bool second = u.pn >= 4; bf16_t* ob = second ? o1 : o0; const int ct = (u.pn & 3) * BM; const bool gl = second ? GELU1 : GELU0;
#pragma unroll
        for (int ai = 0; ai < 2; ++ai)
#pragma unroll
            for (int m = 0; m < 4; ++m) { const int row = u.pm * BM + ai * HALF + wr * 64 + m * 16 + fr; const float rs = rstd16(ssq, row);
#pragma unroll
                for (int bj = 0; bj < 2; ++bj) { f32x4 v0 = acc[ai][bj][m][0] * rs, v1 = acc[ai][bj][m][1] * rs;
                    if (gl) {
#pragma unroll
                        for (int i = 0; i < 4; ++i) { v0[i] = gelu_tanh_f(v0[i]); v1[i] = gelu_tanh_f(v1[i]); } }
                    st_bf16x8(ob + (size_t)row * D + ct + bj * HALF + wc * 32 + 8 * fq, v0, v1); } }
    }
};
__device__ __forceinline__ float one_minus_exp(float x) {
    const float t = -x * (1.0f + x * (0.5f + x * (0.16666667f + x * (0.041666668f + x * (0.0083333338f + x * 0.0013888889f)))));
    const float e = 1.0f - fast_exp2(1.4426950408889634f * x); return x > -0.25f ? t : e;
}
struct EpiLruGate {
    static constexpr bool PERM = false;
    float* af; float* bf; const bf16_t* xcb; const float* ba; const float* bx; const float* sp8;
    __device__ __forceinline__ void operator()(const AccT& acc, const GUnit& u, int wr, int wc, int fr, int fq) const {
#pragma unroll
        for (int n = 0; n < 2; ++n) { const int c = u.pn * HALF + wc * 32 + n * 16 + 4 * fq;
            const f32x4 vba = *(const f32x4*)(ba + c), vbx = *(const f32x4*)(bx + c), vsp = *(const f32x4*)(sp8 + c);
#pragma unroll
            for (int ai = 0; ai < 2; ++ai)
#pragma unroll
                for (int m = 0; m < 4; ++m) { const int row = u.pm * BM + ai * HALF + wr * 64 + m * 16 + fr; const size_t off = (size_t)row * D + c;
                    const u32x2 xw = *(const u32x2*)(xcb + off); const f32x4 xc = {bflo(xw.x), bfhi(xw.x), bflo(xw.y), bfhi(xw.y)};
                    const f32x4 rp = acc[ai][0][m][n] + vba, ip = acc[ai][1][m][n] + vbx; f32x4 a, b;
#pragma unroll
                    for (int i = 0; i < 4; ++i) { const float la = -vsp[i] * sigmoid_f(rp[i]); a[i] = fast_exp2(1.4426950408889634f * la); b[i] = sqrtf(one_minus_exp(2.0f * la)) * (sigmoid_f(ip[i]) * xc[i]); }
                    *(f32x4*)(af + off) = a; *(f32x4*)(bf + off) = b; } }
    }
};
struct Args { const void* in[35]; float* out; unsigned char* ws; float* hsrc; int ph_lo, ph_hi; unsigned wmask, lmask; };
struct Frame {
    LAS unsigned char* lds; unsigned char* ws; const void* const* in; float* h;
    int tid, lane, wave, vcu, G, gw, NGW;
};
#define WSP(T, off) ((T*)(F.ws + (off)))
#define INF(i) ((const float*)F.in[i])

enum { MODE_ID = 0, MODE_GU = 1, MODE_ROPEQ = 2, MODE_ROPELAT = 3 };
struct Fam { const float* src; const float* g; bf16_t* dst; int Ksrc, Kdst, N, Npad, ldt, mode, row_off, ksrc_off; float scale; };
__device__ __forceinline__ int rope_pos(int d) { return 8 * ((d >> 2) & 3) + 4 * (d >> 4) + (d & 3); }
__device__ __forceinline__ int map_row(int mode, int n) {
    if (mode == MODE_GU) return ((n >> 7) << 8) + (n & 127);
    if (mode == MODE_ROPEQ) { const int head = n / 96, loc = n - head * 96; return loc >= 64 ? head * 96 + 64 + rope_pos(loc - 64) : n; }
    if (mode == MODE_ROPELAT) return (n >= 640 && n < 672) ? 640 + rope_pos(n - 640) : n;
    return n;
}
__device__ __forceinline__ void conv_item(const Fam& f, LAS float* scr, int item, int lane) {
    const int nblk = f.Npad / 64, kb = item / nblk, nb = item - kb * nblk, k0 = 64 * kb, n0 = 64 * nb;
    const int col = n0 + 4 * (lane & 15);
#pragma unroll 4
    for (int i = 0; i < 16; ++i) { const int kk = 4 * i + (lane >> 4), srow = k0 + kk - f.ksrc_off;
        f32x4 v = {0.f, 0.f, 0.f, 0.f};
        if (srow >= 0 && srow < f.Ksrc && col < f.N) v = *(const f32x4*)(f.src + (size_t)srow * f.N + col);
        LAS float* s = scr + kk * 65 + 4 * (lane & 15); s[0] = v[0]; s[1] = v[1]; s[2] = v[2]; s[3] = v[3]; }
    asm volatile("s_waitcnt lgkmcnt(0)" ::: "memory");
    const int c = lane & 7; float gk[8];
#pragma unroll
    for (int t = 0; t < 8; ++t) { const int srow = k0 + 8 * c + t - f.ksrc_off; gk[t] = (f.g && srow >= 0 && srow < f.Ksrc) ? f.g[srow] * f.scale : f.scale; }
#pragma unroll
    for (int j = 0; j < 8; ++j) { const int n = (lane >> 3) + 8 * j; const LAS float* s = scr + (8 * c) * 65 + n;
        u32x4 o; o.x = pk2(s[0 * 65] * gk[0], s[1 * 65] * gk[1]); o.y = pk2(s[2 * 65] * gk[2], s[3 * 65] * gk[3]); o.z = pk2(s[4 * 65] * gk[4], s[5 * 65] * gk[5]); o.w = pk2(s[6 * 65] * gk[6], s[7 * 65] * gk[7]);
        const int drow = map_row(f.mode, n0 + n) + f.row_off;
        *(u32x4*)(f.dst + (size_t)drow * f.ldt + k0 + 8 * c) = o; }
    asm volatile("s_waitcnt lgkmcnt(0)" ::: "memory");
}
constexpr int NFAM = 17;
__device__ __forceinline__ int fam_count(int f) { return (f == 5 || f == 6) ? 8 : (f == 8) ? 4 : (f >= 11 && f <= 13) ? 2 : (f >= 14) ? 16 : 1; }
__device__ __forceinline__ Fam get_fam(const Frame& F, int f, int j) {
    Fam r; r.g = nullptr; r.mode = MODE_ID; r.row_off = 0; r.ksrc_off = 0; r.scale = 1.f;
    const float* norm_mix = INF(2); const float* norm_ffn = INF(3);
    switch (f) {
    case 0: r.src = INF(5); r.g = norm_mix; r.dst = WSP(bf16_t, W_MLA_IN); r.Ksrc = r.Kdst = 1024; r.N = 672; r.Npad = 768; r.ldt = 1024; r.mode = MODE_ROPELAT; break;
    case 1: r.src = INF(8); r.g = INF(6); r.dst = WSP(bf16_t, W_UQ); r.Ksrc = r.Kdst = 384; r.N = r.Npad = 1536; r.ldt = 384; r.mode = MODE_ROPEQ; r.scale = 0.10206207261596575f * 1.4426950408889634f; break;
    case 2: r.src = INF(9); r.g = INF(7); r.dst = WSP(bf16_t, W_UKV); r.Ksrc = r.Kdst = 256; r.N = r.Npad = 2048; r.ldt = 256; break;
    case 3: r.src = INF(10); r.dst = WSP(bf16_t, W_O); r.Ksrc = r.Kdst = 1024; r.N = r.Npad = 1024; r.ldt = 1024; break;
    case 4: r.src = INF(11); r.g = norm_mix + 1024; r.dst = WSP(bf16_t, W_LRU_IN); r.Ksrc = r.Kdst = 1024; r.N = r.Npad = 2048; r.ldt = 1024; break;
    case 5: case 6: r.src = INF(f == 5 ? 14 : 16) + (size_t)j * 16384; r.dst = WSP(bf16_t, W_LRU_G) + (size_t)j * 65536; r.Ksrc = 128; r.Kdst = 256; r.N = r.Npad = 128; r.ldt = 256; r.row_off = (f == 6) ? 128 : 0; r.ksrc_off = (j & 1) * 128; break;
    case 7: r.src = INF(19); r.dst = WSP(bf16_t, W_LRU_OUT); r.Ksrc = r.Kdst = 1024; r.N = r.Npad = 1024; r.ldt = 1024; break;
    case 8: r.src = INF(20) + (size_t)j * 65536; r.dst = WSP(bf16_t, W_POOL) + (size_t)j * 65536; r.Ksrc = r.Kdst = 256; r.N = r.Npad = 256; r.ldt = 256; break;
    case 9: r.src = INF(22); r.g = norm_mix + 3072; r.dst = WSP(bf16_t, W_GM_IN); r.Ksrc = r.Kdst = 1024; r.N = r.Npad = 2048; r.ldt = 1024; break;
    case 10: r.src = INF(27); r.dst = WSP(bf16_t, W_GM_OUT); r.Ksrc = r.Kdst = 1024; r.N = r.Npad = 1024; r.ldt = 1024; break;
    case 11: case 12: r.src = INF(f == 11 ? 28 : 29) + (size_t)j * D * FF; r.g = norm_ffn + 2048 * j; r.dst = (bf16_t*)(F.ws + W_FFN + (size_t)j * 21 * MiB); r.Ksrc = r.Kdst = 1024; r.N = r.Npad = FF; r.ldt = 1024; r.mode = MODE_GU; r.row_off = (f == 12) ? 128 : 0; break;
    case 13: r.src = INF(30) + (size_t)j * D * FF; r.dst = (bf16_t*)(F.ws + W_FFN + (size_t)j * 21 * MiB + 14 * MiB); r.Ksrc = r.Kdst = FF; r.N = r.Npad = 1024; r.ldt = FF; break;
    case 14: case 15: r.src = INF(f == 14 ? 32 : 33) + (size_t)j * D * FF; r.g = norm_ffn + 1024 + 2048 * (j >> 3); r.dst = (bf16_t*)(F.ws + W_MOE + (size_t)j * 21 * MiB); r.Ksrc = r.Kdst = 1024; r.N = r.Npad = FF; r.ldt = 1024; r.mode = MODE_GU; r.row_off = (f == 15) ? 128 : 0; break;
    default: r.src = INF(34) + (size_t)j * D * FF; r.dst = (bf16_t*)(F.ws + W_MOE + (size_t)j * 21 * MiB + 14 * MiB); r.Ksrc = r.Kdst = FF; r.N = r.Npad = 1024; r.ldt = FF; break;
    }
    return r;
}
__device__ __forceinline__ void stats_row(const Frame& F, const float* src, int row, float* rstd_out) {
    const f32x4* xr = (const f32x4*)(src + (size_t)row * D) + F.lane; f32x4 v[4]; float s = 0.f;
#pragma unroll
    for (int j = 0; j < 4; ++j) { v[j] = xr[64 * j]; s += sumsq4(v[j]); }
    s = wave_sum(s);
    bf16_t* hb = WSP(bf16_t, WS_HB) + (size_t)row * D + 4 * F.lane;
#pragma unroll
    for (int j = 0; j < 4; ++j) st_bf16x4(hb + 256 * j, v[j]);
    if (F.lane < 16) WSP(float, WS_SSQ)[(size_t)row * 16 + F.lane] = F.lane == 0 ? s : 0.f;
    if (rstd_out && F.lane == 0) rstd_out[row] = 1.0f / sqrtf(s * (1.0f / 1024.0f) + RMS_EPS);
}
__device__ __forceinline__ void phase_prologue(const Frame& F, unsigned wmask, unsigned lmask, const float* hsrc) {
    LAS float* scr = (LAS float*)(F.lds + F.wave * 16640);
    int base = 0;
    for (int f = 0; f < NFAM; ++f) { if (!((wmask >> f) & 1u)) continue;
        const int cnt = fam_count(f);
        for (int j = 0; j < cnt; ++j) {
            if (f >= 11 && f <= 13 && !((lmask >> j) & 1u)) continue;
            if (f >= 14 && !((lmask >> (2 + (j >> 3))) & 1u)) continue;
            const Fam fm = get_fam(F, f, j); const int nitems = (fm.Kdst / 64) * (fm.Npad / 64);
            for (int it = (F.gw + F.NGW - base % F.NGW) % F.NGW; it < nitems; it += F.NGW) conv_item(fm, scr, it, F.lane);
            base += nitems; } }
    const int gt = F.vcu * NTHR + F.tid, NT = F.G * NTHR;
    if ((wmask >> 17) & 1u) {
        for (int i = gt; i < M * 16; i += NT) { const int row = i >> 4, j = i & 15; const float inv = powf(10000.0f, -(float)j / 16.0f); const float ang = (float)((const int*)F.in[1])[row] * inv;
            WSP(float, WS_ROPE)[2 * i] = cosf(ang); WSP(float, WS_ROPE)[2 * i + 1] = sinf(ang); }
        for (int i = gt; i < D; i += NT) WSP(float, WS_SP8)[i] = 8.0f * log1pf(expf(-INF(18)[i]));
        for (int i = gt; i < 2 * D * NE; i += NT) { const int l = i / (D * NE), c = (i / NE) % D; WSP(float, WS_ROUTW)[i] = INF(3)[(1 + 2 * l) * D + c] * INF(31)[i]; }
        for (int i = gt; i < 4 * 128 * 128; i += NT) { const int t = (i >> 7) & 127, s = i & 127; WSP(bf16_t, W_GM_S)[i] = (bf16_t)(pk2(s <= t ? INF(25)[i] : 0.f, 0.f) & 0xffffu); }
    }
    if (hsrc) for (int row = F.gw; row < M; row += F.NGW) stats_row(F, hsrc, row, WSP(float, WS_RSTD));
}

__device__ __forceinline__ void phase_conv(const Frame& F) {
    const bf16_t* xbr = WSP(bf16_t, B_XBR); bf16_t* xcb = WSP(bf16_t, B_XCB); const float* cw = INF(12); const float* cb = INF(13);
    const int gt = F.vcu * NTHR + F.tid, NT = F.G * NTHR;
    for (int i = gt; i < M * (D / 8); i += NT) { const int row = i >> 7, c = (i & 127) * 8, t = row & (S - 1);
        float acc[8];
#pragma unroll
        for (int k = 0; k < 8; ++k) acc[k] = cb[c + k];
#pragma unroll
        for (int j = 0; j < 4; ++j) { if (t - 3 + j >= 0) { const u32x4 w = *(const u32x4*)(xbr + (size_t)(row - 3 + j) * D + c); const float* wj = cw + j * D + c;
            acc[0] += wj[0] * bflo(w.x); acc[1] += wj[1] * bfhi(w.x); acc[2] += wj[2] * bflo(w.y); acc[3] += wj[3] * bfhi(w.y);
            acc[4] += wj[4] * bflo(w.z); acc[5] += wj[5] * bfhi(w.z); acc[6] += wj[6] * bflo(w.w); acc[7] += wj[7] * bfhi(w.w); } }
        u32x4 o; o.x = pk2(acc[0], acc[1]); o.y = pk2(acc[2], acc[3]); o.z = pk2(acc[4], acc[5]); o.w = pk2(acc[6], acc[7]);
        *(u32x4*)(xcb + (size_t)row * D + c) = o; }
}
__device__ __forceinline__ void phase_scan1(const Frame& F) {
    const float* af = WSP(float, B_AF); const float* bf = WSP(float, B_BF); f32x2* carry = WSP(f32x2, WS_CARRY);
    const int gt = F.vcu * NTHR + F.tid, NT = F.G * NTHR;
    for (int i = gt; i < NB * 64 * D; i += NT) { const int c = i & (D - 1), ch = (i >> 10) & 63, b = i >> 16; const size_t r0 = ((size_t)b * S + ch * 64) * D + c;
        float A = 1.f, H = 0.f;
#pragma unroll 8
        for (int t = 0; t < 64; ++t) { const float a = af[r0 + (size_t)t * D], bb = bf[r0 + (size_t)t * D]; A *= a; H = a * H + bb; }
        carry[i] = (f32x2){A, H}; }
}
__device__ __forceinline__ void phase_scan2(const Frame& F) {
    const float* af = WSP(float, B_AF); const float* bf = WSP(float, B_BF); const f32x2* carry = WSP(f32x2, WS_CARRY);
    const bf16_t* gate = WSP(bf16_t, B_GATEB); bf16_t* yb = WSP(bf16_t, B_YB);
    const int gt = F.vcu * NTHR + F.tid, NT = F.G * NTHR;
    for (int i = gt; i < NB * 64 * D; i += NT) { const int c = i & (D - 1), ch = (i >> 10) & 63, b = i >> 16; const size_t r0 = ((size_t)b * S + ch * 64) * D + c;
        float H = 0.f;
        for (int k = 0; k < ch; ++k) { const f32x2 cv = carry[(b * 64 + k) * D + c]; H = cv.x * H + cv.y; }
#pragma unroll 8
        for (int t = 0; t < 64; ++t) { const size_t o = r0 + (size_t)t * D; H = af[o] * H + bf[o]; yb[o] = (bf16_t)(pk2(H * bf2f(gate[o]), 0.f) & 0xffffu); } }
}
__device__ __forceinline__ void phase_router(const Frame& F, int l) {
    const float* rw = WSP(float, WS_ROUTW) + (size_t)l * D * NE; const float* h = F.h;
    LAS int* se = (LAS int*)F.lds;
    unsigned* gcnt = WSP(unsigned, WS_CTL) + CW_MOECNT + 64 * l;
    const int tpw = (M + F.G - 1) / F.G;
    const int t0 = (int)blockIdx.x * tpw;
    for (int k = F.wave; k < tpw; k += NWAVES) { const int tok = t0 + k; if (tok >= M) break;
        float s[8];
#pragma unroll
        for (int e = 0; e < 8; ++e) s[e] = 0.f;
        float ss = 0.f;
#pragma unroll
        for (int j = 0; j < 4; ++j) { const int c0 = 256 * j + 4 * F.lane; const f32x4 x = *(const f32x4*)(h + (size_t)tok * D + c0); ss += sumsq4(x);
#pragma unroll
            for (int i = 0; i < 4; ++i) { const f32x4 w0 = *(const f32x4*)(rw + (size_t)(c0 + i) * 8), w1 = *(const f32x4*)(rw + (size_t)(c0 + i) * 8 + 4);
                s[0] += x[i] * w0[0]; s[1] += x[i] * w0[1]; s[2] += x[i] * w0[2]; s[3] += x[i] * w0[3]; s[4] += x[i] * w1[0]; s[5] += x[i] * w1[1]; s[6] += x[i] * w1[2]; s[7] += x[i] * w1[3]; } }
        ss = wave_sum(ss);
#pragma unroll
        for (int e = 0; e < 8; ++e) s[e] = wave_sum(s[e]);
        const float rs = 1.0f / sqrtf(ss * (1.0f / 1024.0f) + RMS_EPS);
        int e1 = 0; float v1 = s[0];
#pragma unroll
        for (int e = 1; e < 8; ++e) if (s[e] > v1) { v1 = s[e]; e1 = e; }
        int e2 = 0; float v2 = -INFINITY;
#pragma unroll
        for (int e = 0; e < 8; ++e) if (e != e1 && s[e] > v2) { v2 = s[e]; e2 = e; }
        const float g1 = 1.0f / (1.0f + expf((v2 - v1) * rs));
        if (F.lane == 0) { se[2 * k] = e1; se[2 * k + 1] = e2; WSP(f32x2, WS_TOKG)[tok] = (f32x2){g1, 1.0f - g1}; WSP(float, WS_RSTD)[tok] = rs; }
    }
    __syncthreads();
    if (F.wave == 0) { const int tok = t0 + F.lane; const bool valid = F.lane < tpw && tok < M;
        const int e1 = valid ? se[2 * F.lane] : -1, e2 = valid ? se[2 * F.lane + 1] : -1; int lr1 = 0, lr2 = 0;
        const unsigned long long lt = (1ull << F.lane) - 1ull;
#pragma unroll
        for (int e = 0; e < 8; ++e) { const unsigned long long m1 = __ballot(e1 == e), m2 = __ballot(e2 == e);
            const int before = __popcll(m1 & lt) + __popcll(m2 & lt); if (e1 == e) lr1 = before; if (e2 == e) lr2 = before;
            const int tot = __popcll(m1) + __popcll(m2);
            if (F.lane == e) { const unsigned bs = tot ? __hip_atomic_fetch_add(gcnt + e, (unsigned)tot, __ATOMIC_RELAXED, __HIP_MEMORY_SCOPE_AGENT) : 0u; WSP(int, WS_WGBASE)[blockIdx.x * 8 + e] = (int)bs; } }
        if (valid) { int* ti = WSP(int, WS_TOKINFO) + 4 * (size_t)tok; ti[0] = e1; ti[1] = lr1; ti[2] = e2; ti[3] = lr2; }
    }
    __syncthreads();
}
__device__ __forceinline__ int moe_layout(const Frame& F, int l, int* pstart_rows, int* pend) {
    const unsigned* gcnt = WSP(unsigned, WS_CTL) + CW_MOECNT + 64 * l; int p = 0;
#pragma unroll
    for (int e = 0; e < NE; ++e) { const int c = (int)__hip_atomic_load(gcnt + e, __ATOMIC_RELAXED, __HIP_MEMORY_SCOPE_AGENT); pstart_rows[e] = p * 256; p += (c + 255) >> 8; pend[e] = p; }
    return p;
}
__device__ __forceinline__ void phase_gather(const Frame& F, int l) {
    int ps[NE], pe[NE]; (void)moe_layout(F, l, ps, pe);
    const int tpw = (M + F.G - 1) / F.G;
    const bf16_t* hb = WSP(bf16_t, WS_HB); bf16_t* xg = WSP(bf16_t, B_XG);
    for (int tok = F.gw; tok < M; tok += F.NGW) { const int wg = tok / tpw;
        const int* ti = WSP(int, WS_TOKINFO) + 4 * (size_t)tok; const int e1 = ti[0], lr1 = ti[1], e2 = ti[2], lr2 = ti[3];
        int d1 = 0, d2 = 0;
#pragma unroll
        for (int e = 0; e < NE; ++e) { const int b = WSP(int, WS_WGBASE)[wg * 8 + e]; if (e == e1) d1 = ps[e] + b + lr1; if (e == e2) d2 = ps[e] + b + lr2; }
        const u32x4* src = (const u32x4*)(hb + (size_t)tok * D) + F.lane; const u32x4 a = src[0], b = src[64];
        u32x4* o1 = (u32x4*)(xg + (size_t)d1 * D) + F.lane; u32x4* o2 = (u32x4*)(xg + (size_t)d2 * D) + F.lane; o1[0] = a; o1[64] = b; o2[0] = a; o2[64] = b;
        if (F.lane == 0) { const f32x2 g = WSP(f32x2, WS_TOKG)[tok]; const float rs = WSP(float, WS_RSTD)[tok];
            WSP(float, WS_ROWSCALE)[d1] = rs; WSP(float, WS_ROWSCALE)[d2] = rs; WSP(float, WS_ROWGATE)[d1] = g.x; WSP(float, WS_ROWGATE)[d2] = g.y;
            WSP(int, WS_DEST)[2 * tok] = d1; WSP(int, WS_DEST)[2 * tok + 1] = d2; }
    }
}
template <bool FINAL> __device__ __forceinline__ void phase_combine(const Frame& F) {
    const bf16_t* om = WSP(bf16_t, B_OUTM); const float* gfin = INF(4);
    for (int tok = F.gw; tok < M; tok += F.NGW) {
        const int* ti = WSP(int, WS_TOKINFO) + 4 * (size_t)tok; const int e1 = ti[0], e2 = ti[2]; int d1 = WSP(int, WS_DEST)[2 * tok], d2 = WSP(int, WS_DEST)[2 * tok + 1];
        if (e2 < e1) { const int t = d1; d1 = d2; d2 = t; }
        f32x4 v[4]; float s = 0.f;
#pragma unroll
        for (int j = 0; j < 4; ++j) { const int c = 256 * j + 4 * F.lane; const f32x4 x = *(const f32x4*)(F.h + (size_t)tok * D + c);
            const u32x2 a = *(const u32x2*)(om + (size_t)d1 * D + c), b = *(const u32x2*)(om + (size_t)d2 * D + c);
            const f32x4 y = (f32x4){bflo(a.x), bfhi(a.x), bflo(a.y), bfhi(a.y)} + (f32x4){bflo(b.x), bfhi(b.x), bflo(b.y), bfhi(b.y)};
            v[j] = x + y; s += sumsq4(v[j]); }
        s = wave_sum(s); const float rs = 1.0f / sqrtf(s * (1.0f / 1024.0f) + RMS_EPS);
        if (FINAL) {
#pragma unroll
            for (int j = 0; j < 4; ++j) { const int c = 256 * j + 4 * F.lane; *(f32x4*)(F.h + (size_t)tok * D + c) = v[j] * rs * *(const f32x4*)(gfin + c); }
        } else {
#pragma unroll
            for (int j = 0; j < 4; ++j) { const int c = 256 * j + 4 * F.lane; *(f32x4*)(F.h + (size_t)tok * D + c) = v[j]; st_bf16x4(WSP(bf16_t, WS_HB) + (size_t)tok * D + c, v[j]); }
            if (F.lane < 16) WSP(float, WS_SSQ)[(size_t)tok * 16 + F.lane] = F.lane == 0 ? s : 0.f;
            if (F.lane == 0) WSP(float, WS_RSTD)[tok] = rs;
        }
    }
}
__device__ __forceinline__ void phase_pool(const Frame& F) {
    const float* rstd = WSP(float, WS_RSTD); const float* g = INF(2) + 2 * D; bf16_t* po = WSP(bf16_t, B_POOLED);
    const int gt = F.vcu * NTHR + F.tid, NT = F.G * NTHR;
    for (int i = gt; i < M * (D / 4); i += NT) { const int row = i >> 8, c = (i & 255) * 4, t = row & (S - 1); const int w = 2 << (c >> 8); const int n = t + 1 < w ? t + 1 : w;
        const f32x4 self = *(const f32x4*)(F.h + (size_t)row * D + c) * rstd[row]; f32x4 sum = self;
        for (int k = 1; k < n; ++k) sum += *(const f32x4*)(F.h + (size_t)(row - k) * D + c) * rstd[row - k];
        const f32x4 o = (sum * (1.0f / (float)n) - self) * *(const f32x4*)(g + c);
        st_bf16x4(po + (size_t)row * D + c, o); }
}
typedef short v4i16_t __attribute__((ext_vector_type(4)));
__device__ __forceinline__ int crow(int r, int hi) { return (r & 3) + 8 * (r >> 2) + 4 * hi; }
__device__ __forceinline__ s16x4 vtr(const LAS unsigned char* p) { return __builtin_bit_cast(s16x4, __builtin_amdgcn_ds_read_tr16_b64_v4i16((LAS v4i16_t*)p)); }
__device__ __forceinline__ bf16x8 pack8(const f32x16& p, int b) { u32x4 w; w.x = pk2(p[b], p[b + 1]); w.y = pk2(p[b + 2], p[b + 3]); w.z = pk2(p[b + 4], p[b + 5]); w.w = pk2(p[b + 6], p[b + 7]); return __builtin_bit_cast(bf16x8, w); }
constexpr int AT_KROW = 208, AT_KBYTES = 64 * AT_KROW, AT_BUF = AT_KBYTES + 8192, AT_WSF = 2 * AT_BUF;
__device__ __forceinline__ void attn_unit(const Frame& F, int bh, int qb) {
    const int b = bh >> 4, h = bh & 15, lane = F.lane, r = lane & 31, hh = lane >> 5, wid = F.wave, tid = F.tid;
    const bf16_t* Q = WSP(bf16_t, B_Q); const bf16_t* KB = WSP(bf16_t, B_KB); const bf16_t* VB = WSP(bf16_t, B_VB); bf16_t* OB = WSP(bf16_t, B_OB);
    const size_t rowbase = (size_t)b * S; const int q0 = qb * 256; const int qrow = q0 + 32 * wid + r;
    bf16x8 qf[6];
    { const bf16_t* qp = Q + (rowbase + qrow) * 1536 + h * 96 + 8 * hh;
#pragma unroll
      for (int ks = 0; ks < 6; ++ks) qf[ks] = *(const bf16x8*)(qp + 16 * ks); }
    const int NT = 4 * (qb + 1);
    const int krow0 = tid / 12, kch0 = tid - krow0 * 12, idx1 = 512 + tid, krow1 = idx1 / 12, kch1 = idx1 - krow1 * 12; const bool has1 = tid < 256;
    const int vrow = tid >> 3, vch = tid & 7;
    const bf16_t* kp0 = KB + (rowbase + krow0) * 1536 + h * 96 + 8 * kch0; const bf16_t* kp1 = KB + (rowbase + krow1) * 1536 + h * 96 + 8 * kch1;
    const bf16_t* vp = VB + (rowbase + vrow) * 1024 + h * 64 + 8 * vch;
    const int kd0 = krow0 * AT_KROW + kch0 * 16, kd1 = krow1 * AT_KROW + kch1 * 16, vd = AT_KBYTES + (vch >> 2) * 4096 + vrow * 64 + (vch & 3) * 16;
    LAS unsigned char* lds = F.lds; LAS float* wsf = (LAS float*)(lds + AT_WSF) + wid * 64;
    u32x4 rk0, rk1 = {0u, 0u, 0u, 0u}, rv;
    rk0 = *(const u32x4*)kp0; if (has1) rk1 = *(const u32x4*)kp1; rv = *(const u32x4*)vp;
    *(LAS u32x4*)(lds + kd0) = rk0; if (has1) *(LAS u32x4*)(lds + kd1) = rk1; *(LAS u32x4*)(lds + vd) = rv;
    __syncthreads();
    f32x16 o0, o1;
#pragma unroll
    for (int i = 0; i < 16; ++i) { o0[i] = 0.f; o1[i] = 0.f; }
    float mrun = -INFINITY, lrun = 0.f;
    const int kfrag = r * AT_KROW + hh * 16;
    const int vfrag = AT_KBYTES + ((lane >> 4) & 1) * 32 + (lane & 3) * 8 + (4 * hh + ((lane & 15) >> 2)) * 64;
    for (int t = 0; t < NT; ++t) {
        const int bo = (t & 1) * AT_BUF, bn = ((t + 1) & 1) * AT_BUF; const bool pre = t + 1 < NT;
        if (pre) { const size_t ko = (size_t)(t + 1) * 64 * 1536, vo = (size_t)(t + 1) * 64 * 1024; rk0 = *(const u32x4*)(kp0 + ko); if (has1) rk1 = *(const u32x4*)(kp1 + ko); rv = *(const u32x4*)(vp + vo); }
        if (t * 64 <= q0 + 32 * wid + 31) {
            f32x16 p0, p1;
#pragma unroll
            for (int i = 0; i < 16; ++i) { p0[i] = 0.f; p1[i] = 0.f; }
#pragma unroll
            for (int ks = 0; ks < 6; ++ks) { const bf16x8 a0 = *(const LAS bf16x8*)(lds + bo + kfrag + ks * 32), a1 = *(const LAS bf16x8*)(lds + bo + kfrag + 32 * AT_KROW + ks * 32);
                p0 = __builtin_amdgcn_mfma_f32_32x32x16_bf16(a0, qf[ks], p0, 0, 0, 0); p1 = __builtin_amdgcn_mfma_f32_32x32x16_bf16(a1, qf[ks], p1, 0, 0, 0); }
            if (t >= NT - 4) { const int kb0 = t * 64;
#pragma unroll
                for (int i = 0; i < 16; ++i) { const int kv = kb0 + crow(i, hh); if (kv > qrow) p0[i] = -INFINITY; if (kv + 32 > qrow) p1[i] = -INFINITY; } }
            float mx = fmaxf(p0[0], p1[0]);
#pragma unroll
            for (int i = 1; i < 16; ++i) mx = fmaxf(mx, fmaxf(p0[i], p1[i]));
            mx = fmaxf(mx, __shfl_xor(mx, 32));
            if (__any(mx > mrun)) { const float mn = fmaxf(mrun, mx); const float alpha = fast_exp2(mrun - mn); mrun = mn; lrun *= alpha;
                if (hh == 0) wsf[r] = alpha;
#pragma unroll
                for (int i = 0; i < 16; ++i) { const float al = wsf[crow(i, hh)]; o0[i] *= al; o1[i] *= al; } }
            float ls = 0.f;
#pragma unroll
            for (int i = 0; i < 16; ++i) { p0[i] = fast_exp2(p0[i] - mrun); p1[i] = fast_exp2(p1[i] - mrun); ls += p0[i] + p1[i]; }
            lrun += ls;
            const bf16x8 pa0 = pack8(p0, 0), pa1 = pack8(p0, 8), pa2 = pack8(p1, 0), pa3 = pack8(p1, 8);
            const LAS unsigned char* vb = lds + bo + vfrag;
#define AT_PV(o, d0) do { \
            { const s16x4 lo = vtr(vb + d0 * 4096 + 0 * 1024), hi = vtr(vb + d0 * 4096 + 0 * 1024 + 512); o = __builtin_amdgcn_mfma_f32_32x32x16_bf16(pa0, (bf16x8){lo[0], lo[1], lo[2], lo[3], hi[0], hi[1], hi[2], hi[3]}, o, 0, 0, 0); } \
            { const s16x4 lo = vtr(vb + d0 * 4096 + 1 * 1024), hi = vtr(vb + d0 * 4096 + 1 * 1024 + 512); o = __builtin_amdgcn_mfma_f32_32x32x16_bf16(pa1, (bf16x8){lo[0], lo[1], lo[2], lo[3], hi[0], hi[1], hi[2], hi[3]}, o, 0, 0, 0); } \
            { const s16x4 lo = vtr(vb + d0 * 4096 + 2 * 1024), hi = vtr(vb + d0 * 4096 + 2 * 1024 + 512); o = __builtin_amdgcn_mfma_f32_32x32x16_bf16(pa2, (bf16x8){lo[0], lo[1], lo[2], lo[3], hi[0], hi[1], hi[2], hi[3]}, o, 0, 0, 0); } \
            { const s16x4 lo = vtr(vb + d0 * 4096 + 3 * 1024), hi = vtr(vb + d0 * 4096 + 3 * 1024 + 512); o = __builtin_amdgcn_mfma_f32_32x32x16_bf16(pa3, (bf16x8){lo[0], lo[1], lo[2], lo[3], hi[0], hi[1], hi[2], hi[3]}, o, 0, 0, 0); } } while (0)
            AT_PV(o0, 0); AT_PV(o1, 1);
#undef AT_PV
        }
        if (pre) { *(LAS u32x4*)(lds + bn + kd0) = rk0; if (has1) *(LAS u32x4*)(lds + bn + kd1) = rk1; *(LAS u32x4*)(lds + bn + vd) = rv; }
        __syncthreads();
    }
    lrun += __shfl_xor(lrun, 32);
    if (hh == 0) wsf[32 + r] = lrun;
    bf16_t* op = OB + (rowbase + q0 + 32 * wid) * 1024 + h * 64 + r;
#pragma unroll
    for (int i = 0; i < 16; ++i) { const int qr = crow(i, hh); const float rl = fast_rcp(wsf[32 + qr]);
        op[(size_t)qr * 1024] = (bf16_t)(pk2(o0[i] * rl, 0.f) & 0xffffu); op[(size_t)qr * 1024 + 32] = (bf16_t)(pk2(o1[i] * rl, 0.f) & 0xffffu); }
    __syncthreads();
}
__device__ __forceinline__ void phase_attn(const Frame& F) {
    for (int pi = F.vcu; pi < 512; pi += F.G) { const int bh = pi >> 3, j = pi & 7; attn_unit(F, bh, j); attn_unit(F, bh, 15 - j); }
}

__device__ __forceinline__ void gmlp_unit(const Frame& F, int chunk, int g) {
    const int lane = F.lane, wid = F.wave, tid = F.tid, r = lane & 31, hh = lane >> 5;
    const bf16_t* vsrc = WSP(bf16_t, B_VB2); const bf16_t* usrc = WSP(bf16_t, B_UB); bf16_t* uv = WSP(bf16_t, B_UVB); const bf16_t* wsb = WSP(bf16_t, W_GM_S) + (size_t)g * 16384;
    const float* lng = INF(23); const float* lnb = INF(24); const float* bs = INF(26) + g * 128;
    LAS unsigned char* lds = F.lds; LAS f32x2* stat = (LAS f32x2*)(lds + 65536);
    const size_t row0 = (size_t)chunk * 128;
    for (int k = 0; k < 16; ++k) { const int rr = wid * 16 + k; const u32x4* p = (const u32x4*)(vsrc + (row0 + rr) * D) + lane; const u32x4 a = p[0], b2 = p[64];
        float x[16]; x[0] = bflo(a.x); x[1] = bfhi(a.x); x[2] = bflo(a.y); x[3] = bfhi(a.y); x[4] = bflo(a.z); x[5] = bfhi(a.z); x[6] = bflo(a.w); x[7] = bfhi(a.w);
        x[8] = bflo(b2.x); x[9] = bfhi(b2.x); x[10] = bflo(b2.y); x[11] = bfhi(b2.y); x[12] = bflo(b2.z); x[13] = bfhi(b2.z); x[14] = bflo(b2.w); x[15] = bfhi(b2.w);
        float s = 0.f;
#pragma unroll
        for (int i = 0; i < 16; ++i) s += x[i];
        const float mu = wave_sum(s) * (1.0f / 1024.0f); float q = 0.f;
#pragma unroll
        for (int i = 0; i < 16; ++i) { const float d = x[i] - mu; q += d * d; }
        const float var = wave_sum(q) * (1.0f / 1024.0f);
        if (lane == 0) stat[rr] = (f32x2){mu, 1.0f / sqrtf(var + LN_EPS)}; }
    __syncthreads();
#pragma unroll
    for (int k = 0; k < 8; ++k) { const int idx = tid + k * NTHR, s = idx >> 5, ch = idx & 31, c = g * 256 + ch * 8;
        const u32x4 w = *(const u32x4*)(vsrc + (row0 + s) * D + c); const f32x2 st = stat[s];
        const f32x4 g0 = *(const f32x4*)(lng + c), g1 = *(const f32x4*)(lng + c + 4), b0 = *(const f32x4*)(lnb + c), b1 = *(const f32x4*)(lnb + c + 4);
        f32x4 v0 = {bflo(w.x), bfhi(w.x), bflo(w.y), bfhi(w.y)}, v1 = {bflo(w.z), bfhi(w.z), bflo(w.w), bfhi(w.w)};
        v0 = (v0 - st.x) * st.y * g0 + b0; v1 = (v1 - st.x) * st.y * g1 + b1;
        u32x4 o; o.x = pk2(v0[0], v0[1]); o.y = pk2(v0[2], v0[3]); o.z = pk2(v1[0], v1[1]); o.w = pk2(v1[2], v1[3]);
        *(LAS u32x4*)(lds + (ch >> 2) * 8192 + s * 64 + (ch & 3) * 16) = o; }
    __syncthreads();
    bf16x8 bfr[8];
    { const LAS unsigned char* vb = lds + wid * 8192 + ((lane >> 4) & 1) * 32 + (lane & 3) * 8 + (8 * hh + ((lane & 15) >> 2)) * 64;
#pragma unroll
      for (int ks = 0; ks < 8; ++ks) { const s16x4 lo = vtr(vb + ks * 1024), hi = vtr(vb + ks * 1024 + 256); bfr[ks] = (bf16x8){lo[0], lo[1], lo[2], lo[3], hi[0], hi[1], hi[2], hi[3]}; } }
    const int cg = g * 256 + wid * 32 + r;
#pragma unroll
    for (int mt = 0; mt < 4; ++mt) { f32x16 acc;
#pragma unroll
        for (int i = 0; i < 16; ++i) acc[i] = 0.f;
        const bf16_t* wp = wsb + (size_t)(32 * mt + r) * 128 + 8 * hh;
#pragma unroll
        for (int ks = 0; ks < 8; ++ks) if (ks <= 2 * mt + 1) { const bf16x8 a = *(const bf16x8*)(wp + 16 * ks); acc = __builtin_amdgcn_mfma_f32_32x32x16_bf16(a, bfr[ks], acc, 0, 0, 0); }
#pragma unroll
        for (int i = 0; i < 16; ++i) { const int t = 32 * mt + crow(i, hh); const size_t off = (row0 + t) * D + cg;
            const float v2 = acc[i] + bs[t]; uv[off] = (bf16_t)(pk2(bf2f(usrc[off]) * v2, 0.f) & 0xffffu); } }
    __syncthreads();
}
__device__ __forceinline__ void phase_gmlp(const Frame& F) { for (int u = F.vcu; u < 512; u += F.G) gmlp_unit(F, u >> 2, u & 3); }
constexpr int PH_PRO = 0, PH_LAT = 1, PH_QKV = 2, PH_ATTN = 3, PH_WO = 4, PH_FUP0 = 5, PH_FDN0 = 6, PH_LIN = 7, PH_CONV = 8, PH_LGATE = 9, PH_SCAN1 = 10, PH_SCAN2 = 11, PH_LOUT = 12,
              PH_ROUT0 = 13, PH_GATH0 = 14, PH_MUP0 = 15, PH_MDN0 = 16, PH_COMB0 = 17, PH_POOL = 18, PH_PGEMM = 19, PH_FUP1 = 20, PH_FDN1 = 21, PH_GIN = 22, PH_GGATE = 23, PH_GOUT = 24,
              PH_ROUT1 = 25, PH_GATH1 = 26, PH_MUP1 = 27, PH_MDN1 = 28, PH_FINAL = 29, PH_N = 30;

__device__ __forceinline__ DenseSched dense_sched(const Frame& F, const void* A, int lda, const void* B, int ldb, int nM, int nN) {
    DenseSched s; s.nM = nM; s.nN = nN; s.G = F.G; s.c = (int)blockIdx.x; s.A = (const char*)A; s.B = (const char*)B; s.astep = (size_t)256 * lda * 2; s.bstep = (size_t)256 * ldb * 2; return s;
}
template <int L> __device__ __forceinline__ void phase_ffn_up(const Frame& F) {
    const DenseSched s = dense_sched(F, WSP(bf16_t, WS_HB), D, F.ws + W_FFN + (size_t)L * 21 * MiB, D, M / 256, 2 * FF / 256);
    EpiSwiglu<false> e{WSP(bf16_t, B_ACT), WSP(float, WS_SSQ)};
    gemm_phase(F.lds, D, D, D, s, e);
}
template <int L> __device__ __forceinline__ void phase_ffn_down(const Frame& F) {
    const DenseSched s = dense_sched(F, WSP(bf16_t, B_ACT), FF, F.ws + W_FFN + (size_t)L * 21 * MiB + 14 * MiB, FF, M / 256, D / 256);
    EpiRes e{F.h, F.h, WSP(bf16_t, WS_HB), WSP(float, WS_SSQ), nullptr};
    gemm_phase(F.lds, FF, FF, FF, s, e);
}
__device__ __forceinline__ MoeSched moe_sched(const Frame& F, int l, const void* A, int lda, size_t wofs, int ldb, int nN) {
    MoeSched s; int ps[NE]; s.nM = moe_layout(F, l, ps, s.pend); s.nN = nN; s.G = F.G; s.c = (int)blockIdx.x; s.A = (const char*)A; s.B = (const char*)(F.ws + W_MOE + (size_t)l * 8 * 21 * MiB + wofs);
    s.astep = (size_t)256 * lda * 2; s.bstep = (size_t)256 * ldb * 2; s.estep = (size_t)21 * MiB; return s;
}
template <int L> __device__ __forceinline__ void phase_moe_up(const Frame& F) {
    const MoeSched s = moe_sched(F, L, WSP(bf16_t, B_XG), D, 0, D, 2 * FF / 256);
    EpiSwiglu<true> e{WSP(bf16_t, B_ACTM), WSP(float, WS_ROWSCALE)};
    gemm_phase(F.lds, D, D, D, s, e);
}
template <int L> __device__ __forceinline__ void phase_moe_down(const Frame& F) {
    const MoeSched s = moe_sched(F, L, WSP(bf16_t, B_ACTM), FF, 14 * MiB, FF, D / 256);
    EpiMoeDown e{WSP(bf16_t, B_OUTM), WSP(float, WS_ROWGATE)};
    gemm_phase(F.lds, FF, FF, FF, s, e);
}

__global__ void __launch_bounds__(NTHR, 2) fused_fwd(Args args) {
    extern __shared__ __attribute__((aligned(16))) unsigned char lds_raw[];
    Frame F;
    F.lds = (LAS unsigned char*)lds_raw; F.ws = args.ws; F.in = args.in; F.h = args.out;
    F.tid = threadIdx.x; F.lane = F.tid & 63; F.wave = __builtin_amdgcn_readfirstlane(F.tid >> 6);
    F.G = gridDim.x; { const int bx = blockIdx.x; F.vcu = (F.G % 8 == 0) ? (bx % 8) * (F.G / 8) + bx / 8 : bx; }
    F.gw = F.vcu * NWAVES + F.wave; F.NGW = F.G * NWAVES;
    volatile LAS unsigned* MISC = (volatile LAS unsigned*)(F.lds + MISC_OFF);
    if (F.tid < 64) MISC[F.tid] = 0u;
    __syncthreads();
    XcdBarrier bar = xcd_barrier_post(WSP(unsigned, WS_CTL) + CW_BAR, MISC + 8);
    const int lo = args.ph_lo, hi = args.ph_hi;
#ifdef ONLY_PHASE
#define IN(k) ((k) == ONLY_PHASE && lo <= (k) && (k) < hi)
#else
#define IN(k) (lo <= (k) && (k) < hi)
#endif
#define SEAM(k) do { if (IN(k) && IN((k) + 1)) xcd_barrier(bar); } while (0)

    if (IN(PH_PRO)) { phase_prologue(F, args.wmask, args.lmask, args.hsrc); } SEAM(PH_PRO);
    if (IN(PH_LAT)) { const DenseSched s = dense_sched(F, WSP(bf16_t, WS_HB), D, WSP(bf16_t, W_MLA_IN), D, M / 256, 3);
        EpiLat e{WSP(bf16_t, B_LAT), WSP(float, WS_SLOT24), WSP(float, WS_SSQ), WSP(bf16_t, B_KB), WSP(float, WS_ROPE)};
        gemm_phase(F.lds, D, D, D, s, e); } SEAM(PH_LAT);
    if (IN(PH_QKV)) {
#ifndef SKIP_Q
        { const DenseSched s = dense_sched(F, WSP(bf16_t, B_LAT), 768, WSP(bf16_t, W_UQ), 384, M / 256, 6);
          EpiQ e{WSP(bf16_t, B_Q), WSP(float, WS_SLOT24), WSP(float, WS_ROPE)};
          gemm_phase(F.lds, 768, 384, 384, s, e); }
#endif
#ifndef SKIP_KV
        { const DenseSched s = dense_sched(F, WSP(bf16_t, B_LAT) + 384, 768, WSP(bf16_t, W_UKV), 256, M / 256, 8);
          EpiKV e{WSP(bf16_t, B_KB), WSP(bf16_t, B_VB), WSP(float, WS_SLOT24)};
          gemm_phase(F.lds, 768, 256, 256, s, e); }
#endif
        } SEAM(PH_QKV);
    if (IN(PH_ATTN)) { phase_attn(F); } SEAM(PH_ATTN);
    if (IN(PH_WO)) { const DenseSched s = dense_sched(F, WSP(bf16_t, B_OB), D, WSP(bf16_t, W_O), D, M / 256, 4);
        EpiRes e{INF(0), F.h, WSP(bf16_t, WS_HB), WSP(float, WS_SSQ), nullptr};
        gemm_phase(F.lds, D, D, D, s, e); } SEAM(PH_WO);
    if (IN(PH_FUP0)) { phase_ffn_up<0>(F); } SEAM(PH_FUP0);
    if (IN(PH_FDN0)) { phase_ffn_down<0>(F); } SEAM(PH_FDN0);
    if (IN(PH_LIN)) { const DenseSched s = dense_sched(F, WSP(bf16_t, WS_HB), D, WSP(bf16_t, W_LRU_IN), D, M / 256, 8);
        EpiSplit2<true, false> e{WSP(bf16_t, B_GATEB), WSP(bf16_t, B_XBR), WSP(float, WS_SSQ)};
        gemm_phase(F.lds, D, D, D, s, e); } SEAM(PH_LIN);
    if (IN(PH_CONV)) { phase_conv(F); } SEAM(PH_CONV);
    if (IN(PH_LGATE)) { GroupSched s; s.nM = M / 256; s.nN = 8; s.G = F.G; s.c = (int)blockIdx.x; s.A = (const char*)WSP(bf16_t, B_XCB); s.B = (const char*)WSP(bf16_t, W_LRU_G);
        s.astep = (size_t)256 * D * 2; s.bstep = (size_t)256 * 256 * 2; s.acol_bytes = 512; s.acol_shift = 1;
        EpiLruGate e{WSP(float, B_AF), WSP(float, B_BF), WSP(bf16_t, B_XCB), INF(15), INF(17), WSP(float, WS_SP8)};
        gemm_phase(F.lds, D, 256, 256, s, e); } SEAM(PH_LGATE);
    if (IN(PH_SCAN1)) { phase_scan1(F); } SEAM(PH_SCAN1);
    if (IN(PH_SCAN2)) { phase_scan2(F); } SEAM(PH_SCAN2);
    if (IN(PH_LOUT)) { const DenseSched s = dense_sched(F, WSP(bf16_t, B_YB), D, WSP(bf16_t, W_LRU_OUT), D, M / 256, 4);
        EpiRes e{F.h, F.h, WSP(bf16_t, WS_HB), WSP(float, WS_SSQ), nullptr};
        gemm_phase(F.lds, D, D, D, s, e); } SEAM(PH_LOUT);
    if (IN(PH_ROUT0)) { phase_router(F, 0); } SEAM(PH_ROUT0);
    if (IN(PH_GATH0)) { phase_gather(F, 0); } SEAM(PH_GATH0);
    if (IN(PH_MUP0)) { phase_moe_up<0>(F); } SEAM(PH_MUP0);
    if (IN(PH_MDN0)) { phase_moe_down<0>(F); } SEAM(PH_MDN0);
    if (IN(PH_COMB0)) { phase_combine<false>(F); } SEAM(PH_COMB0);
    if (IN(PH_POOL)) { phase_pool(F); } SEAM(PH_POOL);
    if (IN(PH_PGEMM)) { GroupSched s; s.nM = M / 256; s.nN = 4; s.G = F.G; s.c = (int)blockIdx.x; s.A = (const char*)WSP(bf16_t, B_POOLED); s.B = (const char*)WSP(bf16_t, W_POOL);
        s.astep = (size_t)256 * D * 2; s.bstep = (size_t)256 * 256 * 2; s.acol_bytes = 512; s.acol_shift = 0;
        EpiRes e{F.h, F.h, WSP(bf16_t, WS_HB), WSP(float, WS_SSQ), INF(21)};
        gemm_phase(F.lds, D, 256, 256, s, e); } SEAM(PH_PGEMM);
    if (IN(PH_FUP1)) { phase_ffn_up<1>(F); } SEAM(PH_FUP1);
    if (IN(PH_FDN1)) { phase_ffn_down<1>(F); } SEAM(PH_FDN1);
    if (IN(PH_GIN)) { const DenseSched s = dense_sched(F, WSP(bf16_t, WS_HB), D, WSP(bf16_t, W_GM_IN), D, M / 256, 8);
        EpiSplit2<true, true> e{WSP(bf16_t, B_UB), WSP(bf16_t, B_VB2), WSP(float, WS_SSQ)};
        gemm_phase(F.lds, D, D, D, s, e); } SEAM(PH_GIN);
    if (IN(PH_GGATE)) { phase_gmlp(F); } SEAM(PH_GGATE);
    if (IN(PH_GOUT)) { const DenseSched s = dense_sched(F, WSP(bf16_t, B_UVB), D, WSP(bf16_t, W_GM_OUT), D, M / 256, 4);
        EpiRes e{F.h, F.h, WSP(bf16_t, WS_HB), WSP(float, WS_SSQ), nullptr};
        gemm_phase(F.lds, D, D, D, s, e); } SEAM(PH_GOUT);
    if (IN(PH_ROUT1)) { phase_router(F, 1); } SEAM(PH_ROUT1);
    if (IN(PH_GATH1)) { phase_gather(F, 1); } SEAM(PH_GATH1);
    if (IN(PH_MUP1)) { phase_moe_up<1>(F); } SEAM(PH_MUP1);
    if (IN(PH_MDN1)) { phase_moe_down<1>(F); } SEAM(PH_MDN1);
    if (IN(PH_FINAL)) { phase_combine<true>(F); }
#undef IN
#undef SEAM
}
}
extern "C" void kernel_launch(void* const* d_in, const int* in_sizes, int n_in, void* d_out, int out_size, void* d_ws, size_t ws_size, hipStream_t stream) {
    (void)in_sizes; (void)out_size;
    static int grid = 0;
    if (grid == 0) {
        int dev = 0, cus = 0;
        if (n_in != 35 || ws_size < fk::WS_END) { fprintf(stderr, "kernel_launch: unexpected inputs / workspace (%d inputs, %zu bytes)\n", n_in, ws_size); grid = -1; return; }
        if (hipGetDevice(&dev) != hipSuccess || hipDeviceGetAttribute(&cus, hipDeviceAttributeMultiprocessorCount, dev) != hipSuccess) { grid = -1; return; }
        if (hipFuncSetAttribute((const void*)fk::fused_fwd, hipFuncAttributeMaxDynamicSharedMemorySize, fk::LDS_BYTES) != hipSuccess) { grid = -1; return; }
        int per_cu = 0; (void)hipOccupancyMaxActiveBlocksPerMultiprocessor(&per_cu, (const void*)fk::fused_fwd, fk::NTHR, fk::LDS_BYTES); (void)hipGetLastError();
        grid = cus;
    }
    if (grid < 0) return;
    (void)hipMemsetAsync((char*)d_ws + fk::WS_CTL, 0, fk::CTL_ZERO_BYTES, stream);
    fk::Args a{}; for (int i = 0; i < 35; ++i) a.in[i] = d_in[i];
    a.out = (float*)d_out; a.ws = (unsigned char*)d_ws; a.hsrc = (float*)d_in[0]; a.ph_lo = 0; a.ph_hi = fk::PH_N; a.wmask = 0x3FFFFu; a.lmask = 0xFu;
    hipLaunchKernelGGL(fk::fused_fwd, dim3(grid), dim3(fk::NTHR), fk::LDS_BYTES, stream, a);
}
```

```cpp
#include <hip/hip_runtime.h>
#include <cstdio>
#include <cstdint>
#include <cmath>
namespace fk {
#define LAS __attribute__((address_space(3)))
#define GAS __attribute__((address_space(1)))
typedef unsigned short bf16_t;
typedef short bf16x8 __attribute__((ext_vector_type(8)));
typedef short s16x4 __attribute__((ext_vector_type(4)));
typedef float f32x4 __attribute__((ext_vector_type(4)));
typedef float f32x2 __attribute__((ext_vector_type(2)));
typedef float f32x16 __attribute__((ext_vector_type(16)));
typedef unsigned u32x4 __attribute__((ext_vector_type(4)));
typedef unsigned u32x2 __attribute__((ext_vector_type(2)));
typedef __bf16 bf16x2_t __attribute__((ext_vector_type(2)));

constexpr int D = 1024, NB = 4, S = 4096, M = NB * S, FF = 3584, NE = 8, NH = 16;
constexpr int MOE_MAXP = 136, MOE_MAXROWS = MOE_MAXP * 256;
constexpr float RMS_EPS = 1e-6f, LN_EPS = 1e-5f;
constexpr int NWAVES = 8, NTHR = 512;
constexpr int LDS_BYTES = 147456, MISC_OFF = LDS_BYTES - 256;

constexpr size_t MiB = 1u << 20;
#ifndef FAST_BASE_MIB
#define FAST_BASE_MIB 0
#endif
constexpr size_t FB = (size_t)FAST_BASE_MIB * MiB;
constexpr size_t WS_CTL = FB, CTL_ZERO_BYTES = 1 * MiB;
constexpr size_t WS_SSQ = FB + 1 * MiB;
constexpr size_t WS_SLOT24 = FB + 2 * MiB;
constexpr size_t WS_ROPE = FB + 4 * MiB;
constexpr size_t WS_SP8 = FB + 6 * MiB;
constexpr size_t WS_ROUTW = FB + 6 * MiB + 65536;
constexpr size_t WS_WGBASE = FB + 6 * MiB + 262144;
constexpr size_t WS_RSTD = FB + 6 * MiB + 524288;
constexpr size_t WS_TOKINFO = FB + 7 * MiB;
constexpr size_t WS_TOKG = FB + 7 * MiB + 262144;
constexpr size_t WS_DEST = FB + 7 * MiB + 393216;
constexpr size_t WS_TOKWG = FB + 7 * MiB + 524288;
constexpr size_t WS_ROWSCALE = FB + 8 * MiB;
constexpr size_t WS_ROWGATE = FB + 8 * MiB + 262144;
constexpr size_t WS_CARRY = FB + 9 * MiB;
constexpr size_t WS_HB = FB + 12 * MiB;
constexpr size_t WS_W = FB + 44 * MiB;
constexpr size_t W_MLA_IN = WS_W, W_UQ = WS_W + 1572864, W_UKV = W_UQ + 1179648, W_O = W_UKV + 1048576, W_LRU_IN = W_O + 2 * MiB, W_LRU_G = W_LRU_IN + 4 * MiB,
                 W_LRU_OUT = W_LRU_G + 1 * MiB, W_POOL = W_LRU_OUT + 2 * MiB, W_GM_IN = W_POOL + 524288, W_GM_S = W_GM_IN + 4 * MiB, W_GM_OUT = W_GM_S + 131072;
constexpr size_t W_FFN = WS_W + 20 * MiB;
constexpr size_t W_MOE = WS_W + 62 * MiB;
constexpr size_t WS_BIG = FB + 442 * MiB;
static_assert(W_GM_OUT + 2 * MiB <= W_FFN, "weight map");
constexpr size_t B_LAT = WS_BIG, B_Q = WS_BIG + 24 * MiB, B_KB = WS_BIG + 72 * MiB, B_VB = WS_BIG + 120 * MiB, B_OB = WS_BIG + 152 * MiB;
constexpr size_t B_ACT = WS_BIG;
constexpr size_t B_GATEB = WS_BIG, B_XBR = WS_BIG + 32 * MiB, B_XCB = WS_BIG + 64 * MiB, B_AF = WS_BIG + 96 * MiB, B_BF = WS_BIG + 160 * MiB, B_YB = WS_BIG + 224 * MiB;
constexpr size_t B_XG = WS_BIG, B_OUTM = WS_BIG, B_ACTM = WS_BIG + 68 * MiB;
constexpr size_t B_POOLED = WS_BIG;
constexpr size_t B_UB = WS_BIG, B_VB2 = WS_BIG + 32 * MiB, B_UVB = WS_BIG + 64 * MiB;
constexpr size_t WS_END = WS_BIG + 306 * MiB;
constexpr int CW_TMO = 0, CW_BAR = 4096, CW_MOECNT = 16384;

__device__ __forceinline__ unsigned pk2(float lo, float hi) { f32x2 v = {lo, hi}; bf16x2_t b = __builtin_convertvector(v, bf16x2_t); return __builtin_bit_cast(unsigned, b); }
__device__ __forceinline__ float bf2f(unsigned short b) { return __uint_as_float((unsigned)b << 16); }
__device__ __forceinline__ float bflo(unsigned w) { return __uint_as_float(w << 16); }
__device__ __forceinline__ float bfhi(unsigned w) { return __uint_as_float(w & 0xffff0000u); }
__device__ __forceinline__ float fast_exp2(float x) { return __builtin_amdgcn_exp2f(x); }
__device__ __forceinline__ float fast_rcp(float x) { return __builtin_amdgcn_rcpf(x); }
__device__ __forceinline__ float sigmoid_f(float x) { return fast_rcp(1.0f + fast_exp2(-1.4426950408889634f * x)); }
__device__ __forceinline__ float silu_f(float x) { return x * sigmoid_f(x); }
__device__ __forceinline__ float gelu_tanh_f(float x) { const float u = 0.7978845608028654f * (x + 0.044715f * x * x * x); return x * sigmoid_f(2.0f * u); }
__device__ __forceinline__ float wave_sum(float v) {
#pragma unroll
    for (int o = 1; o < 64; o <<= 1) v += __shfl_xor(v, o);
    return v;
}
__device__ __forceinline__ float hsum4(f32x4 a) { return (a.x + a.y) + (a.z + a.w); }
__device__ __forceinline__ float rstd16(const float* ssq, int row) {
    const f32x4* p = (const f32x4*)(ssq + (size_t)row * 16); const f32x4 a = p[0], b = p[1], c = p[2], d = p[3];
    const float s = (hsum4(a) + hsum4(b)) + (hsum4(c) + hsum4(d)); return 1.0f / sqrtf(s * (1.0f / 1024.0f) + RMS_EPS);
}

#define XB_TMO      128
#define XB_XCNT(j)  (256  + 64 * (j))
#define XB_XSUB(j)  (1280 + 64 * (j))
#define XB_XGEN(j)  (2304 + 64 * (j))
#define XB_TOP      3328
#define XB_TOPGEN   3392
#define XCD_BAR_WORDS 3456
#define XB_SPIN_CAP (1u << 18)
__device__ __forceinline__ unsigned xb_ld(unsigned* p)              { return __hip_atomic_load(p, __ATOMIC_RELAXED, __HIP_MEMORY_SCOPE_AGENT); }
__device__ __forceinline__ unsigned xb_add(unsigned* p, unsigned v) { return __hip_atomic_fetch_add(p, v, __ATOMIC_RELAXED, __HIP_MEMORY_SCOPE_AGENT); }
__device__ __forceinline__ unsigned xb_xcc_id() { return (unsigned)__builtin_amdgcn_s_getreg((3 << 11) | 20) & 0xFu; }
#define XB_SPIN(cond, bar) do { unsigned _sp = 0; while (cond) { __builtin_amdgcn_s_sleep(1); \
    if ((++_sp & 255u) == 0u) { if (xb_ld(&(bar)[XB_TMO])) break; if (_sp > XB_SPIN_CAP) { atomicAdd(&(bar)[XB_TMO], 1u); break; } } } } while (0)
struct XcdBarrier { unsigned* bar; unsigned x; volatile LAS unsigned* st; };
__device__ __forceinline__ XcdBarrier xcd_barrier_post(unsigned* bar, volatile LAS unsigned* st) {
    XcdBarrier b; b.bar = bar; b.x = xb_xcc_id(); b.st = st;
    if (threadIdx.x == 0) (void)xb_add(&bar[XB_XCNT(b.x)], 1u);
    return b;
}
__device__ __forceinline__ void xcd_barrier_complete(unsigned* bar, unsigned x, unsigned& nloc, unsigned& nx) {
    const unsigned G = gridDim.x * gridDim.y * gridDim.z;
    unsigned sum, cnt, mine, sp = 0u;
    for (;;) {
        sum = 0u; cnt = 0u; mine = 0u;
#pragma unroll
        for (unsigned j = 0; j < 16; ++j) { const unsigned c = xb_ld(&bar[XB_XCNT(j)]); sum += c; cnt += (c > 0u) ? 1u : 0u; mine = (j == x) ? c : mine; }
        if (sum == G) break;
        __builtin_amdgcn_s_sleep(1);
        if ((++sp & 255u) == 0u) { if (xb_ld(&bar[XB_TMO])) break; if (sp > XB_SPIN_CAP) { atomicAdd(&bar[XB_TMO], 1u); break; } }
    }
    nloc = mine > 0u ? mine : 1u; nx = cnt > 0u ? cnt : 1u;
}
__device__ __forceinline__ void xcd_barrier(const XcdBarrier& b) {
    asm volatile("s_waitcnt vmcnt(0)" ::: "memory");
    __syncthreads();
    if (threadIdx.x == 0) {
        unsigned* bar = b.bar;
        __builtin_amdgcn_s_waitcnt(0);
        unsigned nloc = b.st[0], nx = b.st[1];
        if (nloc == 0u) { xcd_barrier_complete(bar, b.x, nloc, nx); b.st[0] = nloc; b.st[1] = nx; }
        const unsigned old = xb_add(&bar[XB_XSUB(b.x)], 1u);
        const unsigned gen = old / nloc;
        if (old + 1u == (gen + 1u) * nloc) {
            __builtin_amdgcn_fence(__ATOMIC_RELEASE, "agent");
            asm volatile("s_waitcnt vmcnt(0)" ::: "memory");
            const unsigned og = xb_add(&bar[XB_TOP], 1u);
            const unsigned tg = og / nx;
            if (og + 1u == (tg + 1u) * nx) xb_add(&bar[XB_TOPGEN], 1u);
            else XB_SPIN(xb_ld(&bar[XB_TOPGEN]) == tg, bar);
            __builtin_amdgcn_fence(__ATOMIC_ACQUIRE, "agent");
            xb_add(&bar[XB_XGEN(b.x)], 1u);
            asm volatile("s_waitcnt vmcnt(0)" ::: "memory");
        } else {
            XB_SPIN(xb_ld(&bar[XB_XGEN(b.x)]) == gen, bar);
            __builtin_amdgcn_fence(__ATOMIC_ACQUIRE, "agent");
            asm volatile("s_waitcnt vmcnt(0)" ::: "memory");
        }
    }
    __syncthreads();
}

constexpr int BM = 256, BK = 64, HALF = 128, HTB = HALF * BK * 2, STAGE_BYTES = 8 * HTB, NXCD = 8, WGM = 8;
__device__ __forceinline__ int lds_byte(int r, int c) { const int st = (r >> 4) * 2 + (c >> 5), rr = r & 15, cc = c & 31, ob = rr * 64 + cc * 2; return st * 1024 + (ob ^ (((ob >> 9) & 1) << 5)); }
__device__ __forceinline__ void stage_rc(int b, int& R, int& C) { const int st = b / 1024, sb = b % 1024, swz = sb ^ (((sb >> 9) & 1) << 5); R = (st >> 1) * 16 + swz / 64; C = (st & 1) * 32 + (swz % 64) / 2; }
__device__ __forceinline__ int perm32(int rho) { const int n = rho >> 4, i = rho & 15; return 8 * (i >> 2) + 4 * n + (i & 3); }

__device__ __forceinline__ const char* uni_ptr(const char* p) { const unsigned long long v = (unsigned long long)p; const unsigned lo = __builtin_amdgcn_readfirstlane((unsigned)v), hi = __builtin_amdgcn_readfirstlane((unsigned)(v >> 32)); return (const char*)(((unsigned long long)hi << 32) | lo); }
struct GUnit { int pm, pn; const char* A; const char* B; int ex; };
__device__ __forceinline__ bool tile_order(int i, int G, int c, int nM, int nN, int& pm, int& pn) {
    const int nwg = nM * nN; const long L = (long)i * G + c; if (L >= nwg) return false;
    int wgid = (int)L; { const int q = nwg / NXCD, r = nwg % NXCD, xcd = wgid % NXCD, off = wgid / NXCD; wgid = (xcd < r ? xcd * (q + 1) : r * (q + 1) + (xcd - r) * q) + off; }
    const int nig = WGM * nN, gid = wgid / nig, fm = gid * WGM, gsz = (nM - fm) < WGM ? (nM - fm) : WGM;
    pm = fm + ((wgid % nig) % gsz); pn = (wgid % nig) / gsz; return true;
}
struct DenseSched {
    int nM, nN, G, c; const char* A; const char* B; size_t astep, bstep;
    __device__ __forceinline__ bool next(int i, GUnit& u) const { if (!tile_order(i, G, c, nM, nN, u.pm, u.pn)) return false; u.A = A + (size_t)u.pm * astep; u.B = B + (size_t)u.pn * bstep; u.ex = 0; return true; }
};
struct GroupSched {
    int nM, nN, G, c; const char* A; const char* B; size_t astep, bstep; int acol_bytes, acol_shift;
    __device__ __forceinline__ bool next(int i, GUnit& u) const { if (!tile_order(i, G, c, nM, nN, u.pm, u.pn)) return false;
        u.A = A + (size_t)u.pm * astep + (size_t)(u.pn >> acol_shift) * acol_bytes; u.B = B + (size_t)u.pn * bstep; u.ex = 0; return true; }
};
struct MoeSched {
    int nM, nN, G, c; const char* A; const char* B; size_t astep, bstep, estep; int pend[NE];
    __device__ __forceinline__ bool next(int i, GUnit& u) const { if (!tile_order(i, G, c, nM, nN, u.pm, u.pn)) return false;
        int e = 0;
#pragma unroll
        for (int k = 0; k < NE - 1; ++k) e += (u.pm >= pend[k]) ? 1 : 0;
        u.ex = e; u.A = A + (size_t)u.pm * astep; u.B = B + (size_t)e * estep + (size_t)u.pn * bstep; return true; }
};

template <class Epi, class Sched>
__device__ __forceinline__ void gemm_phase(LAS unsigned char* lds, const int lda, const int nbr, const int K, const Sched& S, const Epi& E) {
    const int tid = threadIdx.x, wid = __builtin_amdgcn_readfirstlane(tid >> 6), lane = tid & 63, wr = wid >> 2, wc = wid & 3, fr = lane & 15, fq = lane >> 4;
    const int nt = K / BK;
    unsigned voffA[2], voffB[2];
#pragma unroll
    for (int i = 0; i < 2; ++i) { int R, C; stage_rc(tid * 16 + i * 8192, R, C); const int Rb = Epi::PERM ? ((R & ~31) + perm32(R & 31)) : R;
        voffA[i] = (unsigned)(R * lda + C) * 2u; voffB[i] = (unsigned)((C >> 3) * nbr + Rb) * 16u; }
    const size_t kstep = (size_t)(BK * 2);
    const size_t hstepA = (size_t)HALF * lda * 2, hstepB = (size_t)HALF * 16, kstepB = (size_t)nbr * 128;
    const unsigned ldsw = (unsigned)wid * 1024u;
    const int aoff = lds_byte(wr * 64 + fr, fq * 8), boff = lds_byte(wc * 32 + fr, fq * 8);
#define PG8_SA(b, h) (((b) * 2 + (h)) * HTB)
#define PG8_SB(b, h) ((4 + (b) * 2 + (h)) * HTB)
#define PG8_STAGE(bufoff, gbase, voff) do { _Pragma("unroll") for (int _i = 0; _i < 2; ++_i) \
        __builtin_amdgcn_global_load_lds((const unsigned*)((const char*)(gbase) + (voff)[_i]), (LAS unsigned*)(lds + (bufoff) + ldsw + _i * 8192), 16, 0, 0); } while (0)
#define PG8_LDA(dst, b, h) do { _Pragma("unroll") for (int m = 0; m < 4; ++m) _Pragma("unroll") for (int k = 0; k < 2; ++k) dst[m][k] = *(const LAS bf16x8*)(lds + PG8_SA(b, h) + aoff + m * 2048 + k * 1024); } while (0)
#define PG8_LDB(dst, b, h) do { _Pragma("unroll") for (int n = 0; n < 2; ++n) _Pragma("unroll") for (int k = 0; k < 2; ++k) dst[n][k] = *(const LAS bf16x8*)(lds + PG8_SB(b, h) + boff + n * 2048 + k * 1024); } while (0)
#define PG8_MMA(ai, bj, At, Bt) do { __builtin_amdgcn_s_setprio(1); _Pragma("unroll") for (int m = 0; m < 4; ++m) _Pragma("unroll") for (int n = 0; n < 2; ++n) _Pragma("unroll") for (int k = 0; k < 2; ++k) \
        acc[ai][bj][m][n] = __builtin_amdgcn_mfma_f32_16x16x32_bf16(Bt[n][k], At[m][k], acc[ai][bj][m][n], 0, 0, 0); __builtin_amdgcn_s_setprio(0); } while (0)
#define PG8_WAIT_V(n) asm volatile("s_waitcnt vmcnt(" #n ")" ::: "memory")
#define PG8_WAIT_L(n) asm volatile("s_waitcnt lgkmcnt(" #n ")" ::: "memory")
#define PG8_BAR __builtin_amdgcn_s_barrier()
#define PG8_SCHED __builtin_amdgcn_sched_barrier(0)
    GUnit cur, nxt; int ui = 0;
    if (!S.next(0, cur)) return;
    f32x4 acc[2][2][4][2];
#pragma unroll
    for (int a = 0; a < 2; ++a)
#pragma unroll
        for (int b = 0; b < 2; ++b)
#pragma unroll
            for (int m = 0; m < 4; ++m)
#pragma unroll
                for (int n = 0; n < 2; ++n) acc[a][b][m][n] = (f32x4){0.f, 0.f, 0.f, 0.f};
    bf16x8 At[4][2], B0[2][2], B1[2][2];
    const char* cA = uni_ptr(cur.A); const char* cB = uni_ptr(cur.B);
    PG8_STAGE(PG8_SB(0, 0), cB, voffB); PG8_STAGE(PG8_SB(0, 1), cB + hstepB, voffB); PG8_STAGE(PG8_SA(0, 0), cA, voffA); PG8_STAGE(PG8_SA(0, 1), cA + hstepA, voffA);
    if (wr == 1) PG8_BAR;
    PG8_WAIT_V(2); PG8_BAR;
    PG8_STAGE(PG8_SB(1, 0), cB + kstepB, voffB); PG8_STAGE(PG8_SA(1, 0), cA + kstep, voffA); PG8_STAGE(PG8_SB(1, 1), cB + hstepB + kstepB, voffB);
    PG8_WAIT_V(6); PG8_BAR;
    for (;;) {
        const bool has_next = S.next(ui + 1, nxt);
        const char* nA = has_next ? uni_ptr(nxt.A) : cA; const char* nB = has_next ? uni_ptr(nxt.B) : cB;
#pragma clang loop unroll(disable)
        for (int t = 0; t < nt; t += 2) {
            const bool last = (t == nt - 2);
            const char* a1 = cA + (size_t)(t + 1) * kstep;
            const char* a2 = last ? nA : cA + (size_t)(t + 2) * kstep; const char* b2 = last ? nB : cB + (size_t)(t + 2) * kstepB;
            const char* a3 = a2 + kstep; const char* b3 = b2 + kstepB;
            PG8_LDB(B0, 0, 0); PG8_LDB(B1, 0, 1); PG8_SCHED; PG8_LDA(At, 0, 0); PG8_STAGE(PG8_SA(1, 1), a1 + hstepA, voffA);
            PG8_WAIT_V(8); PG8_WAIT_L(0); PG8_BAR; PG8_MMA(0, 0, At, B0); PG8_MMA(0, 1, At, B1); PG8_BAR; PG8_SCHED;
            PG8_LDA(At, 0, 1); PG8_STAGE(PG8_SB(0, 0), b2, voffB); PG8_STAGE(PG8_SB(0, 1), b2 + hstepB, voffB); PG8_STAGE(PG8_SA(0, 0), a2, voffA);
            PG8_WAIT_V(8); PG8_WAIT_L(0); PG8_BAR; PG8_MMA(1, 0, At, B0); PG8_MMA(1, 1, At, B1); PG8_BAR; PG8_SCHED;
            PG8_LDB(B0, 1, 0); PG8_LDB(B1, 1, 1); PG8_SCHED; PG8_LDA(At, 1, 0); PG8_STAGE(PG8_SA(0, 1), a2 + hstepA, voffA);
            PG8_WAIT_V(8); PG8_WAIT_L(0); PG8_BAR; PG8_MMA(0, 0, At, B0); PG8_MMA(0, 1, At, B1); PG8_BAR; PG8_SCHED;
            PG8_LDA(At, 1, 1); PG8_STAGE(PG8_SB(1, 0), b3, voffB); PG8_STAGE(PG8_SB(1, 1), b3 + hstepB, voffB); PG8_STAGE(PG8_SA(1, 0), a3, voffA);
            PG8_WAIT_V(8); PG8_WAIT_L(0); PG8_BAR; PG8_MMA(1, 0, At, B0); PG8_MMA(1, 1, At, B1); PG8_BAR; PG8_SCHED;
        }
        if (wr == 0) PG8_BAR;
        E(acc, cur, wr, wc, fr, fq);
        if (!has_next) break;
#pragma unroll
        for (int a = 0; a < 2; ++a)
#pragma unroll
            for (int b = 0; b < 2; ++b)
#pragma unroll
                for (int m = 0; m < 4; ++m)
#pragma unroll
                    for (int n = 0; n < 2; ++n) acc[a][b][m][n] = (f32x4){0.f, 0.f, 0.f, 0.f};
        cur = nxt; cA = nA; cB = nB; ++ui;
        if (wr == 1) PG8_BAR;
    }
    PG8_WAIT_V(0);
    PG8_BAR;
#undef PG8_SA
#undef PG8_SB
#undef PG8_STAGE
#undef PG8_LDA
#undef PG8_LDB
#undef PG8_MMA
#undef PG8_WAIT_V
#undef PG8_WAIT_L
#undef PG8_BAR
#undef PG8_SCHED
}
typedef f32x4 AccT[2][2][4][2];
__device__ __forceinline__ void st_bf16x8(bf16_t* p, f32x4 v0, f32x4 v1) { u32x4 w; w.x = pk2(v0[0], v0[1]); w.y = pk2(v0[2], v0[3]); w.z = pk2(v1[0], v1[1]); w.w = pk2(v1[2], v1[3]); *(u32x4*)p = w; }
__device__ __forceinline__ void st_bf16x4(bf16_t* p, f32x4 v) { u32x2 w; w.x = pk2(v[0], v[1]); w.y = pk2(v[2], v[3]); *(u32x2*)p = w; }
__device__ __forceinline__ float sumsq4(f32x4 v) { return (v[0] * v[0] + v[1] * v[1]) + (v[2] * v[2] + v[3] * v[3]); }
__device__ __forceinline__ float red_fq(float s) { s += __shfl_xor(s, 16); s += __shfl_xor(s, 32); return s; }
__device__ __forceinline__ void rope_rot(f32x4& x1, f32x4& x2, const float* cs  ) {
    const f32x4 t0 = *(const f32x4*)cs, t1 = *(const f32x4*)(cs + 4);
    const f32x4 c = {t0[0], t0[2], t1[0], t1[2]}, s = {t0[1], t0[3], t1[1], t1[3]};
    const f32x4 y1 = x1 * c - x2 * s, y2 = x2 * c + x1 * s; x1 = y1; x2 = y2;
}

struct EpiLat {
    static constexpr bool PERM = true;
    bf16_t* lat; float* slot24; const float* ssq; bf16_t* kb; const float* rope;
    __device__ __forceinline__ void operator()(const AccT& acc, const GUnit& u, int wr, int wc, int fr, int fq) const {
#pragma unroll
        for (int ai = 0; ai < 2; ++ai)
#pragma unroll
            for (int m = 0; m < 4; ++m) { const int row = u.pm * BM + ai * HALF + wr * 64 + m * 16 + fr; const float rs = rstd16(ssq, row);
#pragma unroll
                for (int bj = 0; bj < 2; ++bj) { const int cb = u.pn * BM + bj * HALF + wc * 32;
                    f32x4 v0 = acc[ai][bj][m][0] * rs, v1 = acc[ai][bj][m][1] * rs;
                    if (cb < 640) { st_bf16x8(lat + (size_t)row * 768 + cb + 8 * fq, v0, v1);
                        const float ss = red_fq(sumsq4(v0) + sumsq4(v1)); if (fq == 0) slot24[(size_t)row * 24 + u.pn * 8 + bj * 4 + wc] = ss; }
                    else if (cb == 640) { rope_rot(v0, v1, rope + (size_t)row * 32 + 8 * fq);
                        u32x4 w; w.x = pk2(v0[0], v0[1]); w.y = pk2(v0[2], v0[3]); w.z = pk2(v1[0], v1[1]); w.w = pk2(v1[2], v1[3]);
                        bf16_t* kp = kb + (size_t)row * 1536 + 64 + 8 * fq;
#pragma unroll
                        for (int hh = 0; hh < NH; ++hh) *(u32x4*)(kp + hh * 96) = w; } } }
    }
};
struct EpiQ {
    static constexpr bool PERM = true;
    bf16_t* q; const float* slot24; const float* rope;
    __device__ __forceinline__ void operator()(const AccT& acc, const GUnit& u, int wr, int wc, int fr, int fq) const {
#pragma unroll
        for (int ai = 0; ai < 2; ++ai)
#pragma unroll
            for (int m = 0; m < 4; ++m) { const int row = u.pm * BM + ai * HALF + wr * 64 + m * 16 + fr;
                const f32x4* sp = (const f32x4*)(slot24 + (size_t)row * 24); const float ss = (hsum4(sp[0]) + hsum4(sp[1])) + hsum4(sp[2]);
                const float rs = 1.0f / sqrtf(ss * (1.0f / 384.0f) + RMS_EPS);
#pragma unroll
                for (int bj = 0; bj < 2; ++bj) { const int cb = u.pn * BM + bj * HALF + wc * 32; const int gb = cb >> 5;
                    f32x4 v0 = acc[ai][bj][m][0] * rs, v1 = acc[ai][bj][m][1] * rs;
                    if (gb % 3 == 2) rope_rot(v0, v1, rope + (size_t)row * 32 + 8 * fq);
                    st_bf16x8(q + (size_t)row * 1536 + cb + 8 * fq, v0, v1); } }
    }
};
struct EpiKV {
    static constexpr bool PERM = true;
    bf16_t* kb; bf16_t* vb; const float* slot24;
    __device__ __forceinline__ void operator()(const AccT& acc, const GUnit& u, int wr, int wc, int fr, int fq) const {
#pragma unroll
        for (int ai = 0; ai < 2; ++ai)
#pragma unroll
            for (int m = 0; m < 4; ++m) { const int row = u.pm * BM + ai * HALF + wr * 64 + m * 16 + fr;
                const f32x4* sp = (const f32x4*)(slot24 + (size_t)row * 24 + 12); const float ss = hsum4(sp[0]) + hsum4(sp[1]);
                const float rs = 1.0f / sqrtf(ss * (1.0f / 256.0f) + RMS_EPS);
#pragma unroll
                for (int bj = 0; bj < 2; ++bj) { const int head = u.pn * 2 + bj;
                    const f32x4 v0 = acc[ai][bj][m][0] * rs, v1 = acc[ai][bj][m][1] * rs;
                    bf16_t* p = (wc < 2) ? kb + (size_t)row * 1536 + head * 96 + wc * 32 + 8 * fq : vb + (size_t)row * 1024 + head * 64 + (wc - 2) * 32 + 8 * fq;
                    st_bf16x8(p, v0, v1); } }
    }
};
struct EpiRes {
    static constexpr bool PERM = false;
    const float* base; float* h; bf16_t* hb; float* ssq; const float* colscale;
    __device__ __forceinline__ void operator()(const AccT& acc, const GUnit& u, int wr, int wc, int fr, int fq) const {
#pragma unroll
        for (int ai = 0; ai < 2; ++ai)
#pragma unroll
            for (int m = 0; m < 4; ++m) { const int row = u.pm * BM + ai * HALF + wr * 64 + m * 16 + fr; float ss = 0.f;
#pragma unroll
                for (int bj = 0; bj < 2; ++bj)
#pragma unroll
                    for (int n = 0; n < 2; ++n) { const int col = u.pn * BM + bj * HALF + wc * 32 + n * 16 + 4 * fq; const size_t off = (size_t)row * D + col;
                        f32x4 a = acc[ai][bj][m][n]; if (colscale) a = a * *(const f32x4*)(colscale + col);
                        const f32x4 o = *(const f32x4*)(base + off) + a; *(f32x4*)(h + off) = o; st_bf16x4(hb + off, o); ss += sumsq4(o); }
                ss = red_fq(ss); if (fq == 0) ssq[(size_t)row * 16 + u.pn * 4 + wc] = ss; }
    }
};
template <bool MOE> struct EpiSwiglu {
    static constexpr bool PERM = true;
    bf16_t* act; const float* rowsrc; int var;
    __device__ __forceinline__ void operator()(const AccT& acc, const GUnit& u, int wr, int wc, int fr, int fq) const {
        if (var == 1) return;
#pragma unroll
        for (int ai = 0; ai < 2; ++ai)
#pragma unroll
            for (int m = 0; m < 4; ++m) { const int row = u.pm * BM + ai * HALF + wr * 64 + m * 16 + fr; const float rs = var == 2 ? 1.0f : (MOE ? rowsrc[row] : rstd16(rowsrc, row));
                f32x4 o[2];
#pragma unroll
                for (int n = 0; n < 2; ++n) { const f32x4 g = acc[ai][0][m][n] * rs, up = acc[ai][1][m][n] * rs;
#pragma unroll
                    for (int i = 0; i < 4; ++i) o[n][i] = silu_f(g[i]) * up[i]; }
                st_bf16x8(act + (size_t)row * FF + u.pn * HALF + wc * 32 + 8 * fq, o[0], o[1]); }
    }
};
struct EpiMoeDown {
    static constexpr bool PERM = true;
    bf16_t* out; const float* rowgate;
    __device__ __forceinline__ void operator()(const AccT& acc, const GUnit& u, int wr, int wc, int fr, int fq) const {
#pragma unroll
        for (int ai = 0; ai < 2; ++ai)
#pragma unroll
            for (int m = 0; m < 4; ++m) { const int row = u.pm * BM + ai * HALF + wr * 64 + m * 16 + fr; const float g = rowgate[row];
#pragma unroll
                for (int bj = 0; bj < 2; ++bj) st_bf16x8(out + (size_t)row * D + u.pn * BM + bj * HALF + wc * 32 + 8 * fq, acc[ai][bj][m][0] * g, acc[ai][bj][m][1] * g); }
    }
};
template <bool GELU0, bool GELU1> struct EpiSplit2 {
    static constexpr bool PERM = true;
    bf16_t* o0; bf16_t* o1; const float* ssq;
    __device__ __forceinline__ void operator()(const AccT& acc, const GUnit& u, int wr, int wc, int fr, int fq) const {
        const bool second = u.pn >= 4; bf16_t* ob = second ? o1 : o0; const int ct = (u.pn & 3) * BM; const bool gl = second ? GELU1 : GELU0;
#pragma unroll
        for (int ai = 0; ai < 2; ++ai)
#pragma unroll
            for (int m = 0; m < 4; ++m) { const int row = u.pm * BM + ai * HALF + wr * 64 + m * 16 + fr; const float rs = rstd16(ssq, row);
#pragma unroll
                for (int bj = 0; bj < 2; ++bj) { f32x4 v0 = acc[ai][bj][m][0] * rs, v1 = acc[ai][bj][m][1] * rs;
                    if (gl) {
#pragma unroll
                        for (int i = 0; i < 4; ++i) { v0[i] = gelu_tanh_f(v0[i]); v1[i] = gelu_tanh_f(v1[i]); } }
                    st_bf16x8(ob + (size_t)row * D + ct + bj * HALF + wc * 32 + 8 * fq, v0, v1); } }
    }
};
__device__ __forceinline__ float one_minus_exp(float x) {
    const float t = -x * (1.0f + x * (0.5f + x * (0.16666667f + x * (0.041666668f + x * (0.0083333338f + x * 0.0013888889f)))));
    const float e = 1.0f - fast_exp2(1.4426950408889634f * x); return x > -0.25f ? t : e;
}
struct EpiLruGate {
    static constexpr bool PERM = false;
    float* af; float* bf; const bf16_t* xcb; const float* ba; const float* bx; const float* sp8;
    __device__ __forceinline__ void operator()(const AccT& acc, const GUnit& u, int wr, int wc, int fr, int fq) const {
#pragma unroll
        for (int n = 0; n < 2; ++n) { const int c = u.pn * HALF + wc * 32 + n * 16 + 4 * fq;
            const f32x4 vba = *(const f32x4*)(ba + c), vbx = *(const f32x4*)(bx + c), vsp = *(const f32x4*)(sp8 + c);
#pragma unroll
            for (int ai = 0; ai < 2; ++ai)
#pragma unroll
                for (int m = 0; m < 4; ++m) { const int row = u.pm * BM + ai * HALF + wr * 64 + m * 16 + fr; const size_t off = (size_t)row * D + c;
                    const u32x2 xw = *(const u32x2*)(xcb + off); const f32x4 xc = {bflo(xw.x), bfhi(xw.x), bflo(xw.y), bfhi(xw.y)};
                    const f32x4 rp = acc[ai][0][m][n] + vba, ip = acc[ai][1][m][n] + vbx; f32x4 a, b;
#pragma unroll
                    for (int i = 0; i < 4; ++i) { const float la = -vsp[i] * sigmoid_f(rp[i]); a[i] = fast_exp2(1.4426950408889634f * la); b[i] = sqrtf(one_minus_exp(2.0f * la)) * (sigmoid_f(ip[i]) * xc[i]); }
                    *(f32x4*)(af + off) = a; *(f32x4*)(bf + off) = b; } }
    }
};
struct Args { const void* in[35]; float* out; unsigned char* ws; float* hsrc; int ph_lo, ph_hi; unsigned wmask, lmask; int nrep, pad; };
struct Frame {
    LAS unsigned char* lds; unsigned char* ws; const void* const* in; float* h;
    int tid, lane, wave, vcu, G, gw, NGW;
};
#define WSP(T, off) ((T*)(F.ws + (off)))
#define INF(i) ((const float*)F.in[i])

enum { MODE_ID = 0, MODE_GU = 1, MODE_ROPEQ = 2, MODE_ROPELAT = 3 };
struct Fam { const float* src; const float* g; bf16_t* dst; int Ksrc, Kdst, N, Npad, ldt, mode, row_off, ksrc_off; float scale; };
__device__ __forceinline__ int rope_pos(int d) { return 8 * ((d >> 2) & 3) + 4 * (d >> 4) + (d & 3); }
__device__ __forceinline__ int map_row(int mode, int n) {
    if (mode == MODE_GU) return ((n >> 7) << 8) + (n & 127);
    if (mode == MODE_ROPEQ) { const int head = n / 96, loc = n - head * 96; return loc >= 64 ? head * 96 + 64 + rope_pos(loc - 64) : n; }
    if (mode == MODE_ROPELAT) return (n >= 640 && n < 672) ? 640 + rope_pos(n - 640) : n;
    return n;
}
__device__ __forceinline__ void conv_item(const Fam& f, int item, int lane) {
    const int nblk = (f.Npad + 255) >> 8, kb = item / nblk, nb = item - kb * nblk, k0 = 16 * kb, n = nb * 256 + 4 * lane;
    f32x4 v[16];
#pragma unroll
    for (int r = 0; r < 16; ++r) { const int srow = k0 + r - f.ksrc_off; const bool okr = srow >= 0 && srow < f.Ksrc;
        v[r] = (f32x4){0.f, 0.f, 0.f, 0.f};
        if (okr && n < f.N) v[r] = *(const f32x4*)(f.src + (size_t)srow * f.N + n); }
#pragma unroll
    for (int r = 0; r < 16; ++r) { const int srow = k0 + r - f.ksrc_off; const float gk = (f.g && srow >= 0 && srow < f.Ksrc) ? f.g[srow] * f.scale : f.scale; v[r] = v[r] * gk; }
    if (n < f.Npad) {
        const int drow = map_row(f.mode, n) + f.row_off;
#pragma unroll
        for (int q = 0; q < 2; ++q) { bf16_t* dp = f.dst + ((size_t)(2 * kb + q) * f.ldt + drow) * 8;
#pragma unroll
            for (int j = 0; j < 4; ++j) { u32x4 o; o.x = pk2(v[8 * q + 0][j], v[8 * q + 1][j]); o.y = pk2(v[8 * q + 2][j], v[8 * q + 3][j]); o.z = pk2(v[8 * q + 4][j], v[8 * q + 5][j]); o.w = pk2(v[8 * q + 6][j], v[8 * q + 7][j]);
                *(u32x4*)(dp + 8 * j) = o; } } }
}
constexpr int NFAM = 17;
__device__ __forceinline__ int fam_count(int f) { return (f == 5 || f == 6) ? 8 : (f == 8) ? 4 : (f >= 11 && f <= 13) ? 2 : (f >= 14) ? 16 : 1; }
__device__ __forceinline__ Fam get_fam(const Frame& F, int f, int j) {
    Fam r; r.g = nullptr; r.mode = MODE_ID; r.row_off = 0; r.ksrc_off = 0; r.scale = 1.f;
    const float* norm_mix = INF(2); const float* norm_ffn = INF(3);
    switch (f) {
    case 0: r.src = INF(5); r.g = norm_mix; r.dst = WSP(bf16_t, W_MLA_IN); r.Ksrc = r.Kdst = 1024; r.N = 672; r.Npad = 768; r.ldt = 768; r.mode = MODE_ROPELAT; break;
    case 1: r.src = INF(8); r.g = INF(6); r.dst = WSP(bf16_t, W_UQ); r.Ksrc = r.Kdst = 384; r.N = r.Npad = 1536; r.ldt = 1536; r.mode = MODE_ROPEQ; r.scale = 0.10206207261596575f * 1.4426950408889634f; break;
    case 2: r.src = INF(9); r.g = INF(7); r.dst = WSP(bf16_t, W_UKV); r.Ksrc = r.Kdst = 256; r.N = r.Npad = 2048; r.ldt = 2048; break;
    case 3: r.src = INF(10); r.dst = WSP(bf16_t, W_O); r.Ksrc = r.Kdst = 1024; r.N = r.Npad = 1024; r.ldt = 1024; break;
    case 4: r.src = INF(11); r.g = norm_mix + 1024; r.dst = WSP(bf16_t, W_LRU_IN); r.Ksrc = r.Kdst = 1024; r.N = r.Npad = 2048; r.ldt = 2048; break;
    case 5: case 6: r.src = INF(f == 5 ? 14 : 16) + (size_t)j * 16384; r.dst = WSP(bf16_t, W_LRU_G) + (size_t)j * 65536; r.Ksrc = 128; r.Kdst = 256; r.N = r.Npad = 128; r.ldt = 256; r.row_off = (f == 6) ? 128 : 0; r.ksrc_off = (j & 1) * 128; break;
    case 7: r.src = INF(19); r.dst = WSP(bf16_t, W_LRU_OUT); r.Ksrc = r.Kdst = 1024; r.N = r.Npad = 1024; r.ldt = 1024; break;
    case 8: r.src = INF(20) + (size_t)j * 65536; r.dst = WSP(bf16_t, W_POOL) + (size_t)j * 65536; r.Ksrc = r.Kdst = 256; r.N = r.Npad = 256; r.ldt = 256; break;
    case 9: r.src = INF(22); r.g = norm_mix + 3072; r.dst = WSP(bf16_t, W_GM_IN); r.Ksrc = r.Kdst = 1024; r.N = r.Npad = 2048; r.ldt = 2048; break;
    case 10: r.src = INF(27); r.dst = WSP(bf16_t, W_GM_OUT); r.Ksrc = r.Kdst = 1024; r.N = r.Npad = 1024; r.ldt = 1024; break;
    case 11: case 12: r.src = INF(f == 11 ? 28 : 29) + (size_t)j * D * FF; r.g = norm_ffn + 2048 * j; r.dst = (bf16_t*)(F.ws + W_FFN + (size_t)j * 21 * MiB); r.Ksrc = r.Kdst = 1024; r.N = r.Npad = FF; r.ldt = 2 * FF; r.mode = MODE_GU; r.row_off = (f == 12) ? 128 : 0; break;
    case 13: r.src = INF(30) + (size_t)j * D * FF; r.dst = (bf16_t*)(F.ws + W_FFN + (size_t)j * 21 * MiB + 14 * MiB); r.Ksrc = r.Kdst = FF; r.N = r.Npad = 1024; r.ldt = 1024; break;
    case 14: case 15: r.src = INF(f == 14 ? 32 : 33) + (size_t)j * D * FF; r.g = norm_ffn + 1024 + 2048 * (j >> 3); r.dst = (bf16_t*)(F.ws + W_MOE + (size_t)j * 21 * MiB); r.Ksrc = r.Kdst = 1024; r.N = r.Npad = FF; r.ldt = 2 * FF; r.mode = MODE_GU; r.row_off = (f == 15) ? 128 : 0; break;
    default: r.src = INF(34) + (size_t)j * D * FF; r.dst = (bf16_t*)(F.ws + W_MOE + (size_t)j * 21 * MiB + 14 * MiB); r.Ksrc = r.Kdst = FF; r.N = r.Npad = 1024; r.ldt = 1024; break;
    }
    return r;
}
__device__ __forceinline__ void stats_row(const Frame& F, const float* src, int row, float* rstd_out) {
    const f32x4* xr = (const f32x4*)(src + (size_t)row * D) + F.lane; f32x4 v[4]; float s = 0.f;
#pragma unroll
    for (int j = 0; j < 4; ++j) { v[j] = xr[64 * j]; s += sumsq4(v[j]); }
    s = wave_sum(s);
    bf16_t* hb = WSP(bf16_t, WS_HB) + (size_t)row * D + 4 * F.lane;
#pragma unroll
    for (int j = 0; j < 4; ++j) st_bf16x4(hb + 256 * j, v[j]);
    if (F.lane < 16) WSP(float, WS_SSQ)[(size_t)row * 16 + F.lane] = F.lane == 0 ? s : 0.f;
    if (rstd_out && F.lane == 0) rstd_out[row] = 1.0f / sqrtf(s * (1.0f / 1024.0f) + RMS_EPS);
}
__device__ __forceinline__ void phase_prologue(const Frame& F, unsigned wmask, unsigned lmask, const float* hsrc) {
    int base = 0;
    for (int f = 0; f < NFAM; ++f) { if (!((wmask >> f) & 1u)) continue;
        const int cnt = fam_count(f);
        for (int j = 0; j < cnt; ++j) {
            if (f >= 11 && f <= 13 && !((lmask >> j) & 1u)) continue;
            if (f >= 14 && !((lmask >> (2 + (j >> 3))) & 1u)) continue;
            const Fam fm = get_fam(F, f, j); const int nitems = (fm.Kdst / 16) * ((fm.Npad + 255) >> 8);
            for (int it = (F.gw + F.NGW - base % F.NGW) % F.NGW; it < nitems; it += F.NGW) conv_item(fm, it, F.lane);
            base += nitems; } }
    const int gt = F.vcu * NTHR + F.tid, NT = F.G * NTHR;
    if ((wmask >> 17) & 1u) {
        for (int i = gt; i < M * 16; i += NT) { const int row = i >> 4, j = i & 15; const float inv = powf(10000.0f, -(float)j / 16.0f); const float ang = (float)((const int*)F.in[1])[row] * inv;
            WSP(float, WS_ROPE)[2 * i] = cosf(ang); WSP(float, WS_ROPE)[2 * i + 1] = sinf(ang); }
        for (int i = gt; i < D; i += NT) WSP(float, WS_SP8)[i] = 8.0f * log1pf(expf(-INF(18)[i]));
        for (int i = gt; i < 2 * D * NE; i += NT) { const int l = i / (D * NE), c = (i / NE) % D; WSP(float, WS_ROUTW)[i] = INF(3)[(1 + 2 * l) * D + c] * INF(31)[i]; }
        for (int i = gt; i < 4 * 128 * 128; i += NT) { const int t = (i >> 7) & 127, s = i & 127; WSP(bf16_t, W_GM_S)[i] = (bf16_t)(pk2(s <= t ? INF(25)[i] : 0.f, 0.f) & 0xffffu); }
    }
    if (hsrc) for (int row = F.gw; row < M; row += F.NGW) stats_row(F, hsrc, row, WSP(float, WS_RSTD));
}

__device__ __forceinline__ void phase_conv(const Frame& F) {
    const bf16_t* xbr = WSP(bf16_t, B_XBR); bf16_t* xcb = WSP(bf16_t, B_XCB); const float* cw = INF(12); const float* cb = INF(13);
    const int gt = F.vcu * NTHR + F.tid, NT = F.G * NTHR;
    for (int i = gt; i < M * (D / 8); i += NT) { const int row = i >> 7, c = (i & 127) * 8, t = row & (S - 1);
        float acc[8];
#pragma unroll
        for (int k = 0; k < 8; ++k) acc[k] = cb[c + k];
#pragma unroll
        for (int j = 0; j < 4; ++j) { if (t - 3 + j >= 0) { const u32x4 w = *(const u32x4*)(xbr + (size_t)(row - 3 + j) * D + c); const float* wj = cw + j * D + c;
            acc[0] += wj[0] * bflo(w.x); acc[1] += wj[1] * bfhi(w.x); acc[2] += wj[2] * bflo(w.y); acc[3] += wj[3] * bfhi(w.y);
            acc[4] += wj[4] * bflo(w.z); acc[5] += wj[5] * bfhi(w.z); acc[6] += wj[6] * bflo(w.w); acc[7] += wj[7] * bfhi(w.w); } }
        u32x4 o; o.x = pk2(acc[0], acc[1]); o.y = pk2(acc[2], acc[3]); o.z = pk2(acc[4], acc[5]); o.w = pk2(acc[6], acc[7]);
        *(u32x4*)(xcb + (size_t)row * D + c) = o; }
}
__device__ __forceinline__ void phase_scan1(const Frame& F) {
    const float* af = WSP(float, B_AF); const float* bf = WSP(float, B_BF); f32x2* carry = WSP(f32x2, WS_CARRY);
    const int gt = F.vcu * NTHR + F.tid, NT = F.G * NTHR;
    for (int i = gt; i < NB * 64 * D; i += NT) { const int c = i & (D - 1), ch = (i >> 10) & 63, b = i >> 16; const size_t r0 = ((size_t)b * S + ch * 64) * D + c;
        float A = 1.f, H = 0.f;
#pragma unroll 8
        for (int t = 0; t < 64; ++t) { const float a = af[r0 + (size_t)t * D], bb = bf[r0 + (size_t)t * D]; A *= a; H = a * H + bb; }
        carry[i] = (f32x2){A, H}; }
}
__device__ __forceinline__ void phase_scan2(const Frame& F) {
    const float* af = WSP(float, B_AF); const float* bf = WSP(float, B_BF); const f32x2* carry = WSP(f32x2, WS_CARRY);
    const bf16_t* gate = WSP(bf16_t, B_GATEB); bf16_t* yb = WSP(bf16_t, B_YB);
    const int gt = F.vcu * NTHR + F.tid, NT = F.G * NTHR;
    for (int i = gt; i < NB * 64 * D; i += NT) { const int c = i & (D - 1), ch = (i >> 10) & 63, b = i >> 16; const size_t r0 = ((size_t)b * S + ch * 64) * D + c;
        float H = 0.f;
        for (int k = 0; k < ch; ++k) { const f32x2 cv = carry[(b * 64 + k) * D + c]; H = cv.x * H + cv.y; }
#pragma unroll 8
        for (int t = 0; t < 64; ++t) { const size_t o = r0 + (size_t)t * D; H = af[o] * H + bf[o]; yb[o] = (bf16_t)(pk2(H * bf2f(gate[o]), 0.f) & 0xffffu); } }
}
__device__ __forceinline__ void phase_router(const Frame& F, int l) {
    const float* rw = WSP(float, WS_ROUTW) + (size_t)l * D * NE; const float* h = F.h;
    LAS int* se = (LAS int*)F.lds;
    unsigned* gcnt = WSP(unsigned, WS_CTL) + CW_MOECNT + 64 * l;
    const int tpw = (M + F.G - 1) / F.G;
    const int t0 = (int)blockIdx.x * tpw;
    for (int k = F.wave; k < tpw; k += NWAVES) { const int tok = t0 + k; if (tok >= M) break;
        float s[8];
#pragma unroll
        for (int e = 0; e < 8; ++e) s[e] = 0.f;
        float ss = 0.f;
#pragma unroll
        for (int j = 0; j < 4; ++j) { const int c0 = 256 * j + 4 * F.lane; const f32x4 x = *(const f32x4*)(h + (size_t)tok * D + c0); ss += sumsq4(x);
#pragma unroll
            for (int i = 0; i < 4; ++i) { const f32x4 w0 = *(const f32x4*)(rw + (size_t)(c0 + i) * 8), w1 = *(const f32x4*)(rw + (size_t)(c0 + i) * 8 + 4);
                s[0] += x[i] * w0[0]; s[1] += x[i] * w0[1]; s[2] += x[i] * w0[2]; s[3] += x[i] * w0[3]; s[4] += x[i] * w1[0]; s[5] += x[i] * w1[1]; s[6] += x[i] * w1[2]; s[7] += x[i] * w1[3]; } }
        ss = wave_sum(ss);
#pragma unroll
        for (int e = 0; e < 8; ++e) s[e] = wave_sum(s[e]);
        const float rs = 1.0f / sqrtf(ss * (1.0f / 1024.0f) + RMS_EPS);
        int e1 = 0; float v1 = s[0];
#pragma unroll
        for (int e = 1; e < 8; ++e) if (s[e] > v1) { v1 = s[e]; e1 = e; }
        int e2 = 0; float v2 = -INFINITY;
#pragma unroll
        for (int e = 0; e < 8; ++e) if (e != e1 && s[e] > v2) { v2 = s[e]; e2 = e; }
        const float g1 = 1.0f / (1.0f + expf((v2 - v1) * rs));
        if (F.lane == 0) { se[2 * k] = e1; se[2 * k + 1] = e2; WSP(f32x2, WS_TOKG)[tok] = (f32x2){g1, 1.0f - g1}; WSP(float, WS_RSTD)[tok] = rs; }
    }
    __syncthreads();
    if (F.wave == 0) { const int tok = t0 + F.lane; const bool valid = F.lane < tpw && tok < M;
        const int e1 = valid ? se[2 * F.lane] : -1, e2 = valid ? se[2 * F.lane + 1] : -1; int lr1 = 0, lr2 = 0;
        const unsigned long long lt = (1ull << F.lane) - 1ull;
#pragma unroll
        for (int e = 0; e < 8; ++e) { const unsigned long long m1 = __ballot(e1 == e), m2 = __ballot(e2 == e);
            const int before = __popcll(m1 & lt) + __popcll(m2 & lt); if (e1 == e) lr1 = before; if (e2 == e) lr2 = before;
            const int tot = __popcll(m1) + __popcll(m2);
            if (F.lane == e) { const unsigned bs = tot ? __hip_atomic_fetch_add(gcnt + e, (unsigned)tot, __ATOMIC_RELAXED, __HIP_MEMORY_SCOPE_AGENT) : 0u; WSP(int, WS_WGBASE)[blockIdx.x * 8 + e] = (int)bs; } }
        if (valid) { int* ti = WSP(int, WS_TOKINFO) + 4 * (size_t)tok; ti[0] = e1; ti[1] = lr1; ti[2] = e2; ti[3] = lr2; }
    }
    __syncthreads();
}
__device__ __forceinline__ int moe_layout(const Frame& F, int l, int* pstart_rows, int* pend) {
    const unsigned* gcnt = WSP(unsigned, WS_CTL) + CW_MOECNT + 64 * l; int p = 0;
#pragma unroll
    for (int e = 0; e < NE; ++e) { const int c = (int)__hip_atomic_load(gcnt + e, __ATOMIC_RELAXED, __HIP_MEMORY_SCOPE_AGENT); pstart_rows[e] = p * 256; p += (c + 255) >> 8; pend[e] = p; }
    return p;
}
__device__ __forceinline__ void phase_gather(const Frame& F, int l) {
    int ps[NE], pe[NE]; (void)moe_layout(F, l, ps, pe);
    const int tpw = (M + F.G - 1) / F.G;
    const bf16_t* hb = WSP(bf16_t, WS_HB); bf16_t* xg = WSP(bf16_t, B_XG);
    for (int tok = F.gw; tok < M; tok += F.NGW) { const int wg = tok / tpw;
        const int* ti = WSP(int, WS_TOKINFO) + 4 * (size_t)tok; const int e1 = ti[0], lr1 = ti[1], e2 = ti[2], lr2 = ti[3];
        int d1 = 0, d2 = 0;
#pragma unroll
        for (int e = 0; e < NE; ++e) { const int b = WSP(int, WS_WGBASE)[wg * 8 + e]; if (e == e1) d1 = ps[e] + b + lr1; if (e == e2) d2 = ps[e] + b + lr2; }
        const u32x4* src = (const u32x4*)(hb + (size_t)tok * D) + F.lane; const u32x4 a = src[0], b = src[64];
        u32x4* o1 = (u32x4*)(xg + (size_t)d1 * D) + F.lane; u32x4* o2 = (u32x4*)(xg + (size_t)d2 * D) + F.lane; o1[0] = a; o1[64] = b; o2[0] = a; o2[64] = b;
        if (F.lane == 0) { const f32x2 g = WSP(f32x2, WS_TOKG)[tok]; const float rs = WSP(float, WS_RSTD)[tok];
            WSP(float, WS_ROWSCALE)[d1] = rs; WSP(float, WS_ROWSCALE)[d2] = rs; WSP(float, WS_ROWGATE)[d1] = g.x; WSP(float, WS_ROWGATE)[d2] = g.y;
            WSP(int, WS_DEST)[2 * tok] = d1; WSP(int, WS_DEST)[2 * tok + 1] = d2; }
    }
}
template <bool FINAL> __device__ __forceinline__ void phase_combine(const Frame& F) {
    const bf16_t* om = WSP(bf16_t, B_OUTM); const float* gfin = INF(4);
    for (int tok = F.gw; tok < M; tok += F.NGW) {
        const int* ti = WSP(int, WS_TOKINFO) + 4 * (size_t)tok; const int e1 = ti[0], e2 = ti[2]; int d1 = WSP(int, WS_DEST)[2 * tok], d2 = WSP(int, WS_DEST)[2 * tok + 1];
        if (e2 < e1) { const int t = d1; d1 = d2; d2 = t; }
        f32x4 v[4]; float s = 0.f;
#pragma unroll
        for (int j = 0; j < 4; ++j) { const int c = 256 * j + 4 * F.lane; const f32x4 x = *(const f32x4*)(F.h + (size_t)tok * D + c);
            const u32x2 a = *(const u32x2*)(om + (size_t)d1 * D + c), b = *(const u32x2*)(om + (size_t)d2 * D + c);
            const f32x4 y = (f32x4){bflo(a.x), bfhi(a.x), bflo(a.y), bfhi(a.y)} + (f32x4){bflo(b.x), bfhi(b.x), bflo(b.y), bfhi(b.y)};
            v[j] = x + y; s += sumsq4(v[j]); }
        s = wave_sum(s); const float rs = 1.0f / sqrtf(s * (1.0f / 1024.0f) + RMS_EPS);
        if (FINAL) {
#pragma unroll
            for (int j = 0; j < 4; ++j) { const int c = 256 * j + 4 * F.lane; *(f32x4*)(F.h + (size_t)tok * D + c) = v[j] * rs * *(const f32x4*)(gfin + c); }
        } else {
#pragma unroll
            for (int j = 0; j < 4; ++j) { const int c = 256 * j + 4 * F.lane; *(f32x4*)(F.h + (size_t)tok * D + c) = v[j]; st_bf16x4(WSP(bf16_t, WS_HB) + (size_t)tok * D + c, v[j]); }
            if (F.lane < 16) WSP(float, WS_SSQ)[(size_t)tok * 16 + F.lane] = F.lane == 0 ? s : 0.f;
            if (F.lane == 0) WSP(float, WS_RSTD)[tok] = rs;
        }
    }
}
__device__ __forceinline__ void phase_pool(const Frame& F) {
    const float* rstd = WSP(float, WS_RSTD); const float* g = INF(2) + 2 * D; bf16_t* po = WSP(bf16_t, B_POOLED);
    const int gt = F.vcu * NTHR + F.tid, NT = F.G * NTHR;
    for (int i = gt; i < (M / 32) * (D / 4); i += NT) { const int c = (i & 255) * 4, rb = (i >> 8) * 32, t0 = rb & (S - 1); const int w = 2 << (c >> 8);
        const f32x4 gv = *(const f32x4*)(g + c); f32x4 sum = {0.f, 0.f, 0.f, 0.f};
        const int warm = t0 < w - 1 ? t0 : w - 1;
        for (int k = warm; k >= 1; --k) sum += *(const f32x4*)(F.h + (size_t)(rb - k) * D + c) * rstd[rb - k];
        for (int r = 0; r < 32; ++r) { const int row = rb + r, t = t0 + r;
            const f32x4 self = *(const f32x4*)(F.h + (size_t)row * D + c) * rstd[row]; sum += self;
            const int n = t + 1 < w ? t + 1 : w;
            const f32x4 o = (sum * (1.0f / (float)n) - self) * gv; st_bf16x4(po + (size_t)row * D + c, o);
            if (t + 1 >= w) sum -= *(const f32x4*)(F.h + (size_t)(row - w + 1) * D + c) * rstd[row - w + 1]; }
    }
}
typedef short v4i16_t __attribute__((ext_vector_type(4)));
__device__ __forceinline__ int crow(int r, int hi) { return (r & 3) + 8 * (r >> 2) + 4 * hi; }
__device__ __forceinline__ s16x4 vtr(const LAS unsigned char* p) { return __builtin_bit_cast(s16x4, __builtin_amdgcn_ds_read_tr16_b64_v4i16((LAS v4i16_t*)p)); }
__device__ __forceinline__ bf16x8 pack8(const f32x16& p, int b) { u32x4 w; w.x = pk2(p[b], p[b + 1]); w.y = pk2(p[b + 2], p[b + 3]); w.z = pk2(p[b + 4], p[b + 5]); w.w = pk2(p[b + 6], p[b + 7]); return __builtin_bit_cast(bf16x8, w); }
constexpr int AT_KROW = 208, AT_KBYTES = 64 * AT_KROW, AT_BUF = AT_KBYTES + 8192, AT_WSF = 2 * AT_BUF;
__device__ __forceinline__ void attn_unit(const Frame& F, int bh, int qb) {
    const int b = bh >> 4, h = bh & 15, lane = F.lane, r = lane & 31, hh = lane >> 5, wid = F.wave, tid = F.tid;
    const bf16_t* Q = WSP(bf16_t, B_Q); const bf16_t* KB = WSP(bf16_t, B_KB); const bf16_t* VB = WSP(bf16_t, B_VB); bf16_t* OB = WSP(bf16_t, B_OB);
    const size_t rowbase = (size_t)b * S; const int q0 = qb * 256; const int qrow = q0 + 32 * wid + r;
    bf16x8 qf[6];
    { const bf16_t* qp = Q + (rowbase + qrow) * 1536 + h * 96 + 8 * hh;
#pragma unroll
      for (int ks = 0; ks < 6; ++ks) qf[ks] = *(const bf16x8*)(qp + 16 * ks); }
    const int NT = 4 * (qb + 1);
    const int krow0 = tid / 12, kch0 = tid - krow0 * 12, idx1 = 512 + tid, krow1 = idx1 / 12, kch1 = idx1 - krow1 * 12; const bool has1 = tid < 256;
    const int vrow = tid >> 3, vch = tid & 7;
    const bf16_t* kp0 = KB + (rowbase + krow0) * 1536 + h * 96 + 8 * kch0; const bf16_t* kp1 = KB + (rowbase + krow1) * 1536 + h * 96 + 8 * kch1;
    const bf16_t* vp = VB + (rowbase + vrow) * 1024 + h * 64 + 8 * vch;
    const int kd0 = krow0 * AT_KROW + kch0 * 16, kd1 = krow1 * AT_KROW + kch1 * 16, vd = AT_KBYTES + (vch >> 2) * 4096 + vrow * 64 + (vch & 3) * 16;
    LAS unsigned char* lds = F.lds; LAS float* wsf = (LAS float*)(lds + AT_WSF) + wid * 64;
    u32x4 rk0, rk1 = {0u, 0u, 0u, 0u}, rv;
    rk0 = *(const u32x4*)kp0; if (has1) rk1 = *(const u32x4*)kp1; rv = *(const u32x4*)vp;
    *(LAS u32x4*)(lds + kd0) = rk0; if (has1) *(LAS u32x4*)(lds + kd1) = rk1; *(LAS u32x4*)(lds + vd) = rv;
    __syncthreads();
    f32x16 o0, o1;
#pragma unroll
    for (int i = 0; i < 16; ++i) { o0[i] = 0.f; o1[i] = 0.f; }
    float mrun = -INFINITY, lrun = 0.f;
    const int kfrag = r * AT_KROW + hh * 16;
    const int vfrag = AT_KBYTES + ((lane >> 4) & 1) * 32 + (lane & 3) * 8 + (4 * hh + ((lane & 15) >> 2)) * 64;
    for (int t = 0; t < NT; ++t) {
        const int bo = (t & 1) * AT_BUF, bn = ((t + 1) & 1) * AT_BUF; const bool pre = t + 1 < NT;
        if (pre) { const size_t ko = (size_t)(t + 1) * 64 * 1536, vo = (size_t)(t + 1) * 64 * 1024; rk0 = *(const u32x4*)(kp0 + ko); if (has1) rk1 = *(const u32x4*)(kp1 + ko); rv = *(const u32x4*)(vp + vo); }
        if (t * 64 <= q0 + 32 * wid + 31) {
            f32x16 p0, p1;
#pragma unroll
            for (int i = 0; i < 16; ++i) { p0[i] = 0.f; p1[i] = 0.f; }
#pragma unroll
            for (int ks = 0; ks < 6; ++ks) { const bf16x8 a0 = *(const LAS bf16x8*)(lds + bo + kfrag + ks * 32), a1 = *(const LAS bf16x8*)(lds + bo + kfrag + 32 * AT_KROW + ks * 32);
                p0 = __builtin_amdgcn_mfma_f32_32x32x16_bf16(a0, qf[ks], p0, 0, 0, 0); p1 = __builtin_amdgcn_mfma_f32_32x32x16_bf16(a1, qf[ks], p1, 0, 0, 0); }
            if (t >= NT - 4) { const int kb0 = t * 64;
#pragma unroll
                for (int i = 0; i < 16; ++i) { const int kv = kb0 + crow(i, hh); if (kv > qrow) p0[i] = -INFINITY; if (kv + 32 > qrow) p1[i] = -INFINITY; } }
            float mx = fmaxf(p0[0], p1[0]);
#pragma unroll
            for (int i = 1; i < 16; ++i) mx = fmaxf(mx, fmaxf(p0[i], p1[i]));
            mx = fmaxf(mx, __shfl_xor(mx, 32));
            if (__any(mx > mrun)) { const float mn = fmaxf(mrun, mx); const float alpha = fast_exp2(mrun - mn); mrun = mn; lrun *= alpha;
                if (hh == 0) wsf[r] = alpha;
#pragma unroll
                for (int i = 0; i < 16; ++i) { const float al = wsf[crow(i, hh)]; o0[i] *= al; o1[i] *= al; } }
            float ls = 0.f;
#pragma unroll
            for (int i = 0; i < 16; ++i) { p0[i] = fast_exp2(p0[i] - mrun); p1[i] = fast_exp2(p1[i] - mrun); ls += p0[i] + p1[i]; }
            lrun += ls;
            const bf16x8 pa0 = pack8(p0, 0), pa1 = pack8(p0, 8), pa2 = pack8(p1, 0), pa3 = pack8(p1, 8);
            const LAS unsigned char* vb = lds + bo + vfrag;
#define AT_PV(o, d0) do { \
            { const s16x4 lo = vtr(vb + d0 * 4096 + 0 * 1024), hi = vtr(vb + d0 * 4096 + 0 * 1024 + 512); o = __builtin_amdgcn_mfma_f32_32x32x16_bf16(pa0, (bf16x8){lo[0], lo[1], lo[2], lo[3], hi[0], hi[1], hi[2], hi[3]}, o, 0, 0, 0); } \
            { const s16x4 lo = vtr(vb + d0 * 4096 + 1 * 1024), hi = vtr(vb + d0 * 4096 + 1 * 1024 + 512); o = __builtin_amdgcn_mfma_f32_32x32x16_bf16(pa1, (bf16x8){lo[0], lo[1], lo[2], lo[3], hi[0], hi[1], hi[2], hi[3]}, o, 0, 0, 0); } \
            { const s16x4 lo = vtr(vb + d0 * 4096 + 2 * 1024), hi = vtr(vb + d0 * 4096 + 2 * 1024 + 512); o = __builtin_amdgcn_mfma_f32_32x32x16_bf16(pa2, (bf16x8){lo[0], lo[1], lo[2], lo[3], hi[0], hi[1], hi[2], hi[3]}, o, 0, 0, 0); } \
            { const s16x4 lo = vtr(vb + d0 * 4096 + 3 * 1024), hi = vtr(vb + d0 * 4096 + 3 * 1024 + 512); o = __builtin_amdgcn_mfma_f32_32x32x16_bf16(pa3, (bf16x8){lo[0], lo[1], lo[2], lo[3], hi[0], hi[1], hi[2], hi[3]}, o, 0, 0, 0); } } while (0)
            AT_PV(o0, 0); AT_PV(o1, 1);
#undef AT_PV
        }
        if (pre) { *(LAS u32x4*)(lds + bn + kd0) = rk0; if (has1) *(LAS u32x4*)(lds + bn + kd1) = rk1; *(LAS u32x4*)(lds + bn + vd) = rv; }
        __syncthreads();
    }
    lrun += __shfl_xor(lrun, 32);
    if (hh == 0) wsf[32 + r] = lrun;
    bf16_t* op = OB + (rowbase + q0 + 32 * wid) * 1024 + h * 64 + r;
#pragma unroll
    for (int i = 0; i < 16; ++i) { const int qr = crow(i, hh); const float rl = fast_rcp(wsf[32 + qr]);
        op[(size_t)qr * 1024] = (bf16_t)(pk2(o0[i] * rl, 0.f) & 0xffffu); op[(size_t)qr * 1024 + 32] = (bf16_t)(pk2(o1[i] * rl, 0.f) & 0xffffu); }
    __syncthreads();
}
__device__ __forceinline__ void phase_attn(const Frame& F) {
    for (int pi = F.vcu; pi < 512; pi += F.G) { const int bh = pi >> 3, j = pi & 7; attn_unit(F, bh, j); attn_unit(F, bh, 15 - j); }
}

__device__ __forceinline__ void gmlp_unit(const Frame& F, int chunk, int g) {
    const int lane = F.lane, wid = F.wave, tid = F.tid, r = lane & 31, hh = lane >> 5;
    const bf16_t* vsrc = WSP(bf16_t, B_VB2); const bf16_t* usrc = WSP(bf16_t, B_UB); bf16_t* uv = WSP(bf16_t, B_UVB); const bf16_t* wsb = WSP(bf16_t, W_GM_S) + (size_t)g * 16384;
    const float* lng = INF(23); const float* lnb = INF(24); const float* bs = INF(26) + g * 128;
    LAS unsigned char* lds = F.lds; LAS f32x2* stat = (LAS f32x2*)(lds + 65536);
    const size_t row0 = (size_t)chunk * 128;
    for (int k = 0; k < 16; ++k) { const int rr = wid * 16 + k; const u32x4* p = (const u32x4*)(vsrc + (row0 + rr) * D) + lane; const u32x4 a = p[0], b2 = p[64];
        float x[16]; x[0] = bflo(a.x); x[1] = bfhi(a.x); x[2] = bflo(a.y); x[3] = bfhi(a.y); x[4] = bflo(a.z); x[5] = bfhi(a.z); x[6] = bflo(a.w); x[7] = bfhi(a.w);
        x[8] = bflo(b2.x); x[9] = bfhi(b2.x); x[10] = bflo(b2.y); x[11] = bfhi(b2.y); x[12] = bflo(b2.z); x[13] = bfhi(b2.z); x[14] = bflo(b2.w); x[15] = bfhi(b2.w);
        float s = 0.f;
#pragma unroll
        for (int i = 0; i < 16; ++i) s += x[i];
        const float mu = wave_sum(s) * (1.0f / 1024.0f); float q = 0.f;
#pragma unroll
        for (int i = 0; i < 16; ++i) { const float d = x[i] - mu; q += d * d; }
        const float var = wave_sum(q) * (1.0f / 1024.0f);
        if (lane == 0) stat[rr] = (f32x2){mu, 1.0f / sqrtf(var + LN_EPS)}; }
    __syncthreads();
#pragma unroll
    for (int k = 0; k < 8; ++k) { const int idx = tid + k * NTHR, s = idx >> 5, ch = idx & 31, c = g * 256 + ch * 8;
        const u32x4 w = *(const u32x4*)(vsrc + (row0 + s) * D + c); const f32x2 st = stat[s];
        const f32x4 g0 = *(const f32x4*)(lng + c), g1 = *(const f32x4*)(lng + c + 4), b0 = *(const f32x4*)(lnb + c), b1 = *(const f32x4*)(lnb + c + 4);
        f32x4 v0 = {bflo(w.x), bfhi(w.x), bflo(w.y), bfhi(w.y)}, v1 = {bflo(w.z), bfhi(w.z), bflo(w.w), bfhi(w.w)};
        v0 = (v0 - st.x) * st.y * g0 + b0; v1 = (v1 - st.x) * st.y * g1 + b1;
        u32x4 o; o.x = pk2(v0[0], v0[1]); o.y = pk2(v0[2], v0[3]); o.z = pk2(v1[0], v1[1]); o.w = pk2(v1[2], v1[3]);
        *(LAS u32x4*)(lds + (ch >> 2) * 8192 + s * 64 + (ch & 3) * 16) = o; }
    __syncthreads();
    bf16x8 bfr[8];
    { const LAS unsigned char* vb = lds + wid * 8192 + ((lane >> 4) & 1) * 32 + (lane & 3) * 8 + (8 * hh + ((lane & 15) >> 2)) * 64;
#pragma unroll
      for (int ks = 0; ks < 8; ++ks) { const s16x4 lo = vtr(vb + ks * 1024), hi = vtr(vb + ks * 1024 + 256); bfr[ks] = (bf16x8){lo[0], lo[1], lo[2], lo[3], hi[0], hi[1], hi[2], hi[3]}; } }
    const int cg = g * 256 + wid * 32 + r;
#pragma unroll
    for (int mt = 0; mt < 4; ++mt) { f32x16 acc;
#pragma unroll
        for (int i = 0; i < 16; ++i) acc[i] = 0.f;
        const bf16_t* wp = wsb + (size_t)(32 * mt + r) * 128 + 8 * hh;
#pragma unroll
        for (int ks = 0; ks < 8; ++ks) if (ks <= 2 * mt + 1) { const bf16x8 a = *(const bf16x8*)(wp + 16 * ks); acc = __builtin_amdgcn_mfma_f32_32x32x16_bf16(a, bfr[ks], acc, 0, 0, 0); }
#pragma unroll
        for (int i = 0; i < 16; ++i) { const int t = 32 * mt + crow(i, hh); const size_t off = (row0 + t) * D + cg;
            const float v2 = acc[i] + bs[t]; uv[off] = (bf16_t)(pk2(bf2f(usrc[off]) * v2, 0.f) & 0xffffu); } }
    __syncthreads();
}
__device__ __forceinline__ void phase_gmlp(const Frame& F) { for (int u = F.vcu; u < 512; u += F.G) gmlp_unit(F, u >> 2, u & 3); }
constexpr int PH_PRO = 0, PH_LAT = 1, PH_QKV = 2, PH_ATTN = 3, PH_WO = 4, PH_FUP0 = 5, PH_FDN0 = 6, PH_LIN = 7, PH_CONV = 8, PH_LGATE = 9, PH_SCAN1 = 10, PH_SCAN2 = 11, PH_LOUT = 12,
              PH_ROUT0 = 13, PH_GATH0 = 14, PH_MUP0 = 15, PH_MDN0 = 16, PH_COMB0 = 17, PH_POOL = 18, PH_PGEMM = 19, PH_FUP1 = 20, PH_FDN1 = 21, PH_GIN = 22, PH_GGATE = 23, PH_GOUT = 24,
              PH_ROUT1 = 25, PH_GATH1 = 26, PH_MUP1 = 27, PH_MDN1 = 28, PH_FINAL = 29, PH_N = 30;

__device__ __forceinline__ DenseSched dense_sched(const Frame& F, const void* A, int lda, const void* B, int ldb, int nM, int nN) {
    DenseSched s; s.nM = nM; s.nN = nN; s.G = F.G; s.c = (int)blockIdx.x; s.A = (const char*)A; s.B = (const char*)B; s.astep = (size_t)256 * lda * 2; s.bstep = (size_t)256 * 16; (void)ldb; return s;
}
template <int L> __device__ __forceinline__ void phase_ffn_up(const Frame& F, bf16_t* actout, int var) {
    const DenseSched s = dense_sched(F, WSP(bf16_t, WS_HB), D, F.ws + W_FFN + (size_t)L * 21 * MiB, D, M / 256, 2 * FF / 256);
    EpiSwiglu<false> e{actout, WSP(float, WS_SSQ), var};
    gemm_phase(F.lds, D, 2 * FF, D, s, e);
}
template <int L> __device__ __forceinline__ void phase_ffn_down(const Frame& F, float* hout) {
    const DenseSched s = dense_sched(F, WSP(bf16_t, B_ACT), FF, F.ws + W_FFN + (size_t)L * 21 * MiB + 14 * MiB, FF, M / 256, D / 256);
    EpiRes e{F.h, hout, WSP(bf16_t, WS_HB), WSP(float, WS_SSQ), nullptr};
    gemm_phase(F.lds, FF, D, FF, s, e);
}
__device__ __forceinline__ MoeSched moe_sched(const Frame& F, int l, const void* A, int lda, size_t wofs, int ldb, int nN) {
    MoeSched s; int ps[NE]; s.nM = moe_layout(F, l, ps, s.pend); s.nN = nN; s.G = F.G; s.c = (int)blockIdx.x; s.A = (const char*)A; s.B = (const char*)(F.ws + W_MOE + (size_t)l * 8 * 21 * MiB + wofs);
    s.astep = (size_t)256 * lda * 2; s.bstep = (size_t)256 * 16; (void)ldb; s.estep = (size_t)21 * MiB; return s;
}
template <int L> __device__ __forceinline__ void phase_moe_up(const Frame& F) {
    const MoeSched s = moe_sched(F, L, WSP(bf16_t, B_XG), D, 0, D, 2 * FF / 256);
    EpiSwiglu<true> e{WSP(bf16_t, B_ACTM), WSP(float, WS_ROWSCALE), 0};
    gemm_phase(F.lds, D, 2 * FF, D, s, e);
}
template <int L> __device__ __forceinline__ void phase_moe_down(const Frame& F) {
    const MoeSched s = moe_sched(F, L, WSP(bf16_t, B_ACTM), FF, 14 * MiB, FF, D / 256);
    EpiMoeDown e{WSP(bf16_t, B_OUTM), WSP(float, WS_ROWGATE)};
    gemm_phase(F.lds, FF, D, FF, s, e);
}

__global__ void __launch_bounds__(NTHR, 2) fused_fwd(Args args) {
    extern __shared__ __attribute__((aligned(16))) unsigned char lds_raw[];
    Frame F;
    F.lds = (LAS unsigned char*)lds_raw; F.ws = args.ws; F.in = args.in; F.h = args.out;
    F.tid = threadIdx.x; F.lane = F.tid & 63; F.wave = __builtin_amdgcn_readfirstlane(F.tid >> 6);
    F.G = gridDim.x; { const int bx = blockIdx.x; F.vcu = (F.G % 8 == 0) ? (bx % 8) * (F.G / 8) + bx / 8 : bx; }
    F.gw = F.vcu * NWAVES + F.wave; F.NGW = F.G * NWAVES;
    volatile LAS unsigned* MISC = (volatile LAS unsigned*)(F.lds + MISC_OFF);
    if (F.tid < 64) MISC[F.tid] = 0u;
    __syncthreads();
    XcdBarrier bar = xcd_barrier_post(WSP(unsigned, WS_CTL) + CW_BAR, MISC + 8);
    const int lo = args.ph_lo, hi = args.ph_hi;
#ifdef ONLY_PHASE
#define IN(k) ((k) == ONLY_PHASE && lo <= (k) && (k) < hi)
#else
#define IN(k) (lo <= (k) && (k) < hi)
#endif
#define SEAM(k) do { if (IN(k) && IN((k) + 1)) xcd_barrier(bar); } while (0)
#ifdef REP_PHASE
#define REP_LOOP(k) for (int _r = 0, _nr = ((k) == REP_PHASE ? args.nrep : 1); _r < _nr; ++_r)
#define REP_SEAM(k) if ((k) == REP_PHASE && _r + 1 < _nr) xcd_barrier(bar);
#define REP_H(k) (((k) == REP_PHASE && _r + 1 < _nr) ? (float*)(F.ws + WS_END) : F.h)
#define REP_X(k) ((k) == REP_PHASE && _r + 1 < _nr)
#ifndef REP_VAR
#define REP_VAR 0
#endif
#else
#define REP_LOOP(k)
#define REP_SEAM(k)
#define REP_H(k) F.h
#define REP_X(k) false
#define REP_VAR 0
#endif

    if (IN(PH_PRO)) { REP_LOOP(PH_PRO) { phase_prologue(F, args.wmask, args.lmask, args.hsrc);  REP_SEAM(PH_PRO) } } SEAM(PH_PRO);
    if (IN(PH_LAT)) { REP_LOOP(PH_LAT) { const DenseSched s = dense_sched(F, WSP(bf16_t, WS_HB), D, WSP(bf16_t, W_MLA_IN), D, M / 256, 3);
        EpiLat e{WSP(bf16_t, B_LAT), WSP(float, WS_SLOT24), WSP(float, WS_SSQ), WSP(bf16_t, B_KB), WSP(float, WS_ROPE)};
        gemm_phase(F.lds, D, 768, D, s, e);  REP_SEAM(PH_LAT) } } SEAM(PH_LAT);
    if (IN(PH_QKV)) { REP_LOOP(PH_QKV) {
#ifndef SKIP_Q
        { const DenseSched s = dense_sched(F, WSP(bf16_t, B_LAT), 768, WSP(bf16_t, W_UQ), 384, M / 256, 6);
          EpiQ e{WSP(bf16_t, B_Q), WSP(float, WS_SLOT24), WSP(float, WS_ROPE)};
          gemm_phase(F.lds, 768, 1536, 384, s, e); }
#endif
#ifndef SKIP_KV
        { const DenseSched s = dense_sched(F, WSP(bf16_t, B_LAT) + 384, 768, WSP(bf16_t, W_UKV), 256, M / 256, 8);
          EpiKV e{WSP(bf16_t, B_KB), WSP(bf16_t, B_VB), WSP(float, WS_SLOT24)};
          gemm_phase(F.lds, 768, 2048, 256, s, e); }
#endif
         REP_SEAM(PH_QKV) } } SEAM(PH_QKV);
    if (IN(PH_ATTN)) { REP_LOOP(PH_ATTN) { phase_attn(F);  REP_SEAM(PH_ATTN) } } SEAM(PH_ATTN);
    if (IN(PH_WO)) { REP_LOOP(PH_WO) { const DenseSched s = dense_sched(F, WSP(bf16_t, B_OB), D, WSP(bf16_t, W_O), D, M / 256, 4);
        EpiRes e{INF(0), REP_H(PH_WO), WSP(bf16_t, WS_HB), WSP(float, WS_SSQ), nullptr};
        gemm_phase(F.lds, D, D, D, s, e);  REP_SEAM(PH_WO) } } SEAM(PH_WO);
    if (IN(PH_FUP0)) { REP_LOOP(PH_FUP0) { phase_ffn_up<0>(F, REP_X(PH_FUP0) ? (bf16_t*)(F.ws + WS_END) : WSP(bf16_t, B_ACT), REP_X(PH_FUP0) ? REP_VAR : 0);  REP_SEAM(PH_FUP0) } } SEAM(PH_FUP0);
    if (IN(PH_FDN0)) { REP_LOOP(PH_FDN0) { phase_ffn_down<0>(F, REP_H(PH_FDN0));  REP_SEAM(PH_FDN0) } } SEAM(PH_FDN0);
    if (IN(PH_LIN)) { REP_LOOP(PH_LIN) { const DenseSched s = dense_sched(F, WSP(bf16_t, WS_HB), D, WSP(bf16_t, W_LRU_IN), D, M / 256, 8);
        EpiSplit2<true, false> e{WSP(bf16_t, B_GATEB), WSP(bf16_t, B_XBR), WSP(float, WS_SSQ)};
        gemm_phase(F.lds, D, 2048, D, s, e);  REP_SEAM(PH_LIN) } } SEAM(PH_LIN);
    if (IN(PH_CONV)) { REP_LOOP(PH_CONV) { phase_conv(F);  REP_SEAM(PH_CONV) } } SEAM(PH_CONV);
    if (IN(PH_LGATE)) { REP_LOOP(PH_LGATE) { GroupSched s; s.nM = M / 256; s.nN = 8; s.G = F.G; s.c = (int)blockIdx.x; s.A = (const char*)WSP(bf16_t, B_XCB); s.B = (const char*)WSP(bf16_t, W_LRU_G);
        s.astep = (size_t)256 * D * 2; s.bstep = (size_t)256 * 256 * 2; s.acol_bytes = 512; s.acol_shift = 1;
        EpiLruGate e{WSP(float, B_AF), WSP(float, B_BF), WSP(bf16_t, B_XCB), INF(15), INF(17), WSP(float, WS_SP8)};
        gemm_phase(F.lds, D, 256, 256, s, e);  REP_SEAM(PH_LGATE) } } SEAM(PH_LGATE);
    if (IN(PH_SCAN1)) { REP_LOOP(PH_SCAN1) { phase_scan1(F);  REP_SEAM(PH_SCAN1) } } SEAM(PH_SCAN1);
    if (IN(PH_SCAN2)) { REP_LOOP(PH_SCAN2) { phase_scan2(F);  REP_SEAM(PH_SCAN2) } } SEAM(PH_SCAN2);
    if (IN(PH_LOUT)) { REP_LOOP(PH_LOUT) { const DenseSched s = dense_sched(F, WSP(bf16_t, B_YB), D, WSP(bf16_t, W_LRU_OUT), D, M / 256, 4);
        EpiRes e{F.h, REP_H(PH_LOUT), WSP(bf16_t, WS_HB), WSP(float, WS_SSQ), nullptr};
        gemm_phase(F.lds, D, D, D, s, e);  REP_SEAM(PH_LOUT) } } SEAM(PH_LOUT);
    if (IN(PH_ROUT0)) { REP_LOOP(PH_ROUT0) { phase_router(F, 0);  REP_SEAM(PH_ROUT0) } } SEAM(PH_ROUT0);
    if (IN(PH_GATH0)) { REP_LOOP(PH_GATH0) { phase_gather(F, 0);  REP_SEAM(PH_GATH0) } } SEAM(PH_GATH0);
    if (IN(PH_MUP0)) { REP_LOOP(PH_MUP0) { phase_moe_up<0>(F);  REP_SEAM(PH_MUP0) } } SEAM(PH_MUP0);
    if (IN(PH_MDN0)) { REP_LOOP(PH_MDN0) { phase_moe_down<0>(F);  REP_SEAM(PH_MDN0) } } SEAM(PH_MDN0);
    if (IN(PH_COMB0)) { REP_LOOP(PH_COMB0) { phase_combine<false>(F);  REP_SEAM(PH_COMB0) } } SEAM(PH_COMB0);
    if (IN(PH_POOL)) { REP_LOOP(PH_POOL) { phase_pool(F);  REP_SEAM(PH_POOL) } } SEAM(PH_POOL);
    if (IN(PH_PGEMM)) { REP_LOOP(PH_PGEMM) { GroupSched s; s.nM = M / 256; s.nN = 4; s.G = F.G; s.c = (int)blockIdx.x; s.A = (const char*)WSP(bf16_t, B_POOLED); s.B = (const char*)WSP(bf16_t, W_POOL);
        s.astep = (size_t)256 * D * 2; s.bstep = (size_t)256 * 256 * 2; s.acol_bytes = 512; s.acol_shift = 0;
        EpiRes e{F.h, REP_H(PH_PGEMM), WSP(bf16_t, WS_HB), WSP(float, WS_SSQ), INF(21)};
        gemm_phase(F.lds, D, 256, 256, s, e);  REP_SEAM(PH_PGEMM) } } SEAM(PH_PGEMM);
    if (IN(PH_FUP1)) { REP_LOOP(PH_FUP1) { phase_ffn_up<1>(F, WSP(bf16_t, B_ACT), 0);  REP_SEAM(PH_FUP1) } } SEAM(PH_FUP1);
    if (IN(PH_FDN1)) { REP_LOOP(PH_FDN1) { phase_ffn_down<1>(F, REP_H(PH_FDN1));  REP_SEAM(PH_FDN1) } } SEAM(PH_FDN1);
    if (IN(PH_GIN)) { REP_LOOP(PH_GIN) { const DenseSched s = dense_sched(F, WSP(bf16_t, WS_HB), D, WSP(bf16_t, W_GM_IN), D, M / 256, 8);
        EpiSplit2<true, true> e{WSP(bf16_t, B_UB), WSP(bf16_t, B_VB2), WSP(float, WS_SSQ)};
        gemm_phase(F.lds, D, 2048, D, s, e);  REP_SEAM(PH_GIN) } } SEAM(PH_GIN);
    if (IN(PH_GGATE)) { REP_LOOP(PH_GGATE) { phase_gmlp(F);  REP_SEAM(PH_GGATE) } } SEAM(PH_GGATE);
    if (IN(PH_GOUT)) { REP_LOOP(PH_GOUT) { const DenseSched s = dense_sched(F, WSP(bf16_t, B_UVB), D, WSP(bf16_t, W_GM_OUT), D, M / 256, 4);
        EpiRes e{F.h, REP_H(PH_GOUT), WSP(bf16_t, WS_HB), WSP(float, WS_SSQ), nullptr};
        gemm_phase(F.lds, D, D, D, s, e);  REP_SEAM(PH_GOUT) } } SEAM(PH_GOUT);
    if (IN(PH_ROUT1)) { REP_LOOP(PH_ROUT1) { phase_router(F, 1);  REP_SEAM(PH_ROUT1) } } SEAM(PH_ROUT1);
    if (IN(PH_GATH1)) { REP_LOOP(PH_GATH1) { phase_gather(F, 1);  REP_SEAM(PH_GATH1) } } SEAM(PH_GATH1);
    if (IN(PH_MUP1)) { REP_LOOP(PH_MUP1) { phase_moe_up<1>(F);  REP_SEAM(PH_MUP1) } } SEAM(PH_MUP1);
    if (IN(PH_MDN1)) { REP_LOOP(PH_MDN1) { phase_moe_down<1>(F);  REP_SEAM(PH_MDN1) } } SEAM(PH_MDN1);
    if (IN(PH_FINAL)) { phase_combine<true>(F); }
#undef IN
#undef SEAM
}
}
extern "C" void kernel_launch(void* const* d_in, const int* in_sizes, int n_in, void* d_out, int out_size, void* d_ws, size_t ws_size, hipStream_t stream) {
    (void)in_sizes; (void)out_size;
    static int grid = 0;
    if (grid == 0) {
        int dev = 0, cus = 0;
        if (n_in != 35 || ws_size < fk::WS_END) { fprintf(stderr, "kernel_launch: unexpected inputs / workspace (%d inputs, %zu bytes)\n", n_in, ws_size); grid = -1; return; }
        if (hipGetDevice(&dev) != hipSuccess || hipDeviceGetAttribute(&cus, hipDeviceAttributeMultiprocessorCount, dev) != hipSuccess) { grid = -1; return; }
        if (hipFuncSetAttribute((const void*)fk::fused_fwd, hipFuncAttributeMaxDynamicSharedMemorySize, fk::LDS_BYTES) != hipSuccess) { grid = -1; return; }
        int per_cu = 0; (void)hipOccupancyMaxActiveBlocksPerMultiprocessor(&per_cu, (const void*)fk::fused_fwd, fk::NTHR, fk::LDS_BYTES); (void)hipGetLastError();
        grid = cus;
    }
    if (grid < 0) return;
    (void)hipMemsetAsync((char*)d_ws + fk::WS_CTL, 0, fk::CTL_ZERO_BYTES, stream);
    fk::Args a{}; for (int i = 0; i < 35; ++i) a.in[i] = d_in[i];
    a.out = (float*)d_out; a.ws = (unsigned char*)d_ws; a.hsrc = (float*)d_in[0]; a.ph_lo = 0; a.ph_hi = fk::PH_N; a.wmask = 0x3FFFFu; a.lmask = 0xFu;
#ifdef REP_PHASE
    a.nrep = REP_N;
#else
    a.nrep = 1;
#endif
    hipLaunchKernelGGL(fk::fused_fwd, dim3(grid), dim3(fk::NTHR), fk::LDS_BYTES, stream, a);
}
```

```cpp
#include <hip/hip_runtime.h>
#include <cstdio>
#include <cstdint>
#include <cmath>
#define HB_ONLY 1
#define MOE_F8 3
#define FFN_F8 2
namespace fk {
#define LAS __attribute__((address_space(3)))
#define GAS __attribute__((address_space(1)))
typedef unsigned short bf16_t;
typedef short bf16x8 __attribute__((ext_vector_type(8)));
typedef short s16x4 __attribute__((ext_vector_type(4)));
typedef float f32x4 __attribute__((ext_vector_type(4)));
typedef float f32x2 __attribute__((ext_vector_type(2)));
typedef float f32x16 __attribute__((ext_vector_type(16)));
typedef unsigned u32x4 __attribute__((ext_vector_type(4)));
typedef unsigned u32x2 __attribute__((ext_vector_type(2)));
typedef __bf16 bf16x2_t __attribute__((ext_vector_type(2)));
typedef int i32x4 __attribute__((ext_vector_type(4)));
typedef int i32x8 __attribute__((ext_vector_type(8)));
#ifndef MOE_F8
#define MOE_F8 2
#endif
__host__ __device__ constexpr bool moe_f8(int l) { return ((MOE_F8 >> l) & 1) != 0; }
#ifndef FFN_F8
#define FFN_F8 0
#endif
__host__ __device__ constexpr bool ffn_f8(int l) { return ((FFN_F8 >> l) & 1) != 0; }
constexpr float F8_SX = 8.f, F8_SW = 64.f, F8_SA = 8.f;
__device__ __forceinline__ unsigned pk_fp8x4(float a, float b, float c, float d) {
    a = __builtin_amdgcn_fmed3f(a, -448.f, 448.f); b = __builtin_amdgcn_fmed3f(b, -448.f, 448.f); c = __builtin_amdgcn_fmed3f(c, -448.f, 448.f); d = __builtin_amdgcn_fmed3f(d, -448.f, 448.f);
    int r = __builtin_amdgcn_cvt_pk_fp8_f32(a, b, 0, false); r = __builtin_amdgcn_cvt_pk_fp8_f32(c, d, r, true); return (unsigned)r;
}

constexpr int D = 1024, NB = 4, S = 4096, M = NB * S, FF = 3584, NE = 8, NH = 16;
constexpr int MOE_MAXP = 136, MOE_MAXROWS = MOE_MAXP * 256;
constexpr float RMS_EPS = 1e-6f, LN_EPS = 1e-5f;
constexpr int NWAVES = 8, NTHR = 512;
constexpr int LDS_BYTES = 147456, MISC_OFF = LDS_BYTES - 256;

constexpr size_t MiB = 1u << 20;
#ifndef FAST_BASE_MIB
#define FAST_BASE_MIB 0
#endif
constexpr size_t FB = (size_t)FAST_BASE_MIB * MiB;
constexpr size_t WS_CTL = FB, CTL_ZERO_BYTES = 1 * MiB;
constexpr size_t WS_SSQ = FB + 1 * MiB;
constexpr size_t WS_SLOT24 = FB + 2 * MiB;
constexpr size_t WS_ROPE = FB + 4 * MiB;
constexpr size_t WS_SP8 = FB + 6 * MiB;
constexpr size_t WS_ROUTW = FB + 6 * MiB + 65536;
constexpr size_t WS_WGBASE = FB + 6 * MiB + 262144;
constexpr size_t WS_RSTD = FB + 6 * MiB + 524288;
constexpr size_t WS_TOKINFO = FB + 7 * MiB;
constexpr size_t WS_TOKG = FB + 7 * MiB + 262144;
constexpr size_t WS_DEST = FB + 7 * MiB + 393216;
constexpr size_t WS_ROWTOK = FB + 7 * MiB + 524288;
constexpr size_t WS_ROWSCALE = FB + 8 * MiB;
constexpr size_t WS_ROWGATE = FB + 8 * MiB + 262144;
constexpr size_t WS_CARRY = FB + 9 * MiB;
constexpr size_t WS_HB = FB + 12 * MiB;
constexpr size_t WS_LO = FB + 44 * MiB;
constexpr size_t WS_X8 = WS_LO;
#ifndef HB_ONLY
#define HB_ONLY 0
#endif
static_assert(FFN_F8 == 0 || HB_ONLY, "the fp8 stream copy lives in the lo-half buffer");
constexpr size_t WS_W = FB + 76 * MiB;
constexpr size_t W_MLA_IN = WS_W, W_UQ = WS_W + 2 * MiB, W_UKV = W_UQ + 2 * MiB, W_O = W_UKV + 2 * MiB, W_LRU_IN = W_O + 3 * MiB, W_LRU_G = W_LRU_IN + 5 * MiB,
                 W_LRU_OUT = W_LRU_G + 2 * MiB, W_POOL = W_LRU_OUT + 3 * MiB, W_GM_IN = W_POOL + 1 * MiB, W_GM_S = W_GM_IN + 5 * MiB, W_GM_OUT = W_GM_S + 131072;
constexpr size_t WSTRIDE = 21 * MiB + 96 * 1024;
constexpr size_t WDOWN_OFF = 14 * MiB;
constexpr size_t W_FFN = WS_W + 32 * MiB;
constexpr size_t W_MOE = W_FFN + 2 * WSTRIDE + MiB;
constexpr size_t WS_BIG = FB + 492 * MiB;
static_assert(W_GM_OUT + 4 * MiB <= W_FFN && W_MOE + 16 * WSTRIDE <= WS_BIG, "weight map");
constexpr size_t B_LAT = WS_BIG, B_Q = WS_BIG + 24 * MiB, B_KB = WS_BIG + 72 * MiB, B_VB = WS_BIG + 120 * MiB, B_OB = WS_BIG + 152 * MiB;
constexpr size_t B_ACT = WS_BIG;
constexpr size_t B_GATEB = WS_BIG, B_XBR = WS_BIG + 32 * MiB, B_XCB = WS_BIG + 64 * MiB, B_AF = WS_BIG + 96 * MiB, B_BF = WS_BIG + 160 * MiB, B_YB = WS_BIG + 224 * MiB;
constexpr size_t B_XG = WS_BIG, B_OUTM = WS_BIG, B_ACTM = WS_BIG + 68 * MiB;
constexpr size_t B_POOLED = WS_BIG;
constexpr size_t B_UB = WS_BIG, B_VB2 = WS_BIG + 32 * MiB, B_UVB = WS_BIG + 64 * MiB;
constexpr size_t WS_END = WS_BIG + 306 * MiB;
constexpr size_t WS_SK = WS_END;
constexpr int CW_TMO = 0, CW_BAR = 4096, CW_MOECNT = 16384, CW_SK = 32768;
#ifndef MDN_STREAMK
#define MDN_STREAMK 1
#endif
#ifndef MUP_GATHER
#define MUP_GATHER 0
#endif

__device__ __forceinline__ unsigned pk2(float lo, float hi) { f32x2 v = {lo, hi}; bf16x2_t b = __builtin_convertvector(v, bf16x2_t); return __builtin_bit_cast(unsigned, b); }
__device__ __forceinline__ float bf2f(unsigned short b) { return __uint_as_float((unsigned)b << 16); }
__device__ __forceinline__ float bflo(unsigned w) { return __uint_as_float(w << 16); }
__device__ __forceinline__ float bfhi(unsigned w) { return __uint_as_float(w & 0xffff0000u); }
__device__ __forceinline__ float fast_exp2(float x) { return __builtin_amdgcn_exp2f(x); }
__device__ __forceinline__ float fast_rcp(float x) { return __builtin_amdgcn_rcpf(x); }
__device__ __forceinline__ float sigmoid_f(float x) { return fast_rcp(1.0f + fast_exp2(-1.4426950408889634f * x)); }
__device__ __forceinline__ float silu_f(float x) { return x * sigmoid_f(x); }
__device__ __forceinline__ float gelu_tanh_f(float x) { const float u = 0.7978845608028654f * (x + 0.044715f * x * x * x); return x * sigmoid_f(2.0f * u); }
__device__ __forceinline__ float wave_sum(float v) {
#pragma unroll
    for (int o = 1; o < 64; o <<= 1) v += __shfl_xor(v, o);
    return v;
}
__device__ __forceinline__ float hsum4(f32x4 a) { return (a.x + a.y) + (a.z + a.w); }
__device__ __forceinline__ float rstd16(const float* ssq, int row) {
    const f32x4* p = (const f32x4*)(ssq + (size_t)row * 16); const f32x4 a = p[0], b = p[1], c = p[2], d = p[3];
    const float s = (hsum4(a) + hsum4(b)) + (hsum4(c) + hsum4(d)); return 1.0f / sqrtf(s * (1.0f / 1024.0f) + RMS_EPS);
}

#ifndef BAR_FLAT
#define BAR_FLAT 0
#endif
#define XB_TMO      128
#define XB_XCNT(j)  (256  + 64 * (j))
#define XB_XSUB(j)  (1280 + 64 * (j))
#define XB_XGEN(j)  (2304 + 64 * (j))
#define XB_TOP      3328
#define XB_TOPGEN   3392
#define XCD_BAR_WORDS 3456
#define XB_SPIN_CAP (1u << 18)
__device__ __forceinline__ unsigned xb_ld(unsigned* p)              { return __hip_atomic_load(p, __ATOMIC_RELAXED, __HIP_MEMORY_SCOPE_AGENT); }
__device__ __forceinline__ unsigned xb_add(unsigned* p, unsigned v) { return __hip_atomic_fetch_add(p, v, __ATOMIC_RELAXED, __HIP_MEMORY_SCOPE_AGENT); }
__device__ __forceinline__ unsigned xb_xcc_id() { return (unsigned)__builtin_amdgcn_s_getreg((3 << 11) | 20) & 0xFu; }
#define XB_SPIN(cond, bar) do { unsigned _sp = 0; while (cond) { __builtin_amdgcn_s_sleep(1); \
    if ((++_sp & 255u) == 0u) { if (xb_ld(&(bar)[XB_TMO])) break; if (_sp > XB_SPIN_CAP) { atomicAdd(&(bar)[XB_TMO], 1u); break; } } } } while (0)
struct XcdBarrier { unsigned* bar; unsigned x; volatile LAS unsigned* st; };
__device__ __forceinline__ XcdBarrier xcd_barrier_post(unsigned* bar, volatile LAS unsigned* st) {
    XcdBarrier b; b.bar = bar; b.x = xb_xcc_id(); b.st = st;
    if (threadIdx.x == 0) (void)xb_add(&bar[XB_XCNT(b.x)], 1u);
    return b;
}
__device__ __forceinline__ void xcd_barrier_complete(unsigned* bar, unsigned x, unsigned& nloc, unsigned& nx) {
    const unsigned G = gridDim.x * gridDim.y * gridDim.z;
    unsigned sum, cnt, mine, sp = 0u;
    for (;;) {
        sum = 0u; cnt = 0u; mine = 0u;
#pragma unroll
        for (unsigned j = 0; j < 16; ++j) { const unsigned c = xb_ld(&bar[XB_XCNT(j)]); sum += c; cnt += (c > 0u) ? 1u : 0u; mine = (j == x) ? c : mine; }
        if (sum == G) break;
        __builtin_amdgcn_s_sleep(1);
        if ((++sp & 255u) == 0u) { if (xb_ld(&bar[XB_TMO])) break; if (sp > XB_SPIN_CAP) { atomicAdd(&bar[XB_TMO], 1u); break; } }
    }
    nloc = mine > 0u ? mine : 1u; nx = cnt > 0u ? cnt : 1u;
}
__device__ __forceinline__ void xcd_barrier(const XcdBarrier& b) {
    asm volatile("s_waitcnt vmcnt(0)" ::: "memory");
    __syncthreads();
    if (threadIdx.x == 0) {
        unsigned* bar = b.bar;
        __builtin_amdgcn_s_waitcnt(0);
        unsigned nloc = b.st[0], nx = b.st[1];
        if (nloc == 0u) { xcd_barrier_complete(bar, b.x, nloc, nx); b.st[0] = nloc; b.st[1] = nx; }
        const unsigned old = xb_add(&bar[XB_XSUB(b.x)], 1u);
        const unsigned gen = old / nloc;
#if BAR_FLAT
        if (old + 1u == (gen + 1u) * nloc) { __builtin_amdgcn_fence(__ATOMIC_RELEASE, "agent"); asm volatile("s_waitcnt vmcnt(0)" ::: "memory"); (void)xb_add(&bar[XB_TOP], 1u); }
        { const unsigned target = (gen + 1u) * nx; XB_SPIN(xb_ld(&bar[XB_TOP]) < target, bar); }
        __builtin_amdgcn_fence(__ATOMIC_ACQUIRE, "agent");
        asm volatile("s_waitcnt vmcnt(0)" ::: "memory");
#else
        if (old + 1u == (gen + 1u) * nloc) {
            __builtin_amdgcn_fence(__ATOMIC_RELEASE, "agent");
            asm volatile("s_waitcnt vmcnt(0)" ::: "memory");
            const unsigned og = xb_add(&bar[XB_TOP], 1u);
            const unsigned tg = og / nx;
            if (og + 1u == (tg + 1u) * nx) xb_add(&bar[XB_TOPGEN], 1u);
            else XB_SPIN(xb_ld(&bar[XB_TOPGEN]) == tg, bar);
            __builtin_amdgcn_fence(__ATOMIC_ACQUIRE, "agent");
            xb_add(&bar[XB_XGEN(b.x)], 1u);
            asm volatile("s_waitcnt vmcnt(0)" ::: "memory");
        } else {
            XB_SPIN(xb_ld(&bar[XB_XGEN(b.x)]) == gen, bar);
            __builtin_amdgcn_fence(__ATOMIC_ACQUIRE, "agent");
            asm volatile("s_waitcnt vmcnt(0)" ::: "memory");
        }
#endif
    }
    __syncthreads();
}

#ifdef EXTRA_LIGHT
__device__ __forceinline__ void xcd_barrier_light(const XcdBarrier& b) {
    asm volatile("s_waitcnt vmcnt(0)" ::: "memory");
    __syncthreads();
    if (threadIdx.x == 0) {
        unsigned* bar = b.bar;
        __builtin_amdgcn_s_waitcnt(0);
        unsigned nloc = b.st[0], nx = b.st[1];
        if (nloc == 0u) { xcd_barrier_complete(bar, b.x, nloc, nx); b.st[0] = nloc; b.st[1] = nx; }
        const unsigned old = xb_add(&bar[XB_XSUB(b.x)], 1u);
        const unsigned gen = old / nloc;
        if (old + 1u == (gen + 1u) * nloc) {

            asm volatile("s_waitcnt vmcnt(0)" ::: "memory");
            const unsigned og = xb_add(&bar[XB_TOP], 1u);
            const unsigned tg = og / nx;
            if (og + 1u == (tg + 1u) * nx) xb_add(&bar[XB_TOPGEN], 1u);
            else XB_SPIN(xb_ld(&bar[XB_TOPGEN]) == tg, bar);

            xb_add(&bar[XB_XGEN(b.x)], 1u);
            asm volatile("s_waitcnt vmcnt(0)" ::: "memory");
        } else {
            XB_SPIN(xb_ld(&bar[XB_XGEN(b.x)]) == gen, bar);

            asm volatile("s_waitcnt vmcnt(0)" ::: "memory");
        }
    }
    __syncthreads();
}

#endif
#ifndef WLAYOUT
#define WLAYOUT 0
#endif
constexpr int BM = 256, BK = 64, HALF = 128, HTB = HALF * BK * 2, STAGE_BYTES = 8 * HTB, NXCD = 8, WGM = 8;
__device__ __forceinline__ int lds_byte(int r, int c) { const int st = (r >> 4) * 2 + (c >> 5), rr = r & 15, cc = c & 31, ob = rr * 64 + cc * 2; return st * 1024 + (ob ^ (((ob >> 9) & 1) << 5)); }
__device__ __forceinline__ void stage_rc(int b, int& R, int& C) { const int st = b / 1024, sb = b % 1024, swz = sb ^ (((sb >> 9) & 1) << 5); R = (st >> 1) * 16 + swz / 64; C = (st & 1) * 32 + (swz % 64) / 2; }
__device__ __forceinline__ int perm32(int rho) { const int n = rho >> 4, i = rho & 15; return 8 * (i >> 2) + 4 * n + (i & 3); }

__device__ __forceinline__ const char* uni_ptr(const char* p) { const unsigned long long v = (unsigned long long)p; const unsigned lo = __builtin_amdgcn_readfirstlane((unsigned)v), hi = __builtin_amdgcn_readfirstlane((unsigned)(v >> 32)); return (const char*)(((unsigned long long)hi << 32) | lo); }
#ifndef BPAD
#define BPAD 0
#endif
static_assert(WLAYOUT == 0 && BPAD == 0, "the weight map is sized for the row-major layout");
__host__ __device__ constexpr size_t btile_bytes(int K) {
#if WLAYOUT
    return (size_t)(K / 64 + 1) * 32768;
#else
    return (size_t)(K + BPAD) * 512;
#endif
}
struct GUnit { int pm, pn; const char* A; const char* B; int ex; int nkt, kind, slot; };
__device__ __forceinline__ bool tile_order(int i, int G, int c, int nM, int nN, int& pm, int& pn) {
    const int nwg = nM * nN; const long L = (long)i * G + c; if (L >= nwg) return false;
    int wgid = (int)L; { const int q = nwg / NXCD, r = nwg % NXCD, xcd = wgid % NXCD, off = wgid / NXCD; wgid = (xcd < r ? xcd * (q + 1) : r * (q + 1) + (xcd - r) * q) + off; }
    const int nig = WGM * nN, gid = wgid / nig, fm = gid * WGM, gsz = (nM - fm) < WGM ? (nM - fm) : WGM;
    pm = fm + ((wgid % nig) % gsz); pn = (wgid % nig) / gsz; return true;
}
struct DenseSched {
    int nM, nN, G, c; const char* A; const char* B; size_t astep, bstep;
    __device__ __forceinline__ bool next(int i, GUnit& u) const { if (!tile_order(i, G, c, nM, nN, u.pm, u.pn)) return false; u.A = A + (size_t)u.pm * astep; u.B = B + (size_t)u.pn * bstep; u.ex = 0; u.nkt = 0; u.kind = 0; u.slot = 0; return true; }
};
struct GroupSched {
    int nM, nN, G, c; const char* A; const char* B; size_t astep, bstep; int acol_bytes, acol_shift;
    __device__ __forceinline__ bool next(int i, GUnit& u) const { if (!tile_order(i, G, c, nM, nN, u.pm, u.pn)) return false;
        u.A = A + (size_t)u.pm * astep + (size_t)(u.pn >> acol_shift) * acol_bytes; u.B = B + (size_t)u.pn * bstep; u.ex = 0; u.nkt = 0; u.kind = 0; u.slot = 0; return true; }
};
struct MoeSched {
    int nM, nN, G, c; const char* A; const char* B; size_t astep, bstep, estep; int pend[NE];
    __device__ __forceinline__ bool next(int i, GUnit& u) const { if (!tile_order(i, G, c, nM, nN, u.pm, u.pn)) return false;
        int e = 0;
#pragma unroll
        for (int k = 0; k < NE - 1; ++k) e += (u.pm >= pend[k]) ? 1 : 0;
        u.ex = e; u.A = A + (size_t)u.pm * astep; u.B = B + (size_t)e * estep + (size_t)u.pn * bstep; u.nkt = 0; u.kind = 0; u.slot = 0; return true; }
};
struct SKSched {
    int NP, P, s0, s1, x, r, j; const char* A; const char* B; size_t astep, bstep, estep; int pend[NE];
    __device__ __forceinline__ bool next(int i, GUnit& u) const {
        const int rem = s0 % P; int start;
        if (rem != 0) start = (i == 0) ? s0 : (s0 - rem + P) + (i - 1) * P; else start = s0 + i * P;
        if (start >= s1) return false;
        const int sp = start / P, k0 = start - sp * P; const int endp = (sp + 1) * P < s1 ? (sp + 1) * P : s1; const int len = endp - start;
        const int pm = sp * 8 + r; if (pm >= NP) return false;
        int e = 0;
#pragma unroll
        for (int k = 0; k < NE - 1; ++k) e += (pm >= pend[k]) ? 1 : 0;
        u.pm = pm; u.pn = j; u.ex = e; u.A = A + (size_t)pm * astep + (size_t)k0 * 65536; u.B = B + (size_t)e * estep + (size_t)j * bstep + (size_t)k0 * 256;
        u.nkt = 2 * len; u.kind = k0 > 0 ? 1 : (len < P ? 2 : 0); u.slot = (u.kind == 1 ? x - 1 : x) * 32 + r * 4 + j; return true; }
};

typedef f32x4 AccArr[2][2][4][2];
template <class T, class = void> struct epi_has_post { static constexpr bool value = false; };
template <class T> struct epi_has_post<T, decltype((void)T::POST)> { static constexpr bool value = T::POST; };
struct SKCtx { unsigned char* buf; unsigned* flags; unsigned* tmo; };
__device__ __forceinline__ void sk_store(const SKCtx& sk, const AccArr& acc, int slot, int tid, int lane) {
    const __amdgpu_buffer_rsrc_t rs = __builtin_amdgcn_make_buffer_rsrc(sk.buf + (size_t)slot * 262144, 0, 262144, 0x00020000);
#pragma unroll
    for (int a = 0; a < 2; ++a)
#pragma unroll
        for (int b = 0; b < 2; ++b)
#pragma unroll
            for (int m = 0; m < 4; ++m)
#pragma unroll
                for (int n = 0; n < 2; ++n) __builtin_amdgcn_raw_buffer_store_b128(__builtin_bit_cast(u32x4, acc[a][b][m][n]), rs, (unsigned)((((a * 2 + b) * 4 + m) * 2 + n) * 8192 + tid * 16), 0, 17);
    asm volatile("s_waitcnt vmcnt(0)" ::: "memory");
    __builtin_amdgcn_fence(__ATOMIC_RELEASE, "agent"); asm volatile("s_waitcnt vmcnt(0)" ::: "memory");
    if (lane == 0) __hip_atomic_fetch_add(sk.flags + 16 * slot, 1u, __ATOMIC_RELAXED, __HIP_MEMORY_SCOPE_AGENT);
}
__device__ __forceinline__ void sk_load_init(const SKCtx& sk, AccArr& acc, int slot, int tid) {
    { unsigned sp = 0; while (__builtin_amdgcn_readfirstlane(__hip_atomic_load(sk.flags + 16 * slot, __ATOMIC_RELAXED, __HIP_MEMORY_SCOPE_AGENT)) < 8u) { __builtin_amdgcn_s_sleep(2);
        if (++sp > (1u << 22)) { if (threadIdx.x == 0) __hip_atomic_store(sk.tmo, 1u, __ATOMIC_RELAXED, __HIP_MEMORY_SCOPE_AGENT); break; } } }
    __builtin_amdgcn_fence(__ATOMIC_ACQUIRE, "agent"); asm volatile("s_waitcnt vmcnt(0)" ::: "memory");
    const __amdgpu_buffer_rsrc_t rs = __builtin_amdgcn_make_buffer_rsrc(sk.buf + (size_t)slot * 262144, 0, 262144, 0x00020000);
    const unsigned vo = (unsigned)tid * 16u;
#pragma unroll
    for (int a = 0; a < 2; ++a)
#pragma unroll
        for (int b = 0; b < 2; ++b)
#pragma unroll
            for (int m = 0; m < 4; ++m)
#pragma unroll
                for (int n = 0; n < 2; ++n) acc[a][b][m][n] = __builtin_bit_cast(f32x4, __builtin_amdgcn_raw_buffer_load_b128(rs, vo, (unsigned)((((a * 2 + b) * 4 + m) * 2 + n) * 8192), 17));
    asm volatile("s_waitcnt vmcnt(0)" ::: "memory");
}
template <class Epi, class Sched, bool SK = false, bool ALIGN = true, bool GA = false, bool F8 = false>
__device__ __forceinline__ void gemm_phase(LAS unsigned char* lds, const int lda, const int nbr, const int K, const Sched& S, const Epi& E, const SKCtx sk = SKCtx{nullptr, nullptr, nullptr}, const size_t kpairA = 256, const int* gidx = nullptr) {
    const int tid = threadIdx.x, wid = __builtin_amdgcn_readfirstlane(tid >> 6), lane = tid & 63, wr = wid >> 2, wc = wid & 3, fr = lane & 15, fq = lane >> 4;
    const int nt_full = K / BK;
    unsigned voffA[2], voffB[2];
#pragma unroll
    for (int i = 0; i < 2; ++i) { int R, C; stage_rc(tid * 16 + i * 8192, R, C); const int Rb = Epi::PERM ? ((R & ~31) + perm32(R & 31)) : R;
        voffA[i] = (kpairA == 65536) ? (F8 ? (unsigned)(((C >> 4) * 256 + R) * 32 + (C & 15) * 2) : (unsigned)(((C >> 5) * 256 + R) * 64 + (C & 31) * 2)) : (unsigned)(R * lda + C) * 2u;
#if WLAYOUT
        voffB[i] = (unsigned)((C >> 3) * 256 + Rb) * 16u; }
#else
        voffB[i] = (unsigned)(Rb * (nbr + BPAD) + C) * 2u; }
#endif
    const size_t kstep = (kpairA == 65536) ? (size_t)32768 : (size_t)(BK * 2);
#if WLAYOUT
    const size_t hstepA = (size_t)HALF * lda * 2, hstepB = (size_t)HALF * 16, kstepB = (size_t)32768; (void)nbr;
#else
    const size_t hstepA = (kpairA == 65536) ? (size_t)HALF * (F8 ? 32 : 64) : (size_t)HALF * lda * 2, hstepB = (size_t)HALF * (nbr + BPAD) * 2, kstepB = (size_t)(BK * 2);
#endif
    const unsigned ldsw = (unsigned)wid * 1024u;
    const int aoff = lds_byte(wr * 64 + fr, fq * 8), boff = lds_byte(wc * 32 + fr, fq * 8);
#define PG8_SA(b, h) (((b) * 2 + (h)) * HTB)
#define PG8_SB(b, h) ((4 + (b) * 2 + (h)) * HTB)
#define PG8_STAGE(bufoff, gbase, voff) do { _Pragma("unroll") for (int _i = 0; _i < 2; ++_i) \
        __builtin_amdgcn_global_load_lds((const unsigned*)((const char*)(gbase) + (voff)[_i]), (LAS unsigned*)(lds + (bufoff) + ldsw + _i * 8192), 16, 0, 0); } while (0)
#define PG8_LDA(dst, b, h) do { _Pragma("unroll") for (int m = 0; m < 4; ++m) _Pragma("unroll") for (int k = 0; k < 2; ++k) dst[m][k] = *(const LAS bf16x8*)(lds + PG8_SA(b, h) + aoff + m * 2048 + k * 1024); } while (0)
#define PG8_LDB(dst, b, h) do { _Pragma("unroll") for (int n = 0; n < 2; ++n) _Pragma("unroll") for (int k = 0; k < 2; ++k) dst[n][k] = *(const LAS bf16x8*)(lds + PG8_SB(b, h) + boff + n * 2048 + k * 1024); } while (0)
#define PG8_CAT8(x) __builtin_shufflevector(__builtin_bit_cast(i32x4, (x)[0]), __builtin_bit_cast(i32x4, (x)[1]), 0, 1, 2, 3, 4, 5, 6, 7)
#define PG8_MMA(ai, bj, At, Bt) do { __builtin_amdgcn_s_setprio(1); _Pragma("unroll") for (int m = 0; m < 4; ++m) _Pragma("unroll") for (int n = 0; n < 2; ++n) { \
        if constexpr (F8) asm volatile("v_mfma_f32_16x16x128_f8f6f4 %0, %1, %2, %0" : "+v"(acc[ai][bj][m][n]) : "v"(PG8_CAT8(Bt[n])), "v"(PG8_CAT8(At[m])));     \
        else { _Pragma("unroll") for (int k = 0; k < 2; ++k) acc[ai][bj][m][n] = __builtin_amdgcn_mfma_f32_16x16x32_bf16(Bt[n][k], At[m][k], acc[ai][bj][m][n], 0, 0, 0); } } __builtin_amdgcn_s_setprio(0); } while (0)
#define PG8_WAIT_V(n) asm volatile("s_waitcnt vmcnt(" #n ")" ::: "memory")
#define PG8_WAIT_L(n) asm volatile("s_waitcnt lgkmcnt(" #n ")" ::: "memory")
#define PG8_BAR __builtin_amdgcn_s_barrier()
#define PG8_SCHED __builtin_amdgcn_sched_barrier(0)
    GUnit cur, nxt; int ui = 0;
    if (!S.next(0, cur)) return;
    unsigned vc[2][2] = {{0u, 0u}, {0u, 0u}}, vn[2][2] = {{0u, 0u}, {0u, 0u}};
    int gR[2], gC[2];
#pragma unroll
    for (int i = 0; i < 2; ++i) stage_rc(tid * 16 + i * 8192, gR[i], gC[i]);
#define PG8_GOFF(dst, pm_) do { if constexpr (GA) { _Pragma("unroll") for (int h_ = 0; h_ < 2; ++h_) _Pragma("unroll") for (int i_ = 0; i_ < 2; ++i_) \
        dst[h_][i_] = (unsigned)gidx[(pm_) * BM + h_ * HALF + gR[i_]] * (unsigned)(lda * 2) + (unsigned)(gC[i_] * 2); } } while (0)
    PG8_GOFF(vc, cur.pm);
    f32x4 acc[2][2][4][2];
#pragma unroll
    for (int a = 0; a < 2; ++a)
#pragma unroll
        for (int b = 0; b < 2; ++b)
#pragma unroll
            for (int m = 0; m < 4; ++m)
#pragma unroll
                for (int n = 0; n < 2; ++n) acc[a][b][m][n] = (f32x4){0.f, 0.f, 0.f, 0.f};
    bf16x8 At[4][2], B0[2][2], B1[2][2];
    const char* cA = uni_ptr(cur.A); const char* cB = uni_ptr(cur.B); int nt = SK ? __builtin_amdgcn_readfirstlane(cur.nkt) : nt_full;
    PG8_STAGE(PG8_SB(0, 0), cB, voffB); PG8_STAGE(PG8_SB(0, 1), cB + hstepB, voffB); PG8_STAGE(PG8_SA(0, 0), cA, (GA ? vc[0] : voffA)); PG8_STAGE(PG8_SA(0, 1), cA + (GA ? 0 : hstepA), (GA ? vc[1] : voffA));
    if (wr == 1) PG8_BAR;
    PG8_WAIT_V(2); PG8_BAR;
    PG8_STAGE(PG8_SB(1, 0), cB + kstepB, voffB); PG8_STAGE(PG8_SA(1, 0), cA + kstep, (GA ? vc[0] : voffA)); PG8_STAGE(PG8_SB(1, 1), cB + hstepB + kstepB, voffB);
    PG8_WAIT_V(6); PG8_BAR;
    for (;;) {
        const bool has_next = S.next(ui + 1, nxt);
        const char* nA = has_next ? uni_ptr(nxt.A) : cA; const char* nB = has_next ? uni_ptr(nxt.B) : cB;
        if (has_next) PG8_GOFF(vn, nxt.pm);
#pragma clang loop unroll(disable)
        for (int t = 0; t < nt; t += 2) {
            const bool last = (t == nt - 2);
            const char* a1 = cA + (size_t)(t >> 1) * kpairA + kstep;
            const char* a2 = last ? nA : cA + (size_t)((t >> 1) + 1) * kpairA; const char* b2 = last ? nB : cB + (size_t)(t + 2) * kstepB;
            const char* a3 = a2 + kstep; const char* b3 = b2 + kstepB;
            unsigned va2[2][2];
#pragma unroll
            for (int h_ = 0; h_ < 2; ++h_)
#pragma unroll
                for (int i_ = 0; i_ < 2; ++i_) va2[h_][i_] = GA ? ((last && has_next) ? vn[h_][i_] : vc[h_][i_]) : voffA[i_];
            const size_t hA = GA ? 0 : hstepA;
            PG8_LDB(B0, 0, 0); PG8_LDB(B1, 0, 1); PG8_SCHED; PG8_LDA(At, 0, 0); PG8_STAGE(PG8_SA(1, 1), a1 + hA, (GA ? vc[1] : voffA));
            if (Epi::NSTORE == 8 && t == 0 && ui > 0) PG8_WAIT_V(16); else PG8_WAIT_V(8);
            PG8_WAIT_L(0); PG8_BAR; PG8_MMA(0, 0, At, B0); PG8_MMA(0, 1, At, B1); PG8_BAR; PG8_SCHED;
            PG8_LDA(At, 0, 1); PG8_STAGE(PG8_SB(0, 0), b2, voffB); PG8_STAGE(PG8_SB(0, 1), b2 + hstepB, voffB); PG8_STAGE(PG8_SA(0, 0), a2, va2[0]);
            if (Epi::NSTORE == 8 && t == 0 && ui > 0) PG8_WAIT_V(16); else PG8_WAIT_V(8);
            PG8_WAIT_L(0); PG8_BAR; PG8_MMA(1, 0, At, B0); PG8_MMA(1, 1, At, B1); PG8_BAR; PG8_SCHED;
            PG8_LDB(B0, 1, 0); PG8_LDB(B1, 1, 1); PG8_SCHED; PG8_LDA(At, 1, 0); PG8_STAGE(PG8_SA(0, 1), a2 + hA, va2[1]);
            PG8_WAIT_V(8); PG8_WAIT_L(0); PG8_BAR; PG8_MMA(0, 0, At, B0); PG8_MMA(0, 1, At, B1); PG8_BAR; PG8_SCHED;
            PG8_LDA(At, 1, 1); PG8_STAGE(PG8_SB(1, 0), b3, voffB); PG8_STAGE(PG8_SB(1, 1), b3 + hstepB, voffB); PG8_STAGE(PG8_SA(1, 0), a3, va2[0]);
            PG8_WAIT_V(8); PG8_WAIT_L(0); PG8_BAR; PG8_MMA(1, 0, At, B0); PG8_MMA(1, 1, At, B1); PG8_BAR; PG8_SCHED;
        }
        if constexpr (F8) asm volatile("s_nop 7\n\ts_nop 7\n\ts_nop 3" ::: "memory");
        if constexpr (ALIGN) { if (wr == 0) PG8_BAR; }
        const LAS float* aux = (const LAS float*)(lds + STAGE_BYTES);
        const int kind = SK ? __builtin_amdgcn_readfirstlane(cur.kind) : 0, slot = SK ? __builtin_amdgcn_readfirstlane(cur.slot) : 0;
        (void)kind; (void)slot; (void)sk;
        {
        if constexpr (Epi::ROWSCALE) { if (tid < 256) ((LAS float*)(lds + STAGE_BYTES))[tid] = E.rowscale(cur.pm * BM + tid); PG8_WAIT_L(0); PG8_BAR; }
        E(acc, cur, wr, wc, fr, fq, aux);
        if constexpr (epi_has_post<Epi>::value) { PG8_WAIT_V(0); PG8_BAR; E.post(cur, tid); }
        }
        if (!has_next) break;
        {
#pragma unroll
        for (int a = 0; a < 2; ++a)
#pragma unroll
            for (int b = 0; b < 2; ++b)
#pragma unroll
                for (int m = 0; m < 4; ++m)
#pragma unroll
                    for (int n = 0; n < 2; ++n) acc[a][b][m][n] = (f32x4){0.f, 0.f, 0.f, 0.f};
        }
        cur = nxt; cA = nA; cB = nB; ++ui;
        if constexpr (GA) { _Pragma("unroll") for (int h_ = 0; h_ < 2; ++h_) _Pragma("unroll") for (int i_ = 0; i_ < 2; ++i_) vc[h_][i_] = vn[h_][i_]; } if constexpr (SK) nt = __builtin_amdgcn_readfirstlane(cur.nkt);
        if constexpr (ALIGN) { if (wr == 1) PG8_BAR; }
    }
    PG8_WAIT_V(0);
    if constexpr (!ALIGN) { if (wr == 0) PG8_BAR; }
    PG8_BAR;
#undef PG8_GOFF
#undef PG8_SA
#undef PG8_SB
#undef PG8_STAGE
#undef PG8_LDA
#undef PG8_LDB
#undef PG8_MMA
#undef PG8_CAT8
#undef PG8_WAIT_V
#undef PG8_WAIT_L
#undef PG8_BAR
#undef PG8_SCHED
}
typedef f32x4 AccT[2][2][4][2];
__device__ __forceinline__ void st_bf16x8(bf16_t* p, f32x4 v0, f32x4 v1) { u32x4 w; w.x = pk2(v0[0], v0[1]); w.y = pk2(v0[2], v0[3]); w.z = pk2(v1[0], v1[1]); w.w = pk2(v1[2], v1[3]); *(u32x4*)p = w; }
#ifndef ACT_STORE_POL
#define ACT_STORE_POL 0
#endif
__device__ __forceinline__ void st_bf16x8_pol(bf16_t* p, f32x4 v0, f32x4 v1, int pol) {
    u32x4 w; w.x = pk2(v0[0], v0[1]); w.y = pk2(v0[2], v0[3]); w.z = pk2(v1[0], v1[1]); w.w = pk2(v1[2], v1[3]);
    if (pol == 4) asm volatile("global_store_dwordx4 %0, %1, off sc1" :: "v"(p), "v"(w) : "memory");
    else if (pol == 5) asm volatile("global_store_dwordx4 %0, %1, off nt" :: "v"(p), "v"(w) : "memory");
    else *(u32x4*)p = w;
}
__device__ __forceinline__ void st_bf16x4(bf16_t* p, f32x4 v) { u32x2 w; w.x = pk2(v[0], v[1]); w.y = pk2(v[2], v[3]); *(u32x2*)p = w; }
__device__ __forceinline__ float sumsq4(f32x4 v) { return (v[0] * v[0] + v[1] * v[1]) + (v[2] * v[2] + v[3] * v[3]); }
__device__ __forceinline__ float red_fq(float s) { s += __shfl_xor(s, 16); s += __shfl_xor(s, 32); return s; }
__device__ __forceinline__ void rope_rot(f32x4& x1, f32x4& x2, const float* cs  ) {
    const f32x4 t0 = *(const f32x4*)cs, t1 = *(const f32x4*)(cs + 4);
    const f32x4 c = {t0[0], t0[2], t1[0], t1[2]}, s = {t0[1], t0[3], t1[1], t1[3]};
    const f32x4 y1 = x1 * c - x2 * s, y2 = x2 * c + x1 * s; x1 = y1; x2 = y2;
}

struct EpiLat {
    static constexpr bool PERM = true, ROWSCALE = true; static constexpr int NSTORE = 0;
    bf16_t* lat; float* slot24; const float* ssq; bf16_t* kb; const float* rope;
    __device__ __forceinline__ float rowscale(int row) const { return rstd16(ssq, row); }
    __device__ __forceinline__ void operator()(const AccT& acc, const GUnit& u, int wr, int wc, int fr, int fq, const LAS float* aux) const {
#pragma unroll
        for (int ai = 0; ai < 2; ++ai)
#pragma unroll
            for (int m = 0; m < 4; ++m) { const int row = u.pm * BM + ai * HALF + wr * 64 + m * 16 + fr; const float rs = aux[ai * HALF + wr * 64 + m * 16 + fr];
#pragma unroll
                for (int bj = 0; bj < 2; ++bj) { const int cb = u.pn * BM + bj * HALF + wc * 32;
                    f32x4 v0 = acc[ai][bj][m][0] * rs, v1 = acc[ai][bj][m][1] * rs;
                    if (cb < 640) { st_bf16x8(lat + (size_t)row * 768 + cb + 8 * fq, v0, v1);
                        const float ss = red_fq(sumsq4(v0) + sumsq4(v1)); if (fq == 0) slot24[(size_t)row * 24 + u.pn * 8 + bj * 4 + wc] = ss; }
                    else if (cb == 640) { rope_rot(v0, v1, rope + (size_t)row * 32 + 8 * fq);
                        u32x4 w; w.x = pk2(v0[0], v0[1]); w.y = pk2(v0[2], v0[3]); w.z = pk2(v1[0], v1[1]); w.w = pk2(v1[2], v1[3]);
                        bf16_t* kp = kb + (size_t)row * 1536 + 64 + 8 * fq;
#pragma unroll
                        for (int hh = 0; hh < NH; ++hh) *(u32x4*)(kp + hh * 96) = w; } } }
    }
};
struct EpiQ {
    static constexpr bool PERM = true, ROWSCALE = true; static constexpr int NSTORE = 0;
    bf16_t* q; const float* slot24; const float* rope;
    __device__ __forceinline__ float rowscale(int row) const { const f32x4* sp = (const f32x4*)(slot24 + (size_t)row * 24); const float ss = (hsum4(sp[0]) + hsum4(sp[1])) + hsum4(sp[2]); return 1.0f / sqrtf(ss * (1.0f / 384.0f) + RMS_EPS); }
    __device__ __forceinline__ void operator()(const AccT& acc, const GUnit& u, int wr, int wc, int fr, int fq, const LAS float* aux) const {
#pragma unroll
        for (int ai = 0; ai < 2; ++ai)
#pragma unroll
            for (int m = 0; m < 4; ++m) { const int row = u.pm * BM + ai * HALF + wr * 64 + m * 16 + fr;
                const float rs = aux[ai * HALF + wr * 64 + m * 16 + fr];
#pragma unroll
                for (int bj = 0; bj < 2; ++bj) { const int cb = u.pn * BM + bj * HALF + wc * 32; const int gb = cb >> 5;
                    f32x4 v0 = acc[ai][bj][m][0] * rs, v1 = acc[ai][bj][m][1] * rs;
                    if (gb % 3 == 2) rope_rot(v0, v1, rope + (size_t)row * 32 + 8 * fq);
                    st_bf16x8(q + (size_t)row * 1536 + cb + 8 * fq, v0, v1); } }
    }
};
struct EpiKV {
    static constexpr bool PERM = true, ROWSCALE = true; static constexpr int NSTORE = 0;
    bf16_t* kb; bf16_t* vb; const float* slot24;
    __device__ __forceinline__ float rowscale(int row) const { const f32x4* sp = (const f32x4*)(slot24 + (size_t)row * 24 + 12); const float ss = hsum4(sp[0]) + hsum4(sp[1]); return 1.0f / sqrtf(ss * (1.0f / 256.0f) + RMS_EPS); }
    __device__ __forceinline__ void operator()(const AccT& acc, const GUnit& u, int wr, int wc, int fr, int fq, const LAS float* aux) const {
#pragma unroll
        for (int ai = 0; ai < 2; ++ai)
#pragma unroll
            for (int m = 0; m < 4; ++m) { const int row = u.pm * BM + ai * HALF + wr * 64 + m * 16 + fr;
                const float rs = aux[ai * HALF + wr * 64 + m * 16 + fr];
#pragma unroll
                for (int bj = 0; bj < 2; ++bj) { const int head = u.pn * 2 + bj;
                    const f32x4 v0 = acc[ai][bj][m][0] * rs, v1 = acc[ai][bj][m][1] * rs;
                    bf16_t* p = (wc < 2) ? kb + (size_t)row * 1536 + head * 96 + wc * 32 + 8 * fq : vb + (size_t)row * 1024 + head * 64 + (wc - 2) * 32 + 8 * fq;
                    st_bf16x8(p, v0, v1); } }
    }
};
#ifndef HB_ONLY
#define HB_ONLY 0
#endif
__device__ __forceinline__ f32x4 hilo_ld(const bf16_t* hi, const bf16_t* lo, size_t off) { const u32x2 a = *(const u32x2*)(hi + off);
#if HB_ONLY
    (void)lo; return (f32x4){bflo(a.x), bfhi(a.x), bflo(a.y), bfhi(a.y)}; }
#else
    const u32x2 b = *(const u32x2*)(lo + off);
    return (f32x4){bflo(a.x) + bflo(b.x), bfhi(a.x) + bfhi(b.x), bflo(a.y) + bflo(b.y), bfhi(a.y) + bfhi(b.y)}; }
#endif
__device__ __forceinline__ void hilo_st(bf16_t* hi, bf16_t* lo, size_t off, f32x4 o) { u32x2 h; h.x = pk2(o[0], o[1]); h.y = pk2(o[2], o[3]);
#if HB_ONLY
    (void)lo; *(u32x2*)(hi + off) = h; }
#else
    const f32x4 r = o - (f32x4){bflo(h.x), bfhi(h.x), bflo(h.y), bfhi(h.y)}; u32x2 l; l.x = pk2(r[0], r[1]); l.y = pk2(r[2], r[3]); *(u32x2*)(hi + off) = h; *(u32x2*)(lo + off) = l; }
#endif
struct EpiRes {
    static constexpr bool PERM = false, ROWSCALE = false; static constexpr int NSTORE = 0;
    const float* basef; bf16_t* hb; bf16_t* lo; float* ssq; const float* colscale; unsigned char* x8; float ascale;
    __device__ __forceinline__ void operator()(const AccT& acc, const GUnit& u, int wr, int wc, int fr, int fq, const LAS float* aux) const {
#pragma unroll
        for (int ai = 0; ai < 2; ++ai)
#pragma unroll
            for (int m = 0; m < 4; ++m) { const int row = u.pm * BM + ai * HALF + wr * 64 + m * 16 + fr; float ss = 0.f;
#pragma unroll
                for (int bj = 0; bj < 2; ++bj)
#pragma unroll
                    for (int n = 0; n < 2; ++n) { const int col = u.pn * BM + bj * HALF + wc * 32 + n * 16 + 4 * fq; const size_t off = (size_t)row * D + col;
                        f32x4 a = acc[ai][bj][m][n] * ascale; if (colscale) a = a * *(const f32x4*)(colscale + col);
                        const f32x4 o = (basef ? *(const f32x4*)(basef + off) : hilo_ld(hb, lo, off)) + a; hilo_st(hb, lo, off, o); ss += sumsq4(o);
                        if (x8) *(unsigned*)(x8 + off) = pk_fp8x4(o[0], o[1], o[2], o[3]); }
                ss = red_fq(ss); if (fq == 0) ssq[(size_t)row * 16 + u.pn * 4 + wc] = ss; }
    }
};
template <bool MOE, bool F8 = false> struct EpiSwiglu {
    static constexpr bool PERM = true, ROWSCALE = true; static constexpr int NSTORE = 8;
    bf16_t* act; const float* rowsrc; int var; float rmul;
    __device__ __forceinline__ float rowscale(int row) const { return (MOE ? rowsrc[row] : rstd16(rowsrc, row)) * rmul; }
    __device__ __forceinline__ void operator()(const AccT& acc, const GUnit& u, int wr, int wc, int fr, int fq, const LAS float* aux) const {
        if (var == 1) return;
        char* blk = (char*)act + (size_t)__builtin_amdgcn_readfirstlane(u.pm * (FF / 128) + u.pn) * (F8 ? 32768 : 65536);
        const unsigned lo = F8 ? (unsigned)((wc * 256 + wr * 64 + fr) * 32 + fq * 8) : (unsigned)((wc * 256 + wr * 64 + fr) * 64 + fq * 16);
#pragma unroll
        for (int ai = 0; ai < 2; ++ai)
#pragma unroll
            for (int m = 0; m < 4; ++m) { const float rs = aux[ai * HALF + wr * 64 + m * 16 + fr];
                f32x4 o[2];
                const float ke = rs * -1.4426950408889634f, s2 = rs * rs * (F8 ? F8_SA : 1.f);
#pragma unroll
                for (int n = 0; n < 2; ++n) { const f32x4 t = acc[ai][0][m][n] * ke, gu = (acc[ai][0][m][n] * acc[ai][1][m][n]) * s2;
                    const f32x4 d = (f32x4){fast_exp2(t[0]), fast_exp2(t[1]), fast_exp2(t[2]), fast_exp2(t[3])} + 1.0f;
                    o[n] = gu * (f32x4){fast_rcp(d[0]), fast_rcp(d[1]), fast_rcp(d[2]), fast_rcp(d[3])}; }
                if constexpr (F8) { u32x2 q; q.x = pk_fp8x4(o[0][0], o[0][1], o[0][2], o[0][3]); q.y = pk_fp8x4(o[1][0], o[1][1], o[1][2], o[1][3]);
                    *(u32x2*)(blk + lo + (unsigned)((ai * HALF + m * 16) * 32)) = q; }
                else st_bf16x8_pol((bf16_t*)(blk + lo + (unsigned)((ai * HALF + m * 16) * 64)), o[0], o[1], ACT_STORE_POL); }
    }
};
struct EpiMoeDown {
    static constexpr bool PERM = true, ROWSCALE = true; static constexpr int NSTORE = 0;
    bf16_t* out; const float* rowgate; bf16_t* out2;
    __device__ __forceinline__ float rowscale(int row) const { return rowgate[row]; }
    __device__ __forceinline__ void operator()(const AccT& acc, const GUnit& u, int wr, int wc, int fr, int fq, const LAS float* aux) const {
#pragma unroll
        for (int ai = 0; ai < 2; ++ai)
#pragma unroll
            for (int m = 0; m < 4; ++m) { const int row = u.pm * BM + ai * HALF + wr * 64 + m * 16 + fr; const float g = aux[ai * HALF + wr * 64 + m * 16 + fr];
#pragma unroll
                for (int bj = 0; bj < 2; ++bj) st_bf16x8((u.kind == 1 ? out2 : out) + (size_t)row * D + u.pn * BM + bj * HALF + wc * 32 + 8 * fq, acc[ai][bj][m][0] * g, acc[ai][bj][m][1] * g); }
    }
};
template <bool GELU0, bool GELU1> struct EpiSplit2 {
    static constexpr bool PERM = true, ROWSCALE = true; static constexpr int NSTORE = 0;
    bf16_t* o0; bf16_t* o1; const float* ssq;
    __device__ __forceinline__ float rowscale(int row) const { return rstd16(ssq, row); }
    __device__ __forceinline__ void operator()(const AccT& acc, const GUnit& u, int wr, int wc, int fr, int fq, const LAS float* aux) const {
        const bool second = u.pn >= 4; bf16_t* ob = second ? o1 : o0; const int ct = (u.pn & 3) * BM; const bool gl = second ? GELU1 : GELU0;
#pragma unroll
        for (int ai = 0; ai < 2; ++ai)
#pragma unroll
            for (int m = 0; m < 4; ++m) { const int row = u.pm * BM + ai * HALF + wr * 64 + m * 16 + fr; const float rs = aux[ai * HALF + wr * 64 + m * 16 + fr];
#pragma unroll
                for (int bj = 0; bj < 2; ++bj) { f32x4 v0 = acc[ai][bj][m][0] * rs, v1 = acc[ai][bj][m][1] * rs;
                    if (gl) {
#pragma unroll
                        for (int i = 0; i < 4; ++i) { v0[i] = gelu_tanh_f(v0[i]); v1[i] = gelu_tanh_f(v1[i]); } }
                    st_bf16x8(ob + (size_t)row * D + ct + bj * HALF + wc * 32 + 8 * fq, v0, v1); } }
    }
};
__device__ __forceinline__ float one_minus_exp(float x) {
    const float t = -x * (1.0f + x * (0.5f + x * (0.16666667f + x * (0.041666668f + x * (0.0083333338f + x * 0.0013888889f)))));
    const float e = 1.0f - fast_exp2(1.4426950408889634f * x); return x > -0.25f ? t : e;
}
struct EpiLruGate {
    static constexpr bool PERM = false, ROWSCALE = false, POST = true; static constexpr int NSTORE = 0;
    unsigned* ab; const bf16_t* xcb; const float* ba; const float* bx; const float* sp8; f32x2* carry;
    __device__ __forceinline__ void post(const GUnit& u, int tid) const {
        const int chunk = tid >> 7, c = u.pn * HALF + (tid & 127); const size_t r0 = (size_t)(u.pm * BM + chunk * 64);
        float A = 1.f, H = 0.f; const unsigned* p = ab + r0 * D + c;
#pragma unroll 1
        for (int t0 = 0; t0 < 64; t0 += 32) { unsigned w[32];
#pragma unroll
            for (int q = 0; q < 32; ++q) w[q] = p[(size_t)(t0 + q) * D];
#pragma unroll
            for (int q = 0; q < 32; ++q) { const float a = fast_exp2(bflo(w[q])), bb = bfhi(w[q]); A *= a; H = a * H + bb; } }
        carry[(r0 >> 6) * D + c] = (f32x2){A, H};
    }
    __device__ __forceinline__ void operator()(const AccT& acc, const GUnit& u, int wr, int wc, int fr, int fq, const LAS float* aux) const {
#pragma unroll
        for (int n = 0; n < 2; ++n) { const int c = u.pn * HALF + wc * 32 + n * 16 + 4 * fq;
            const f32x4 vba = *(const f32x4*)(ba + c), vbx = *(const f32x4*)(bx + c), vsp = *(const f32x4*)(sp8 + c);
#pragma unroll
            for (int ai = 0; ai < 2; ++ai)
#pragma unroll
                for (int m = 0; m < 4; ++m) { const int row = u.pm * BM + ai * HALF + wr * 64 + m * 16 + fr; const size_t off = (size_t)row * D + c;
                    const u32x2 xw = *(const u32x2*)(xcb + off); const f32x4 xc = {bflo(xw.x), bfhi(xw.x), bflo(xw.y), bfhi(xw.y)};
                    const f32x4 rp = acc[ai][0][m][n] + vba, ip = acc[ai][1][m][n] + vbx; f32x4 a, b;
#pragma unroll
                    for (int i = 0; i < 4; ++i) { const float la = -vsp[i] * sigmoid_f(rp[i]); a[i] = 1.4426950408889634f * la; b[i] = sqrtf(one_minus_exp(2.0f * la)) * (sigmoid_f(ip[i]) * xc[i]); }
                    u32x4 w; w.x = pk2(a[0], b[0]); w.y = pk2(a[1], b[1]); w.z = pk2(a[2], b[2]); w.w = pk2(a[3], b[3]); *(u32x4*)(ab + off) = w; } }
    }
};
struct Args { const void* in[35]; float* out; unsigned char* ws; float* hsrc; int ph_lo, ph_hi; unsigned wmask, lmask; int nrep, pad; };
struct Frame {
    LAS unsigned char* lds; unsigned char* ws; const void* const* in; float* h;
    int tid, lane, wave, vcu, G, gw, NGW;
};
#define WSP(T, off) ((T*)(F.ws + (off)))
#define INF(i) ((const float*)F.in[i])

enum { MODE_ID = 0, MODE_GU = 1, MODE_ROPEQ = 2, MODE_ROPELAT = 3 };
struct Fam { const float* src; const float* g; bf16_t* dst; int Ksrc, Kdst, N, Npad, ldt, mode, row_off, ksrc_off; float scale; int f8; };
__device__ __forceinline__ int rope_pos(int d) { return 8 * ((d >> 2) & 3) + 4 * (d >> 4) + (d & 3); }
__device__ __forceinline__ int map_row(int mode, int n) {
    if (mode == MODE_GU) return ((n >> 7) << 8) + (n & 127);
    if (mode == MODE_ROPEQ) { const int head = n / 96, loc = n - head * 96; return loc >= 64 ? head * 96 + 64 + rope_pos(loc - 64) : n; }
    if (mode == MODE_ROPELAT) return (n >= 640 && n < 672) ? 640 + rope_pos(n - 640) : n;
    return n;
}
#if WLAYOUT
__device__ __forceinline__ void conv_item(const Fam& f, int item, int lane) {
    const int nblk = (f.Npad + 63) >> 6, kb = item / nblk, nb = item - kb * nblk, k0 = 64 * kb, n = nb * 64 + lane;
    float v[64];
    const bool okn = n < f.N;
#pragma unroll
    for (int r = 0; r < 64; ++r) { const int srow = k0 + r - f.ksrc_off; v[r] = 0.f; if (okn && srow >= 0 && srow < f.Ksrc) v[r] = f.src[(size_t)srow * f.N + n]; }
#pragma unroll
    for (int r = 0; r < 64; ++r) { const int srow = k0 + r - f.ksrc_off; const float gk = (f.g && srow >= 0 && srow < f.Ksrc) ? f.g[srow] * f.scale : f.scale; v[r] *= gk; }
    if (n < f.Npad) {
        const int drow = map_row(f.mode, n) + f.row_off;
        bf16_t* dp = f.dst + ((size_t)(drow >> 8) * (btile_bytes(f.Kdst) / 2)) + ((size_t)(8 * kb) * 256 + (drow & 255)) * 8;
#pragma unroll
        for (int q = 0; q < 8; ++q) { u32x4 o; o.x = pk2(v[8 * q + 0], v[8 * q + 1]); o.y = pk2(v[8 * q + 2], v[8 * q + 3]); o.z = pk2(v[8 * q + 4], v[8 * q + 5]); o.w = pk2(v[8 * q + 6], v[8 * q + 7]);
            *(u32x4*)(dp + (size_t)q * 2048) = o; } }
}
#else
#ifdef CONV_NT
#define CONV_LD(p) __builtin_nontemporal_load(p)
#else
#define CONV_LD(p) (*(p))
#endif
__device__ __forceinline__ void conv_load(const Fam& f, int item, int lane, f32x4 (&v)[16]) {
    const int nblk = f.Npad / 64, kb = item / nblk, nb = item - kb * nblk, k0 = 64 * kb, n0 = 64 * nb;
    const int col = n0 + 4 * (lane & 15);
#pragma unroll
    for (int i = 0; i < 16; ++i) { const int kk = 4 * i + (lane >> 4), srow = k0 + kk - f.ksrc_off;
        v[i] = (f32x4){0.f, 0.f, 0.f, 0.f};
        if (srow >= 0 && srow < f.Ksrc && col < f.N) v[i] = CONV_LD((const f32x4*)(f.src + (size_t)srow * f.N + col)); }
}
__device__ __forceinline__ void conv_store(const Fam& f, LAS float* scr, int item, int lane, const f32x4 (&v)[16]) {
    const int nblk = f.Npad / 64, kb = item / nblk, nb = item - kb * nblk, k0 = 64 * kb, n0 = 64 * nb;
#pragma unroll
    for (int i = 0; i < 16; ++i) { const int kk = 4 * i + (lane >> 4); LAS float* s = scr + kk * 65 + 4 * (lane & 15); s[0] = v[i][0]; s[1] = v[i][1]; s[2] = v[i][2]; s[3] = v[i][3]; }
    asm volatile("s_waitcnt lgkmcnt(0)" ::: "memory");
    const int c = lane & 7; float gk[8];
#pragma unroll
    for (int t = 0; t < 8; ++t) { const int srow = k0 + 8 * c + t - f.ksrc_off; gk[t] = (f.g && srow >= 0 && srow < f.Ksrc) ? f.g[srow] * f.scale : f.scale; }
#pragma unroll
    for (int j = 0; j < 8; ++j) { const int n = (lane >> 3) + 8 * j; const LAS float* s = scr + (8 * c) * 65 + n;
        u32x4 o; o.x = pk2(s[0 * 65] * gk[0], s[1 * 65] * gk[1]); o.y = pk2(s[2 * 65] * gk[2], s[3 * 65] * gk[3]); o.z = pk2(s[4 * 65] * gk[4], s[5 * 65] * gk[5]); o.w = pk2(s[6 * 65] * gk[6], s[7 * 65] * gk[7]);
        const int drow = map_row(f.mode, n0 + n) + f.row_off;
        if (f.f8) { u32x2 q; q.x = pk_fp8x4(s[0 * 65] * gk[0], s[1 * 65] * gk[1], s[2 * 65] * gk[2], s[3 * 65] * gk[3]); q.y = pk_fp8x4(s[4 * 65] * gk[4], s[5 * 65] * gk[5], s[6 * 65] * gk[6], s[7 * 65] * gk[7]);
            *(u32x2*)((char*)f.dst + (size_t)drow * f.ldt + k0 + 8 * c) = q; }
        else *(u32x4*)(f.dst + (size_t)drow * f.ldt + k0 + 8 * c) = o; }
    asm volatile("s_waitcnt lgkmcnt(0)" ::: "memory");
}
#endif
constexpr int NFAM = 17;
__device__ __forceinline__ int fam_count(int f) { return (f == 5 || f == 6) ? 8 : (f == 8) ? 4 : (f >= 11 && f <= 13) ? 2 : (f >= 14) ? 16 : 1; }
__device__ __forceinline__ Fam get_fam(const Frame& F, int f, int j) {
    Fam r; r.g = nullptr; r.mode = MODE_ID; r.row_off = 0; r.ksrc_off = 0; r.scale = 1.f; r.f8 = 0;
    const float* norm_mix = INF(2); const float* norm_ffn = INF(3);
    switch (f) {
    case 0: r.src = INF(5); r.g = norm_mix; r.dst = WSP(bf16_t, W_MLA_IN); r.Ksrc = r.Kdst = 1024; r.N = 672; r.Npad = 768; r.ldt = 768; r.mode = MODE_ROPELAT; break;
    case 1: r.src = INF(8); r.g = INF(6); r.dst = WSP(bf16_t, W_UQ); r.Ksrc = r.Kdst = 384; r.N = r.Npad = 1536; r.ldt = 1536; r.mode = MODE_ROPEQ; r.scale = 0.10206207261596575f * 1.4426950408889634f; break;
    case 2: r.src = INF(9); r.g = INF(7); r.dst = WSP(bf16_t, W_UKV); r.Ksrc = r.Kdst = 256; r.N = r.Npad = 2048; r.ldt = 2048; break;
    case 3: r.src = INF(10); r.dst = WSP(bf16_t, W_O); r.Ksrc = r.Kdst = 1024; r.N = r.Npad = 1024; r.ldt = 1024; break;
    case 4: r.src = INF(11); r.g = norm_mix + 1024; r.dst = WSP(bf16_t, W_LRU_IN); r.Ksrc = r.Kdst = 1024; r.N = r.Npad = 2048; r.ldt = 2048; break;
    case 5: case 6: r.src = INF(f == 5 ? 14 : 16) + (size_t)j * 16384; r.dst = WSP(bf16_t, W_LRU_G) + (size_t)j * (btile_bytes(256) / 2); r.Ksrc = 128; r.Kdst = 256; r.N = r.Npad = 128; r.ldt = 256; r.row_off = (f == 6) ? 128 : 0; r.ksrc_off = (j & 1) * 128; break;
    case 7: r.src = INF(19); r.dst = WSP(bf16_t, W_LRU_OUT); r.Ksrc = r.Kdst = 1024; r.N = r.Npad = 1024; r.ldt = 1024; break;
    case 8: r.src = INF(20) + (size_t)j * 65536; r.dst = WSP(bf16_t, W_POOL) + (size_t)j * (btile_bytes(256) / 2); r.Ksrc = r.Kdst = 256; r.N = r.Npad = 256; r.ldt = 256; break;
    case 9: r.src = INF(22); r.g = norm_mix + 3072; r.dst = WSP(bf16_t, W_GM_IN); r.Ksrc = r.Kdst = 1024; r.N = r.Npad = 2048; r.ldt = 2048; break;
    case 10: r.src = INF(27); r.dst = WSP(bf16_t, W_GM_OUT); r.Ksrc = r.Kdst = 1024; r.N = r.Npad = 1024; r.ldt = 1024; break;
    case 11: case 12: r.src = INF(f == 11 ? 28 : 29) + (size_t)j * D * FF; r.g = norm_ffn + 2048 * j; r.dst = (bf16_t*)(F.ws + W_FFN + (size_t)j * WSTRIDE); r.Ksrc = r.Kdst = 1024; r.N = r.Npad = FF; r.ldt = 2 * FF; r.mode = MODE_GU; r.row_off = (f == 12) ? 128 : 0; if (ffn_f8(j)) { r.f8 = 1; r.scale = F8_SW; } break;
    case 13: r.src = INF(30) + (size_t)j * D * FF; r.dst = (bf16_t*)(F.ws + W_FFN + (size_t)j * WSTRIDE + WDOWN_OFF); r.Ksrc = r.Kdst = FF; r.N = r.Npad = 1024; r.ldt = 1024; if (ffn_f8(j)) { r.f8 = 1; r.scale = F8_SW; } break;
    case 14: case 15: r.src = INF(f == 14 ? 32 : 33) + (size_t)j * D * FF; r.g = norm_ffn + 1024 + 2048 * (j >> 3); r.dst = (bf16_t*)(F.ws + W_MOE + (size_t)j * WSTRIDE); r.Ksrc = r.Kdst = 1024; r.N = r.Npad = FF; r.ldt = 2 * FF; r.mode = MODE_GU; r.row_off = (f == 15) ? 128 : 0; if (moe_f8(j >> 3)) { r.f8 = 1; r.scale = F8_SW; } break;
    default: r.src = INF(34) + (size_t)j * D * FF; r.dst = (bf16_t*)(F.ws + W_MOE + (size_t)j * WSTRIDE + WDOWN_OFF); r.Ksrc = r.Kdst = FF; r.N = r.Npad = 1024; r.ldt = 1024; if (moe_f8(j >> 3)) { r.f8 = 1; r.scale = F8_SW; } break;
    }
#if !WLAYOUT
    r.ldt = r.Kdst + BPAD;
#endif
    return r;
}
__device__ __forceinline__ void stats_row(const Frame& F, const float* src, int row, float* rstd_out) {
    const f32x4* xr = (const f32x4*)(src + (size_t)row * D) + F.lane; f32x4 v[4]; float s = 0.f;
#pragma unroll
    for (int j = 0; j < 4; ++j) { v[j] = xr[64 * j]; s += sumsq4(v[j]); }
    s = wave_sum(s);
    bf16_t* hb = WSP(bf16_t, WS_HB) + (size_t)row * D + 4 * F.lane;
#pragma unroll
    for (int j = 0; j < 4; ++j) st_bf16x4(hb + 256 * j, v[j]);
    if (F.lane < 16) WSP(float, WS_SSQ)[(size_t)row * 16 + F.lane] = F.lane == 0 ? s : 0.f;
    if (rstd_out && F.lane == 0) rstd_out[row] = 1.0f / sqrtf(s * (1.0f / 1024.0f) + RMS_EPS);
}
__device__ __forceinline__ void phase_prologue(const Frame& F, unsigned wmask, unsigned lmask, const float* hsrc) {
#if WLAYOUT
    int base = 0;
    for (int f = 0; f < NFAM; ++f) { if (!((wmask >> f) & 1u)) continue;
        const int cnt = fam_count(f);
        for (int j = 0; j < cnt; ++j) {
            if (f >= 11 && f <= 13 && !((lmask >> j) & 1u)) continue;
            if (f >= 14 && !((lmask >> (2 + (j >> 3))) & 1u)) continue;
            const Fam fm = get_fam(F, f, j); const int nitems = (fm.Kdst / 64) * ((fm.Npad + 63) >> 6);
            for (int it = (F.gw + F.NGW - base % F.NGW) % F.NGW; it < nitems; it += F.NGW) conv_item(fm, it, F.lane);
            base += nitems; } }
#else
    { LAS float* scr = (LAS float*)(F.lds + F.wave * 16640);
      int cf = -1, cj = 0, cbase = 0, cn = 0; Fam cfm;
      auto seek = [&](int g) -> bool {
          while (cf < NFAM && (cf < 0 || g >= cbase + cn)) {
              if (cf >= 0) { cbase += cn; ++cj; if (cj >= fam_count(NFAM - 1 - cf)) { ++cf; cj = 0; } } else { cf = 0; cj = 0; }
              cn = 0;
              while (cf < NFAM) { const int rf = NFAM - 1 - cf;
                  const bool en = ((wmask >> rf) & 1u) && !(rf >= 11 && rf <= 13 && !((lmask >> cj) & 1u)) && !(rf >= 14 && !((lmask >> (2 + (cj >> 3))) & 1u));
                  if (en) break; ++cj; if (cj >= fam_count(rf)) { ++cf; cj = 0; } }
              if (cf < NFAM) { cfm = get_fam(F, NFAM - 1 - cf, cj); cn = (cfm.Kdst / 64) * (cfm.Npad / 64); } }
          return cf < NFAM; };
      f32x4 va[16], vb[16]; Fam fa, fb; int ia = 0, ib = 0; int p = F.gw;
      bool ha = seek(2 * p); if (ha) { fa = cfm; ia = 2 * p - cbase; conv_load(fa, ia, F.lane, va); }
      while (ha) {
          const bool hb = seek(2 * p + 1); if (hb) { fb = cfm; ib = 2 * p + 1 - cbase; conv_load(fb, ib, F.lane, vb); }
          conv_store(fa, scr, ia, F.lane, va);
          p += F.NGW;
          ha = seek(2 * p); if (ha) { fa = cfm; ia = 2 * p - cbase; conv_load(fa, ia, F.lane, va); }
          if (hb) conv_store(fb, scr, ib, F.lane, vb); } }
#endif
    const int gt = F.vcu * NTHR + F.tid, NT = F.G * NTHR;
    if ((wmask >> 17) & 1u) {
        for (int i = gt; i < M * 16; i += NT) { const int row = i >> 4, j = i & 15; const float inv = powf(10000.0f, -(float)j / 16.0f); const float ang = (float)((const int*)F.in[1])[row] * inv;
            WSP(float, WS_ROPE)[2 * i] = cosf(ang); WSP(float, WS_ROPE)[2 * i + 1] = sinf(ang); }
        for (int i = gt; i < D; i += NT) WSP(float, WS_SP8)[i] = 8.0f * log1pf(expf(-INF(18)[i]));
        for (int i = gt; i < 2 * D * NE; i += NT) { const int l = i / (D * NE), c = (i / NE) % D; WSP(float, WS_ROUTW)[i] = INF(3)[(1 + 2 * l) * D + c] * INF(31)[i]; }
        for (int i = gt; i < 4 * 128 * 128; i += NT) { const int t = (i >> 7) & 127, s = i & 127; WSP(bf16_t, W_GM_S)[i] = (bf16_t)(pk2(s <= t ? INF(25)[i] : 0.f, 0.f) & 0xffffu); }
    }
    if (hsrc) for (int row = F.gw; row < M; row += F.NGW) stats_row(F, hsrc, row, WSP(float, WS_RSTD));
}

__device__ __forceinline__ void phase_conv(const Frame& F) {
    const bf16_t* xbr = WSP(bf16_t, B_XBR); bf16_t* xcb = WSP(bf16_t, B_XCB); const float* cw = INF(12); const float* cb = INF(13);
    const int gt = F.vcu * NTHR + F.tid, NT = F.G * NTHR;
    for (int i = gt; i < (M / 4) * (D / 8); i += NT) { const int r0 = (i >> 7) * 4, c = (i & 127) * 8, t0 = r0 & (S - 1);
        u32x4 w[7];
#pragma unroll
        for (int q = 0; q < 7; ++q) { w[q] = (u32x4){0u, 0u, 0u, 0u}; if (t0 - 3 + q >= 0) w[q] = *(const u32x4*)(xbr + (size_t)(r0 - 3 + q) * D + c); }
        f32x4 wv[4][2]; const f32x4 b0 = *(const f32x4*)(cb + c), b1 = *(const f32x4*)(cb + c + 4);
#pragma unroll
        for (int jj = 0; jj < 4; ++jj) { wv[jj][0] = *(const f32x4*)(cw + jj * D + c); wv[jj][1] = *(const f32x4*)(cw + jj * D + c + 4); }
#pragma unroll
        for (int rr = 0; rr < 4; ++rr) { f32x4 a0 = b0, a1 = b1;
#pragma unroll
            for (int jj = 0; jj < 4; ++jj) { const u32x4 x = w[rr + jj];
                a0 += wv[jj][0] * (f32x4){bflo(x.x), bfhi(x.x), bflo(x.y), bfhi(x.y)}; a1 += wv[jj][1] * (f32x4){bflo(x.z), bfhi(x.z), bflo(x.w), bfhi(x.w)}; }
            u32x4 o; o.x = pk2(a0[0], a0[1]); o.y = pk2(a0[2], a0[3]); o.z = pk2(a1[0], a1[1]); o.w = pk2(a1[2], a1[3]);
            *(u32x4*)(xcb + (size_t)(r0 + rr) * D + c) = o; } }
}
__device__ __forceinline__ void phase_scan1(const Frame& F) {
    const unsigned* ab = WSP(unsigned, B_AF); f32x2* carry = WSP(f32x2, WS_CARRY);
    const int gt = F.vcu * NTHR + F.tid, NT = F.G * NTHR;
    for (int i = gt; i < NB * 64 * D; i += NT) { const int c = i & (D - 1), ch = (i >> 10) & 63, b = i >> 16; const size_t r0 = ((size_t)b * S + ch * 64) * D + c;
        float A = 1.f, H = 0.f;
#pragma unroll 8
        for (int t = 0; t < 64; ++t) { const unsigned w = ab[r0 + (size_t)t * D]; const float a = fast_exp2(bflo(w)), bb = bfhi(w); A *= a; H = a * H + bb; }
        carry[i] = (f32x2){A, H}; }
}
__device__ __forceinline__ void phase_scan2(const Frame& F) {
    const u32x2* ab = WSP(u32x2, B_AF); const f32x4* carry = WSP(f32x4, WS_CARRY);
    const unsigned* gate = WSP(unsigned, B_GATEB); unsigned* yb = WSP(unsigned, B_YB);
    const int gt = F.vcu * NTHR + F.tid, NT = F.G * NTHR;
    for (int i = gt; i < NB * 64 * (D / 2); i += NT) { const int c2 = i & (D / 2 - 1), ch = (i >> 9) & 63, b = i >> 15; const size_t r0 = (((size_t)b * S + ch * 64) * D) / 2 + c2;
        float H0 = 0.f, H1 = 0.f;
        for (int k0 = 0; k0 < ch; k0 += 16) { f32x4 cv[16];
#pragma unroll
            for (int q = 0; q < 16; ++q) { const int k = (k0 + q) < 63 ? (k0 + q) : 63; cv[q] = carry[((size_t)(b * 64 + k) * D) / 2 + c2]; }
#pragma unroll
            for (int q = 0; q < 16; ++q) if (k0 + q < ch) { H0 = cv[q][0] * H0 + cv[q][1]; H1 = cv[q][2] * H1 + cv[q][3]; } }
#pragma unroll 1
        for (int t0 = 0; t0 < 64; t0 += 16) { u32x2 w[16]; unsigned g[16];
#pragma unroll
            for (int q = 0; q < 16; ++q) { const size_t o = r0 + (size_t)(t0 + q) * (D / 2); w[q] = ab[o]; g[q] = gate[o]; }
#pragma unroll
            for (int q = 0; q < 16; ++q) { const size_t o = r0 + (size_t)(t0 + q) * (D / 2);
                H0 = fast_exp2(bflo(w[q].x)) * H0 + bfhi(w[q].x); H1 = fast_exp2(bflo(w[q].y)) * H1 + bfhi(w[q].y);
                yb[o] = pk2(H0 * bflo(g[q]), H1 * bfhi(g[q])); } }
    }
}
__device__ __forceinline__ void phase_router(const Frame& F, int l) {
    const float* rw = WSP(float, WS_ROUTW) + (size_t)l * D * NE; const bf16_t* hhi = WSP(bf16_t, WS_HB); const bf16_t* hlo = WSP(bf16_t, WS_LO);
    LAS int* se = (LAS int*)F.lds;
    unsigned* gcnt = WSP(unsigned, WS_CTL) + CW_MOECNT + 64 * l;
    const int tpw = (M + F.G - 1) / F.G;
    const int t0 = (int)blockIdx.x * tpw;
    for (int k = F.wave; k < tpw; k += NWAVES) { const int tok = t0 + k; if (tok >= M) break;
        float s[8];
#pragma unroll
        for (int e = 0; e < 8; ++e) s[e] = 0.f;
        float ss = 0.f;
#pragma unroll
        for (int j = 0; j < 4; ++j) { const int c0 = 256 * j + 4 * F.lane; const f32x4 x = hilo_ld(hhi, hlo, (size_t)tok * D + c0); ss += sumsq4(x);
#pragma unroll
            for (int i = 0; i < 4; ++i) { const f32x4 w0 = *(const f32x4*)(rw + (size_t)(c0 + i) * 8), w1 = *(const f32x4*)(rw + (size_t)(c0 + i) * 8 + 4);
                s[0] += x[i] * w0[0]; s[1] += x[i] * w0[1]; s[2] += x[i] * w0[2]; s[3] += x[i] * w0[3]; s[4] += x[i] * w1[0]; s[5] += x[i] * w1[1]; s[6] += x[i] * w1[2]; s[7] += x[i] * w1[3]; } }
        ss = wave_sum(ss);
#pragma unroll
        for (int e = 0; e < 8; ++e) s[e] = wave_sum(s[e]);
        const float rs = 1.0f / sqrtf(ss * (1.0f / 1024.0f) + RMS_EPS);
        int e1 = 0; float v1 = s[0];
#pragma unroll
        for (int e = 1; e < 8; ++e) if (s[e] > v1) { v1 = s[e]; e1 = e; }
        int e2 = 0; float v2 = -INFINITY;
#pragma unroll
        for (int e = 0; e < 8; ++e) if (e != e1 && s[e] > v2) { v2 = s[e]; e2 = e; }
        const float g1 = 1.0f / (1.0f + expf((v2 - v1) * rs));
        if (F.lane == 0) { se[2 * k] = e1; se[2 * k + 1] = e2; WSP(f32x2, WS_TOKG)[tok] = (f32x2){g1, 1.0f - g1}; WSP(float, WS_RSTD)[tok] = rs; }
    }
    __syncthreads();
    if (F.wave == 0) { const int tok = t0 + F.lane; const bool valid = F.lane < tpw && tok < M;
        const int e1 = valid ? se[2 * F.lane] : -1, e2 = valid ? se[2 * F.lane + 1] : -1; int lr1 = 0, lr2 = 0;
        const unsigned long long lt = (1ull << F.lane) - 1ull;
#pragma unroll
        for (int e = 0; e < 8; ++e) { const unsigned long long m1 = __ballot(e1 == e), m2 = __ballot(e2 == e);
            const int before = __popcll(m1 & lt) + __popcll(m2 & lt); if (e1 == e) lr1 = before; if (e2 == e) lr2 = before;
            const int tot = __popcll(m1) + __popcll(m2);
            if (F.lane == e) { if (tot) (void)__hip_atomic_fetch_add(gcnt + e, (unsigned)tot, __ATOMIC_RELAXED, __HIP_MEMORY_SCOPE_AGENT); WSP(int, WS_WGBASE)[blockIdx.x * 8 + e] = tot; } }
        if (valid) { int* ti = WSP(int, WS_TOKINFO) + 4 * (size_t)tok; ti[0] = e1; ti[1] = lr1; ti[2] = e2; ti[3] = lr2; }
    }
    __syncthreads();
}
__device__ __forceinline__ int moe_layout(const Frame& F, int l, int* pstart_rows, int* pend) {
    const unsigned* gcnt = WSP(unsigned, WS_CTL) + CW_MOECNT + 64 * l; int p = 0;
#pragma unroll
    for (int e = 0; e < NE; ++e) { const int c = (int)__hip_atomic_load(gcnt + e, __ATOMIC_RELAXED, __HIP_MEMORY_SCOPE_AGENT); pstart_rows[e] = p * 256; p += (c + 255) >> 8; pend[e] = p; }
    return p;
}
__device__ __forceinline__ void phase_gather(const Frame& F, int l) {
    int ps[NE], pe[NE]; (void)moe_layout(F, l, ps, pe);
    const int tpw = (M + F.G - 1) / F.G;
    LAS int* lbase = (LAS int*)F.lds;
    { const int e = F.wave; int v[4]; int run = 0;
#pragma unroll
      for (int q = 0; q < 4; ++q) { const int w = 4 * F.lane + q; v[q] = w < F.G ? WSP(int, WS_WGBASE)[w * 8 + e] : 0; }
      const int tot4 = (v[0] + v[1]) + (v[2] + v[3]); int incl = tot4;
#pragma unroll
      for (int o = 1; o < 64; o <<= 1) { const int t = __shfl_up(incl, o); if (F.lane >= o) incl += t; }
      run = incl - tot4;
#pragma unroll
      for (int q = 0; q < 4; ++q) { const int w = 4 * F.lane + q; if (w < F.G) lbase[w * 8 + e] = run; run += v[q]; } }
    __syncthreads();
    int* rowtok = WSP(int, WS_ROWTOK);
    for (int tok = F.gw; tok < M; tok += F.NGW) { const int wg = tok / tpw;
        const int* ti = WSP(int, WS_TOKINFO) + 4 * (size_t)tok; const int e1 = ti[0], lr1 = ti[1], e2 = ti[2], lr2 = ti[3];
        int d1 = 0, d2 = 0;
#pragma unroll
        for (int e = 0; e < NE; ++e) { const int b = lbase[wg * 8 + e]; if (e == e1) d1 = ps[e] + b + lr1; if (e == e2) d2 = ps[e] + b + lr2; }
#if !MUP_GATHER
        { const u32x4* src = (const u32x4*)(WSP(bf16_t, WS_HB) + (size_t)tok * D) + F.lane; const u32x4 a = src[0], b = src[64]; bf16_t* xg = WSP(bf16_t, B_XG);
          if (moe_f8(l)) {
              const float q = WSP(float, WS_RSTD)[tok] * F8_SX; u32x2 pa, pb;
              pa.x = pk_fp8x4(bflo(a.x) * q, bfhi(a.x) * q, bflo(a.y) * q, bfhi(a.y) * q); pa.y = pk_fp8x4(bflo(a.z) * q, bfhi(a.z) * q, bflo(a.w) * q, bfhi(a.w) * q);
              pb.x = pk_fp8x4(bflo(b.x) * q, bfhi(b.x) * q, bflo(b.y) * q, bfhi(b.y) * q); pb.y = pk_fp8x4(bflo(b.z) * q, bfhi(b.z) * q, bflo(b.w) * q, bfhi(b.w) * q);
              u32x2* o1 = (u32x2*)((char*)xg + (size_t)d1 * D) + F.lane; u32x2* o2 = (u32x2*)((char*)xg + (size_t)d2 * D) + F.lane; o1[0] = pa; o1[64] = pb; o2[0] = pa; o2[64] = pb;
          } else {
          u32x4* o1 = (u32x4*)(xg + (size_t)d1 * D) + F.lane; u32x4* o2 = (u32x4*)(xg + (size_t)d2 * D) + F.lane; o1[0] = a; o1[64] = b; o2[0] = a; o2[64] = b; } }
#endif
        if (F.lane == 0) { const f32x2 g = WSP(f32x2, WS_TOKG)[tok]; const float rs = WSP(float, WS_RSTD)[tok];
            rowtok[d1] = tok; rowtok[d2] = tok;
            const float rsc = moe_f8(l) ? 1.f / (F8_SX * F8_SW) : rs, gsc = moe_f8(l) ? 1.f / (F8_SA * F8_SW) : 1.f;
            WSP(float, WS_ROWSCALE)[d1] = rsc; WSP(float, WS_ROWSCALE)[d2] = rsc; WSP(float, WS_ROWGATE)[d1] = g.x * gsc; WSP(float, WS_ROWGATE)[d2] = g.y * gsc;
            WSP(int, WS_DEST)[2 * tok] = d1; WSP(int, WS_DEST)[2 * tok + 1] = d2; }
    }
    if (blockIdx.x < NE) {
        const int e = (int)blockIdx.x; const int cnt = (int)__hip_atomic_load(WSP(unsigned, WS_CTL) + CW_MOECNT + 64 * l + e, __ATOMIC_RELAXED, __HIP_MEMORY_SCOPE_AGENT);
        int pse = 0, pee = 0;
#pragma unroll
        for (int k = 0; k < NE; ++k) if (k == e) { pse = ps[k]; pee = pe[k] * 256; }
        for (int r = pse + cnt + F.tid; r < pee; r += NTHR) { rowtok[r] = 0; WSP(float, WS_ROWSCALE)[r] = 0.f; WSP(float, WS_ROWGATE)[r] = 0.f; } }
}
__device__ __forceinline__ unsigned sk_split_mask(const Frame& F, int l) {
#if MDN_STREAMK
    if (F.G != 256) return 0u;
    int ps[NE], pe[NE]; const int NP = moe_layout(F, l, ps, pe); const int P = moe_f8(l) ? FF / 256 : FF / 128, T = ((NP + 7) >> 3) * P; unsigned m = 0u;
#pragma unroll
    for (int x = 1; x < 8; ++x) { const int s = (x * T) >> 3; if (s % P) m |= 1u << (s / P); }
    return m;
#else
    return 0u;
#endif
}
template <bool FINAL> __device__ __forceinline__ void phase_combine(const Frame& F, const float oscale, const int l) {
    const bf16_t* om = WSP(bf16_t, B_OUTM); const bf16_t* om2 = (const bf16_t*)(F.ws + WS_SK); const float* gfin = INF(4);
#ifdef SK_E1
    const unsigned smask = 0u; (void)l;
#else
    const unsigned smask = sk_split_mask(F, l);
#endif
    for (int tok = F.gw; tok < M; tok += F.NGW) {
        const int* ti = WSP(int, WS_TOKINFO) + 4 * (size_t)tok; const int e1 = ti[0], e2 = ti[2]; int d1 = WSP(int, WS_DEST)[2 * tok], d2 = WSP(int, WS_DEST)[2 * tok + 1];
        if (e2 < e1) { const int t = d1; d1 = d2; d2 = t; }
        f32x4 v[4]; float s = 0.f;
#pragma unroll
        for (int j = 0; j < 4; ++j) { const int c = 256 * j + 4 * F.lane; const f32x4 x = hilo_ld(WSP(bf16_t, WS_HB), WSP(bf16_t, WS_LO), (size_t)tok * D + c);
            const u32x2 a = *(const u32x2*)(om + (size_t)d1 * D + c), b = *(const u32x2*)(om + (size_t)d2 * D + c);
            f32x4 ya = (f32x4){bflo(a.x), bfhi(a.x), bflo(a.y), bfhi(a.y)}, yb = (f32x4){bflo(b.x), bfhi(b.x), bflo(b.y), bfhi(b.y)};
            if ((smask >> (d1 >> 11)) & 1u) { const u32x2 a2 = *(const u32x2*)(om2 + (size_t)d1 * D + c); ya += (f32x4){bflo(a2.x), bfhi(a2.x), bflo(a2.y), bfhi(a2.y)}; }
            if ((smask >> (d2 >> 11)) & 1u) { const u32x2 b2 = *(const u32x2*)(om2 + (size_t)d2 * D + c); yb += (f32x4){bflo(b2.x), bfhi(b2.x), bflo(b2.y), bfhi(b2.y)}; }
            v[j] = x + (ya + yb); s += sumsq4(v[j]); }
        s = wave_sum(s); const float rs = 1.0f / sqrtf(s * (1.0f / 1024.0f) + RMS_EPS);
        if (FINAL) {
#pragma unroll
            for (int j = 0; j < 4; ++j) { const int c = 256 * j + 4 * F.lane; *(f32x4*)(F.h + (size_t)tok * D + c) = v[j] * (rs * oscale) * *(const f32x4*)(gfin + c); }
        } else {
#pragma unroll
            for (int j = 0; j < 4; ++j) { const int c = 256 * j + 4 * F.lane; hilo_st(WSP(bf16_t, WS_HB), WSP(bf16_t, WS_LO), (size_t)tok * D + c, v[j]); }
            if (F.lane < 16) WSP(float, WS_SSQ)[(size_t)tok * 16 + F.lane] = F.lane == 0 ? s : 0.f;
            if (F.lane == 0) WSP(float, WS_RSTD)[tok] = rs;
        }
    }
}
__device__ __forceinline__ void phase_pool(const Frame& F) {
    const float* rstd = WSP(float, WS_RSTD); const float* g = INF(2) + 2 * D; bf16_t* po = WSP(bf16_t, B_POOLED);
    const int gt = F.vcu * NTHR + F.tid, NT = F.G * NTHR;
    for (int i = gt; i < (M / 32) * (D / 4); i += NT) { const int c = (i & 255) * 4, rb = (i >> 8) * 32, t0 = rb & (S - 1); const int w = 2 << (c >> 8);
        const f32x4 gv = *(const f32x4*)(g + c); f32x4 sum = {0.f, 0.f, 0.f, 0.f};
        const int warm = t0 < w - 1 ? t0 : w - 1;
        const bf16_t* hhi = WSP(bf16_t, WS_HB); const bf16_t* hlo = WSP(bf16_t, WS_LO);
        for (int k = warm; k >= 1; --k) sum += hilo_ld(hhi, hlo, (size_t)(rb - k) * D + c) * rstd[rb - k];
#pragma unroll 1
        for (int r0 = 0; r0 < 32; r0 += 8) { f32x4 sv[8], ov[8];
#pragma unroll
            for (int q = 0; q < 8; ++q) { const int row = rb + r0 + q; const bool has = t0 + r0 + q + 1 >= w; const int ro = has ? row - w + 1 : row;
                sv[q] = hilo_ld(hhi, hlo, (size_t)row * D + c) * rstd[row]; ov[q] = hilo_ld(hhi, hlo, (size_t)ro * D + c) * (has ? rstd[ro] : 0.f); }
#pragma unroll
            for (int q = 0; q < 8; ++q) { const int row = rb + r0 + q, t = t0 + r0 + q; sum += sv[q];
                const int n = t + 1 < w ? t + 1 : w;
                const f32x4 o = (sum * (1.0f / (float)n) - sv[q]) * gv; st_bf16x4(po + (size_t)row * D + c, o);
                sum -= ov[q]; } }
    }
}
typedef short v4i16_t __attribute__((ext_vector_type(4)));
__device__ __forceinline__ int crow(int r, int hi) { return (r & 3) + 8 * (r >> 2) + 4 * hi; }
__device__ __forceinline__ s16x4 vtr(const LAS unsigned char* p) { return __builtin_bit_cast(s16x4, __builtin_amdgcn_ds_read_tr16_b64_v4i16((LAS v4i16_t*)p)); }
__device__ __forceinline__ bf16x8 pack8(const f32x16& p, int b) { u32x4 w; w.x = pk2(p[b], p[b + 1]); w.y = pk2(p[b + 2], p[b + 3]); w.z = pk2(p[b + 4], p[b + 5]); w.w = pk2(p[b + 6], p[b + 7]); return __builtin_bit_cast(bf16x8, w); }
__device__ __forceinline__ void glds16s(const char* base  , unsigned voff, unsigned lds_dst  ) { unsigned keep;
    asm volatile("s_mov_b32 %0, m0\n\ts_mov_b32 m0, %3\n\ts_nop 0\n\tglobal_load_lds_dwordx4 %1, %2\n\ts_mov_b32 m0, %0" : "=&s"(keep) : "v"(voff), "s"(base), "s"(lds_dst) : "memory"); }
#ifndef ATT_THR
#define ATT_THR 8.0f
#endif
constexpr int AT_KROW = 208, AT_KBYTES = 13 * 1024  , AT_VBYTES = 8192, AT_KOFF = 0, AT_VOFF = 3 * AT_KBYTES, AT_WSF = 3 * AT_KBYTES + 3 * AT_VBYTES;
__device__ __forceinline__ void attn_unit(const Frame& F, int bh, int qb, const int att_var) {
    const int b = bh >> 4, h = bh & 15, lane = F.lane, r = lane & 31, hh = lane >> 5, wid = F.wave, tid = F.tid;
    const bf16_t* Q = WSP(bf16_t, B_Q); const bf16_t* KB = WSP(bf16_t, B_KB); const bf16_t* VB = WSP(bf16_t, B_VB); bf16_t* OB = WSP(bf16_t, B_OB);
    const size_t rowbase = (size_t)b * S; const int q0 = qb * 256; const int qrow = q0 + 32 * wid + r;
    bf16x8 qf[6];
    { const bf16_t* qp = Q + (rowbase + qrow) * 1536 + h * 96 + 8 * hh;
#pragma unroll
      for (int ks = 0; ks < 6; ++ks) qf[ks] = *(const bf16x8*)(qp + 16 * ks); }
    const int NT = 4 * (qb + 1);
    const int kc0 = wid * 64 + lane, kc1 = 512 + wid * 64 + lane;
    const int kr0 = kc0 / 13, kq0 = kc0 - kr0 * 13, kr1 = kc1 / 13, kq1 = kc1 - kr1 * 13; const bool has1 = wid < 5;
    const unsigned koff0 = (unsigned)(kr0 * 3072 + (kq0 < 12 ? kq0 : 11) * 16), koff1 = (unsigned)((kr1 < 64 ? kr1 : 63) * 3072 + (kq1 < 12 ? kq1 : 11) * 16);
    const int vc = wid * 64 + lane, vdh = vc >> 8, vrow = (vc >> 2) & 63, vq = vc & 3;
    const unsigned voff = (unsigned)(vrow * 2048 + vdh * 64 + vq * 16);
    const char* Kt0 = (const char*)(KB + rowbase * 1536 + h * 96); const char* Vt0 = (const char*)(VB + rowbase * 1024 + h * 64);
    LAS unsigned char* lds = F.lds; LAS float* wsf = (LAS float*)(lds + AT_WSF) + wid * 64; const unsigned lds0 = (unsigned)(size_t)lds;
#define AT_DMA_K(t, slot) do { const char* kt_ = uni_ptr(Kt0 + (size_t)(t) * (64 * 3072)); const unsigned kl_ = (unsigned)__builtin_amdgcn_readfirstlane((int)(lds0 + (slot) * AT_KBYTES + wid * 1024)); glds16s(kt_, koff0, kl_); \
        if (has1) glds16s(kt_, koff1, kl_ + 8192u); } while (0)
#define AT_DMA_V(t, slot) do { const char* vt_ = uni_ptr(Vt0 + (size_t)(t) * (64 * 2048)); glds16s(vt_, voff, (unsigned)__builtin_amdgcn_readfirstlane((int)(lds0 + AT_VOFF + (slot) * AT_VBYTES + wid * 1024))); } while (0)
    AT_DMA_K(0, 0); AT_DMA_V(0, 0); AT_DMA_K(1, 1); AT_DMA_V(1, 1); AT_DMA_K(2, 2);
    asm volatile("s_waitcnt vmcnt(0)" ::: "memory"); __builtin_amdgcn_s_barrier(); asm volatile("" ::: "memory");
    f32x16 o0, o1, osum;
#pragma unroll
    for (int i = 0; i < 16; ++i) { o0[i] = 0.f; o1[i] = 0.f; osum[i] = 0.f; }
    float mrun = 0.f, pend = 0.f;
    f32x16 negm;
#pragma unroll
    for (int i = 0; i < 16; ++i) negm[i] = 0.f;
    const bf16x8 ones = {0x3F80, 0x3F80, 0x3F80, 0x3F80, 0x3F80, 0x3F80, 0x3F80, 0x3F80};
    const int kfrag = AT_KOFF + r * AT_KROW + hh * 16;
    const int vfrag = AT_VOFF + ((lane >> 4) & 1) * 32 + (lane & 3) * 8 + (4 * hh + ((lane & 15) >> 2)) * 64;
    const int wmax = q0 + 32 * wid + 31;
#define AT_QK(P0, P1, slot) do { const LAS unsigned char* kb_ = lds + (slot) * AT_KBYTES + kfrag; \
        { const bf16x8 a0 = *(const LAS bf16x8*)(kb_), a1 = *(const LAS bf16x8*)(kb_ + 32 * AT_KROW); \
          P0 = __builtin_amdgcn_mfma_f32_32x32x16_bf16(a0, qf[0], negm, 0, 0, 0); P1 = __builtin_amdgcn_mfma_f32_32x32x16_bf16(a1, qf[0], negm, 0, 0, 0); } \
        _Pragma("unroll") for (int ks = 1; ks < 6; ++ks) { const bf16x8 a0 = *(const LAS bf16x8*)(kb_ + ks * 32), a1 = *(const LAS bf16x8*)(kb_ + 32 * AT_KROW + ks * 32); \
            P0 = __builtin_amdgcn_mfma_f32_32x32x16_bf16(a0, qf[ks], P0, 0, 0, 0); P1 = __builtin_amdgcn_mfma_f32_32x32x16_bf16(a1, qf[ks], P1, 0, 0, 0); } } while (0)
#define AT_PV1(o, d0, ks, pa) do { const s16x4 lo = vtr(vb + d0 * 4096 + ks * 1024), hi = vtr(vb + d0 * 4096 + ks * 1024 + 512); \
        o = __builtin_amdgcn_mfma_f32_32x32x16_bf16(pa, (bf16x8){lo[0], lo[1], lo[2], lo[3], hi[0], hi[1], hi[2], hi[3]}, o, 0, 0, 0); } while (0)
#define AT_SOFT(P0, P1, t) do { \
        if (__any(pend != 0.f)) { _Pragma("unroll") for (int i = 0; i < 16; ++i) { P0[i] -= pend; P1[i] -= pend; } } pend = 0.f; \
        if ((t) >= NT - 4) { const int kb0 = (t) * 64; _Pragma("unroll") for (int i = 0; i < 16; ++i) { const int kv = kb0 + crow(i, hh); if (kv > qrow) P0[i] = -INFINITY; if (kv + 32 > qrow) P1[i] = -INFINITY; } } \
        float mx = fmaxf(fmaxf(P0[0], P1[0]), fmaxf(P0[1], P1[1])); _Pragma("unroll") for (int i = 2; i < 16; i += 2) mx = fmaxf(mx, fmaxf(fmaxf(P0[i], P1[i]), fmaxf(P0[i + 1], P1[i + 1]))); \
        mx = fmaxf(mx, __shfl_xor(mx, 32)); \
        if ((t) == 0 || __any(mx > ATT_THR)) { const float dl = (t) == 0 ? mx : fmaxf(mx, 0.f); mrun += dl; pend = dl; const float alpha = fast_exp2(-dl); { const float nm_ = -mrun; _Pragma("unroll") for (int i = 0; i < 16; ++i) negm[i] = nm_; } \
            _Pragma("unroll") for (int i = 0; i < 16; ++i) { P0[i] -= dl; P1[i] -= dl; } \
            if ((t) != 0) { if (hh == 0) wsf[r] = alpha; \
                _Pragma("unroll") for (int i = 0; i < 16; ++i) { const float al = wsf[crow(i, hh)]; o0[i] *= al; o1[i] *= al; osum[i] *= al; } } } \
        _Pragma("unroll") for (int i = 0; i < 16; ++i) { P0[i] = fast_exp2(P0[i]); P1[i] = fast_exp2(P1[i]); } \
        pk0 = pack8(P0, 0); pk1 = pack8(P0, 8); pk2_ = pack8(P1, 0); pk3 = pack8(P1, 8); } while (0)
#define AT_PV(sv) do { const LAS unsigned char* vb = lds + (sv) * AT_VBYTES + vfrag; \
        AT_PV1(o0, 0, 0, pk0); AT_PV1(o1, 1, 0, pk0); osum = __builtin_amdgcn_mfma_f32_32x32x16_bf16(pk0, ones, osum, 0, 0, 0); \
        AT_PV1(o0, 0, 1, pk1); AT_PV1(o1, 1, 1, pk1); osum = __builtin_amdgcn_mfma_f32_32x32x16_bf16(pk1, ones, osum, 0, 0, 0); \
        AT_PV1(o0, 0, 2, pk2_); AT_PV1(o1, 1, 2, pk2_); osum = __builtin_amdgcn_mfma_f32_32x32x16_bf16(pk2_, ones, osum, 0, 0, 0); \
        AT_PV1(o0, 0, 3, pk3); AT_PV1(o1, 1, 3, pk3); osum = __builtin_amdgcn_mfma_f32_32x32x16_bf16(pk3, ones, osum, 0, 0, 0); } while (0)
#define AT_H0(SQ0, SQ1, t) do { \
        const bool dK = (t) + 4 >= 3 && (t) + 4 < NT, dV = (t) + 2 >= 2 && (t) + 2 < NT; \
        if (dK) AT_DMA_K((t) + 4, s_b); \
        if (dV) AT_DMA_V((t) + 2, s_c); \
        if ((t) >= 0 && (t) * 64 <= wmax) AT_PV(s_a); \
        if ((t) + 2 < NT && ((t) + 2) * 64 <= wmax) AT_QK(SQ0, SQ1, s_c); \
        if (dK && dV) { if (has1) asm volatile("s_waitcnt vmcnt(3) lgkmcnt(0)" ::: "memory"); else asm volatile("s_waitcnt vmcnt(2) lgkmcnt(0)" ::: "memory"); } \
        else asm volatile("s_waitcnt vmcnt(0) lgkmcnt(0)" ::: "memory"); \
        __builtin_amdgcn_s_barrier(); asm volatile("" ::: "memory"); } while (0)
#define AT_H1(SS0, SS1, t) do { \
        if ((t) + 1 >= 0 && (t) + 1 < NT && ((t) + 1) * 64 <= wmax) AT_SOFT(SS0, SS1, (t) + 1); \
        asm volatile("s_waitcnt lgkmcnt(0)" ::: "memory"); __builtin_amdgcn_s_barrier(); asm volatile("" ::: "memory"); \
        { const int tmp_ = s_a; s_a = s_b; s_b = s_c; s_c = tmp_; } } while (0)
    f32x16 pA0, pA1, pB0, pB1; bf16x8 pk0, pk1, pk2_, pk3;
    pk0 = ones; pk1 = ones; pk2_ = ones; pk3 = ones;
    int s_a = 1, s_b = 2, s_c = 0;
    if (wid >= 4) { __builtin_amdgcn_s_barrier(); asm volatile("" ::: "memory"); }
    for (int t = -2; t < NT; t += 2) { AT_H0(pA0, pA1, t); AT_H1(pB0, pB1, t); AT_H0(pB0, pB1, t + 1); AT_H1(pA0, pA1, t + 1); }
    if (wid < 4) { __builtin_amdgcn_s_barrier(); asm volatile("" ::: "memory"); }
#undef AT_H0
#undef AT_H1
#undef AT_SOFT
#undef AT_PV
#undef AT_DMA_K
#undef AT_DMA_V
#undef AT_QK
#undef AT_PV1
    bf16_t* op = OB + (rowbase + q0 + 32 * wid) * 1024 + h * 64 + r;
#pragma unroll
    for (int i = 0; i < 16; ++i) { const int qr = crow(i, hh); const float rl = fast_rcp(osum[i]);
        op[(size_t)qr * 1024] = (bf16_t)(pk2(o0[i] * rl, 0.f) & 0xffffu); op[(size_t)qr * 1024 + 32] = (bf16_t)(pk2(o1[i] * rl, 0.f) & 0xffffu); }
    __syncthreads();
}
__device__ __forceinline__ void phase_attn(const Frame& F, const int att_var) {
    for (int pi = F.vcu; pi < 512; pi += F.G) { const int bh = pi >> 3, j = pi & 7; attn_unit(F, bh, j, att_var); attn_unit(F, bh, 15 - j, att_var); }
}

__device__ __forceinline__ void gmlp_unit(const Frame& F, int chunk, int g) {
    const int lane = F.lane, wid = F.wave, tid = F.tid, r = lane & 31, hh = lane >> 5;
    const bf16_t* vsrc = WSP(bf16_t, B_VB2); const bf16_t* usrc = WSP(bf16_t, B_UB); bf16_t* uv = WSP(bf16_t, B_UVB); const bf16_t* wsb = WSP(bf16_t, W_GM_S) + (size_t)g * 16384;
    const float* lng = INF(23); const float* lnb = INF(24); const float* bs = INF(26) + g * 128;
    LAS unsigned char* lds = F.lds; LAS f32x2* stat = (LAS f32x2*)(lds + 65536);
    const size_t row0 = (size_t)chunk * 128;
    for (int k = 0; k < 16; ++k) { const int rr = wid * 16 + k; const u32x4* p = (const u32x4*)(vsrc + (row0 + rr) * D) + lane; const u32x4 a = p[0], b2 = p[64];
        float x[16]; x[0] = bflo(a.x); x[1] = bfhi(a.x); x[2] = bflo(a.y); x[3] = bfhi(a.y); x[4] = bflo(a.z); x[5] = bfhi(a.z); x[6] = bflo(a.w); x[7] = bfhi(a.w);
        x[8] = bflo(b2.x); x[9] = bfhi(b2.x); x[10] = bflo(b2.y); x[11] = bfhi(b2.y); x[12] = bflo(b2.z); x[13] = bfhi(b2.z); x[14] = bflo(b2.w); x[15] = bfhi(b2.w);
        float s = 0.f;
#pragma unroll
        for (int i = 0; i < 16; ++i) s += x[i];
        const float mu = wave_sum(s) * (1.0f / 1024.0f); float q = 0.f;
#pragma unroll
        for (int i = 0; i < 16; ++i) { const float d = x[i] - mu; q += d * d; }
        const float var = wave_sum(q) * (1.0f / 1024.0f);
        if (lane == 0) stat[rr] = (f32x2){mu, 1.0f / sqrtf(var + LN_EPS)}; }
    __syncthreads();
#pragma unroll
    for (int k = 0; k < 8; ++k) { const int idx = tid + k * NTHR, s = idx >> 5, ch = idx & 31, c = g * 256 + ch * 8;
        const u32x4 w = *(const u32x4*)(vsrc + (row0 + s) * D + c); const f32x2 st = stat[s];
        const f32x4 g0 = *(const f32x4*)(lng + c), g1 = *(const f32x4*)(lng + c + 4), b0 = *(const f32x4*)(lnb + c), b1 = *(const f32x4*)(lnb + c + 4);
        f32x4 v0 = {bflo(w.x), bfhi(w.x), bflo(w.y), bfhi(w.y)}, v1 = {bflo(w.z), bfhi(w.z), bflo(w.w), bfhi(w.w)};
        v0 = (v0 - st.x) * st.y * g0 + b0; v1 = (v1 - st.x) * st.y * g1 + b1;
        u32x4 o; o.x = pk2(v0[0], v0[1]); o.y = pk2(v0[2], v0[3]); o.z = pk2(v1[0], v1[1]); o.w = pk2(v1[2], v1[3]);
        *(LAS u32x4*)(lds + (ch >> 2) * 8192 + s * 64 + (ch & 3) * 16) = o; }
    __syncthreads();
    bf16x8 bfr[8];
    { const LAS unsigned char* vb = lds + wid * 8192 + ((lane >> 4) & 1) * 32 + (lane & 3) * 8 + (8 * hh + ((lane & 15) >> 2)) * 64;
#pragma unroll
      for (int ks = 0; ks < 8; ++ks) { const s16x4 lo = vtr(vb + ks * 1024), hi = vtr(vb + ks * 1024 + 256); bfr[ks] = (bf16x8){lo[0], lo[1], lo[2], lo[3], hi[0], hi[1], hi[2], hi[3]}; } }
    __syncthreads();
    LAS bf16_t* ost = (LAS bf16_t*)(lds + wid * 8192);
#pragma unroll
    for (int mt = 0; mt < 4; ++mt) { f32x16 acc;
#pragma unroll
        for (int i = 0; i < 16; ++i) acc[i] = 0.f;
        const bf16_t* wp = wsb + (size_t)(32 * mt + r) * 128 + 8 * hh;
#pragma unroll
        for (int ks = 0; ks < 8; ++ks) if (ks <= 2 * mt + 1) { const bf16x8 a = *(const bf16x8*)(wp + 16 * ks); acc = __builtin_amdgcn_mfma_f32_32x32x16_bf16(a, bfr[ks], acc, 0, 0, 0); }
#pragma unroll
        for (int i = 0; i < 16; ++i) { const int t = 32 * mt + crow(i, hh); ost[t * 32 + r] = (bf16_t)(pk2(acc[i] + bs[t], 0.f) & 0xffffu); } }
    asm volatile("s_waitcnt lgkmcnt(0)" ::: "memory");
#pragma unroll
    for (int k = 0; k < 8; ++k) { const int t = 16 * k + (lane >> 2), ch = lane & 3; const size_t off = (row0 + t) * D + g * 256 + wid * 32 + ch * 8;
        const u32x4 v2 = *(const LAS u32x4*)(ost + t * 32 + ch * 8); const u32x4 uu = *(const u32x4*)(usrc + off); u32x4 o;
        o.x = pk2(bflo(uu.x) * bflo(v2.x), bfhi(uu.x) * bfhi(v2.x)); o.y = pk2(bflo(uu.y) * bflo(v2.y), bfhi(uu.y) * bfhi(v2.y));
        o.z = pk2(bflo(uu.z) * bflo(v2.z), bfhi(uu.z) * bfhi(v2.z)); o.w = pk2(bflo(uu.w) * bflo(v2.w), bfhi(uu.w) * bfhi(v2.w));
        *(u32x4*)(uv + off) = o; }
    __syncthreads();
}
__device__ __forceinline__ void phase_gmlp(const Frame& F) { for (int u = F.vcu; u < 512; u += F.G) gmlp_unit(F, u >> 2, u & 3); }
constexpr int PH_PRO = 0, PH_LAT = 1, PH_QKV = 2, PH_ATTN = 3, PH_WO = 4, PH_FUP0 = 5, PH_FDN0 = 6, PH_LIN = 7, PH_CONV = 8, PH_LGATE = 9, PH_SCAN1 = 10, PH_SCAN2 = 11, PH_LOUT = 12,
              PH_ROUT0 = 13, PH_GATH0 = 14, PH_MUP0 = 15, PH_MDN0 = 16, PH_COMB0 = 17, PH_POOL = 18, PH_PGEMM = 19, PH_FUP1 = 20, PH_FDN1 = 21, PH_GIN = 22, PH_GGATE = 23, PH_GOUT = 24,
              PH_ROUT1 = 25, PH_GATH1 = 26, PH_MUP1 = 27, PH_MDN1 = 28, PH_FINAL = 29, PH_N = 30;

__device__ __forceinline__ DenseSched dense_sched(const Frame& F, const void* A, int lda, const void* B, int ldb, int nM, int nN) {
    DenseSched s; s.nM = nM; s.nN = nN; s.G = F.G; s.c = (int)blockIdx.x; s.A = (const char*)A; s.B = (const char*)B; s.astep = (size_t)256 * lda * 2; s.bstep = btile_bytes(ldb); return s;
}
template <int L> __device__ __forceinline__ void phase_ffn_up(const Frame& F, bf16_t* actout, int var) {
    if constexpr (ffn_f8(L)) {
        const DenseSched s = dense_sched(F, F.ws + WS_X8, D / 2, F.ws + W_FFN + (size_t)L * WSTRIDE, D / 2, M / 256, 2 * FF / 256);
        EpiSwiglu<false, true> e{actout, WSP(float, WS_SSQ), var, 1.f / F8_SW};
        gemm_phase<EpiSwiglu<false, true>, DenseSched, false, true, false, true>(F.lds, D / 2, D / 2, D / 2, s, e);
        return;
    }
    const DenseSched s = dense_sched(F, WSP(bf16_t, WS_HB), D, F.ws + W_FFN + (size_t)L * WSTRIDE, D, M / 256, 2 * FF / 256);
    EpiSwiglu<false> e{actout, WSP(float, WS_SSQ), var, 1.f};
#if defined(REP_PHASE) && REP_VAR == 3
    if (var == 3) { gemm_phase<EpiSwiglu<false>, DenseSched, false, false>(F.lds, D, D, D, s, e); return; }
#endif
    gemm_phase(F.lds, D, D, D, s, e);
}
template <int L> __device__ __forceinline__ void phase_ffn_down(const Frame& F) {
    constexpr bool F8 = ffn_f8(L); constexpr int KD = F8 ? FF / 2 : FF;
    const DenseSched s = dense_sched(F, WSP(bf16_t, B_ACT), KD, F.ws + W_FFN + (size_t)L * WSTRIDE + WDOWN_OFF, KD, M / 256, D / 256);
    EpiRes e{nullptr, WSP(bf16_t, WS_HB), WSP(bf16_t, WS_LO), WSP(float, WS_SSQ), nullptr, nullptr, F8 ? 1.f / (F8_SA * F8_SW) : 1.f};
    gemm_phase<EpiRes, DenseSched, false, true, false, F8>(F.lds, 128, KD, KD, s, e, SKCtx{nullptr, nullptr, nullptr}, 65536);
}
__device__ __forceinline__ MoeSched moe_sched(const Frame& F, int l, const void* A, int lda, size_t wofs, int ldb, int nN) {
    MoeSched s; int ps[NE]; s.nM = moe_layout(F, l, ps, s.pend); s.nN = nN; s.G = F.G; s.c = (int)blockIdx.x; s.A = (const char*)A; s.B = (const char*)(F.ws + W_MOE + (size_t)l * 8 * WSTRIDE + wofs);
    s.astep = (size_t)256 * lda * 2; s.bstep = btile_bytes(ldb); s.estep = WSTRIDE; return s;
}
template <int L> __device__ __forceinline__ void phase_moe_up(const Frame& F, const int var) {
    if constexpr (moe_f8(L)) {
        EpiSwiglu<true, true> e{WSP(bf16_t, B_ACTM), WSP(float, WS_ROWSCALE), var, 1.f};
        const MoeSched s = moe_sched(F, L, WSP(bf16_t, B_XG), D / 2, 0, D / 2, 2 * FF / 256);
        gemm_phase<EpiSwiglu<true, true>, MoeSched, false, true, false, true>(F.lds, D / 2, D / 2, D / 2, s, e);
        return;
    }
    EpiSwiglu<true> e{WSP(bf16_t, B_ACTM), WSP(float, WS_ROWSCALE), var, 1.f};
#if MUP_GATHER
    MoeSched s = moe_sched(F, L, WSP(bf16_t, WS_HB), D, 0, D, 2 * FF / 256); s.astep = 0;
    gemm_phase<EpiSwiglu<true>, MoeSched, false, true, true>(F.lds, D, D, D, s, e, SKCtx{nullptr, nullptr, nullptr}, 256, WSP(int, WS_ROWTOK));
#else
    const MoeSched s = moe_sched(F, L, WSP(bf16_t, B_XG), D, 0, D, 2 * FF / 256);
    gemm_phase(F.lds, D, D, D, s, e);
#endif
}
template <int L> __device__ __forceinline__ void phase_moe_down(const Frame& F) {
    EpiMoeDown e{WSP(bf16_t, B_OUTM), WSP(float, WS_ROWGATE), (bf16_t*)(F.ws + WS_SK)};
#if MDN_STREAMK
    if (F.G == 256) {
        constexpr bool F8 = moe_f8(L); constexpr int KD = F8 ? FF / 2 : FF;
        SKSched s; int ps[NE]; s.NP = moe_layout(F, L, ps, s.pend); s.P = KD / 128; const int T = ((s.NP + 7) >> 3) * s.P;
        s.x = F.vcu >> 5; s.r = (F.vcu >> 2) & 7; s.j = F.vcu & 3; s.s0 = (s.x * T) >> 3; s.s1 = ((s.x + 1) * T) >> 3;
#ifdef SK_NOSPLIT
        s.s0 = (s.s0 / s.P) * s.P; s.s1 = (s.x == 7) ? T : (s.s1 / s.P) * s.P;
#endif
        s.A = (const char*)WSP(bf16_t, B_ACTM); s.B = (const char*)(F.ws + W_MOE + (size_t)L * 8 * WSTRIDE + WDOWN_OFF); s.astep = (size_t)256 * KD * 2; s.bstep = btile_bytes(KD); s.estep = WSTRIDE;
        const SKCtx sk{F.ws + WS_SK, WSP(unsigned, WS_CTL) + CW_SK + L * 4096, WSP(unsigned, WS_CTL) + CW_TMO};
        gemm_phase<EpiMoeDown, SKSched, true, true, false, F8>(F.lds, 128, KD, KD, s, e, sk, 65536);
        return;
    }
#endif
    { constexpr bool F8 = moe_f8(L); constexpr int KD = F8 ? FF / 2 : FF;
    const MoeSched s = moe_sched(F, L, WSP(bf16_t, B_ACTM), KD, WDOWN_OFF, KD, D / 256);
    gemm_phase<EpiMoeDown, MoeSched, false, true, false, F8>(F.lds, 128, KD, KD, s, e, SKCtx{nullptr, nullptr, nullptr}, 65536); }
}

__global__ void __launch_bounds__(NTHR, 2) fused_fwd(Args args) {
    extern __shared__ __attribute__((aligned(16))) unsigned char lds_raw[];
    Frame F;
    F.lds = (LAS unsigned char*)lds_raw; F.ws = args.ws; F.in = args.in; F.h = args.out;
    F.tid = threadIdx.x; F.lane = F.tid & 63; F.wave = __builtin_amdgcn_readfirstlane(F.tid >> 6);
    F.G = gridDim.x; { const int bx = blockIdx.x; F.vcu = (F.G % 8 == 0) ? (bx % 8) * (F.G / 8) + bx / 8 : bx; }
    F.gw = F.vcu * NWAVES + F.wave; F.NGW = F.G * NWAVES;
    volatile LAS unsigned* MISC = (volatile LAS unsigned*)(F.lds + MISC_OFF);
    if (F.tid < 64) MISC[F.tid] = 0u;
    __syncthreads();
    XcdBarrier bar = xcd_barrier_post(WSP(unsigned, WS_CTL) + CW_BAR, MISC + 8);
    const int lo = args.ph_lo, hi = args.ph_hi;
#ifdef TS_LO
#define TS_MARK(k, which) do { if (blockIdx.x == 0 && F.tid == 0 && (k) == (which ? TS_HI : TS_LO)) { const unsigned long long t_ = __builtin_amdgcn_s_memrealtime(); \
        if (which) { unsigned long long t0_ = ((unsigned long long*)(F.ws + WS_CTL))[1024]; __hip_atomic_store(WSP(unsigned, WS_CTL) + 2060, (unsigned)(t_ - t0_), __ATOMIC_RELAXED, __HIP_MEMORY_SCOPE_AGENT); } \
        else ((unsigned long long*)(F.ws + WS_CTL))[1024] = t_; } } while (0)
#else
#define TS_MARK(k, which)
#endif
#ifdef ONLY_PHASE
#define IN(k) ((k) == ONLY_PHASE && lo <= (k) && (k) < hi)
#else
#define IN(k) (lo <= (k) && (k) < hi)
#endif
#define SEAM(k) do { if (IN(k) && IN((k) + 1)) xcd_barrier(bar); } while (0)
#ifdef REP_PHASE
#define REP_LOOP(k) for (int _r = 0, _nr = ((k) == REP_PHASE ? args.nrep : 1); _r < _nr; ++_r)
#define REP_SEAM(k) if ((k) == REP_PHASE && _r + 1 < _nr) xcd_barrier(bar);
#define REP_H(k) (((k) == REP_PHASE && _r + 1 < _nr) ? (float*)(F.ws + WS_SK) : F.h)
#define REP_X(k) ((k) == REP_PHASE && _r + 1 < _nr)
#ifndef REP_VAR
#define REP_VAR 0
#endif
#else
#define REP_LOOP(k)
#define REP_SEAM(k)
#define REP_H(k) F.h
#define REP_X(k) false
#define REP_VAR 0
#endif

    TS_MARK(PH_PRO, 0); if (IN(PH_PRO)) { REP_LOOP(PH_PRO) { phase_prologue(F, args.wmask, args.lmask, args.hsrc);  REP_SEAM(PH_PRO) } } SEAM(PH_PRO); TS_MARK(PH_PRO, 1);
#ifdef EXTRA_BARRIERS
#ifdef EXTRA_LIGHT
    for (int q_ = 0; q_ < EXTRA_BARRIERS; ++q_) xcd_barrier_light(bar);
#else
    for (int q_ = 0; q_ < EXTRA_BARRIERS; ++q_) xcd_barrier(bar);
#endif
#endif
    TS_MARK(PH_LAT, 0); if (IN(PH_LAT)) { REP_LOOP(PH_LAT) { const DenseSched s = dense_sched(F, WSP(bf16_t, WS_HB), D, WSP(bf16_t, W_MLA_IN), D, M / 256, 3);
        EpiLat e{WSP(bf16_t, B_LAT), WSP(float, WS_SLOT24), WSP(float, WS_SSQ), WSP(bf16_t, B_KB), WSP(float, WS_ROPE)};
        gemm_phase(F.lds, D, D, D, s, e);  REP_SEAM(PH_LAT) } } SEAM(PH_LAT); TS_MARK(PH_LAT, 1);
    TS_MARK(PH_QKV, 0); if (IN(PH_QKV)) { REP_LOOP(PH_QKV) {
#ifndef SKIP_Q
        { const DenseSched s = dense_sched(F, WSP(bf16_t, B_LAT), 768, WSP(bf16_t, W_UQ), 384, M / 256, 6);
          EpiQ e{WSP(bf16_t, B_Q), WSP(float, WS_SLOT24), WSP(float, WS_ROPE)};
          gemm_phase(F.lds, 768, 384, 384, s, e); }
#endif
#ifndef SKIP_KV
        { const DenseSched s = dense_sched(F, WSP(bf16_t, B_LAT) + 384, 768, WSP(bf16_t, W_UKV), 256, M / 256, 8);
          EpiKV e{WSP(bf16_t, B_KB), WSP(bf16_t, B_VB), WSP(float, WS_SLOT24)};
          gemm_phase(F.lds, 768, 256, 256, s, e); }
#endif
         REP_SEAM(PH_QKV) } } SEAM(PH_QKV); TS_MARK(PH_QKV, 1);
    TS_MARK(PH_ATTN, 0); if (IN(PH_ATTN)) { REP_LOOP(PH_ATTN) { phase_attn(F, REP_X(PH_ATTN) ? REP_VAR : 0);  REP_SEAM(PH_ATTN) } } SEAM(PH_ATTN); TS_MARK(PH_ATTN, 1);
    TS_MARK(PH_WO, 0); if (IN(PH_WO)) { REP_LOOP(PH_WO) { const DenseSched s = dense_sched(F, WSP(bf16_t, B_OB), D, WSP(bf16_t, W_O), D, M / 256, 4);
        EpiRes e{HB_ONLY ? nullptr : INF(0), WSP(bf16_t, WS_HB), WSP(bf16_t, WS_LO), WSP(float, WS_SSQ), nullptr, ffn_f8(0) ? F.ws + WS_X8 : nullptr, 1.f};
        gemm_phase(F.lds, D, D, D, s, e);  REP_SEAM(PH_WO) } } SEAM(PH_WO); TS_MARK(PH_WO, 1);
    TS_MARK(PH_FUP0, 0); if (IN(PH_FUP0)) { REP_LOOP(PH_FUP0) { phase_ffn_up<0>(F, REP_X(PH_FUP0) ? (bf16_t*)(F.ws + WS_BIG + 128 * MiB) : WSP(bf16_t, B_ACT), REP_X(PH_FUP0) ? REP_VAR : 0);  REP_SEAM(PH_FUP0) } } SEAM(PH_FUP0); TS_MARK(PH_FUP0, 1);
    TS_MARK(PH_FDN0, 0); if (IN(PH_FDN0)) { REP_LOOP(PH_FDN0) { phase_ffn_down<0>(F);  REP_SEAM(PH_FDN0) } } SEAM(PH_FDN0); TS_MARK(PH_FDN0, 1);
    TS_MARK(PH_LIN, 0); if (IN(PH_LIN)) { REP_LOOP(PH_LIN) { const DenseSched s = dense_sched(F, WSP(bf16_t, WS_HB), D, WSP(bf16_t, W_LRU_IN), D, M / 256, 8);
        EpiSplit2<true, false> e{WSP(bf16_t, B_GATEB), WSP(bf16_t, B_XBR), WSP(float, WS_SSQ)};
        gemm_phase(F.lds, D, D, D, s, e);  REP_SEAM(PH_LIN) } } SEAM(PH_LIN); TS_MARK(PH_LIN, 1);
    TS_MARK(PH_CONV, 0); if (IN(PH_CONV)) { REP_LOOP(PH_CONV) { phase_conv(F);  REP_SEAM(PH_CONV) } } SEAM(PH_CONV); TS_MARK(PH_CONV, 1);
    TS_MARK(PH_LGATE, 0); if (IN(PH_LGATE)) { REP_LOOP(PH_LGATE) { GroupSched s; s.nM = M / 256; s.nN = 8; s.G = F.G; s.c = (int)blockIdx.x; s.A = (const char*)WSP(bf16_t, B_XCB); s.B = (const char*)WSP(bf16_t, W_LRU_G);
        s.astep = (size_t)256 * D * 2; s.bstep = btile_bytes(256); s.acol_bytes = 512; s.acol_shift = 1;
        EpiLruGate e{WSP(unsigned, B_AF), WSP(bf16_t, B_XCB), INF(15), INF(17), WSP(float, WS_SP8), WSP(f32x2, WS_CARRY)};
        gemm_phase(F.lds, D, 256, 256, s, e);  REP_SEAM(PH_LGATE) } } SEAM(PH_LGATE); TS_MARK(PH_LGATE, 1);
    TS_MARK(PH_SCAN2, 0); if (IN(PH_SCAN2)) { REP_LOOP(PH_SCAN2) { phase_scan2(F);  REP_SEAM(PH_SCAN2) } } SEAM(PH_SCAN2); TS_MARK(PH_SCAN2, 1);
    TS_MARK(PH_LOUT, 0); if (IN(PH_LOUT)) { REP_LOOP(PH_LOUT) { const DenseSched s = dense_sched(F, WSP(bf16_t, B_YB), D, WSP(bf16_t, W_LRU_OUT), D, M / 256, 4);
        EpiRes e{nullptr, WSP(bf16_t, WS_HB), WSP(bf16_t, WS_LO), WSP(float, WS_SSQ), nullptr, nullptr, 1.f};
        gemm_phase(F.lds, D, D, D, s, e);  REP_SEAM(PH_LOUT) } } SEAM(PH_LOUT); TS_MARK(PH_LOUT, 1);
    TS_MARK(PH_ROUT0, 0); if (IN(PH_ROUT0)) { REP_LOOP(PH_ROUT0) { phase_router(F, 0);  REP_SEAM(PH_ROUT0) } } SEAM(PH_ROUT0); TS_MARK(PH_ROUT0, 1);
    TS_MARK(PH_GATH0, 0); if (IN(PH_GATH0)) { REP_LOOP(PH_GATH0) { phase_gather(F, 0);  REP_SEAM(PH_GATH0) } } SEAM(PH_GATH0); TS_MARK(PH_GATH0, 1);
    TS_MARK(PH_MUP0, 0); if (IN(PH_MUP0)) { REP_LOOP(PH_MUP0) { phase_moe_up<0>(F, REP_X(PH_MUP0) ? REP_VAR : 0);  REP_SEAM(PH_MUP0) } } SEAM(PH_MUP0); TS_MARK(PH_MUP0, 1);
    TS_MARK(PH_MDN0, 0); if (IN(PH_MDN0)) { REP_LOOP(PH_MDN0) { phase_moe_down<0>(F);  REP_SEAM(PH_MDN0) } } SEAM(PH_MDN0); TS_MARK(PH_MDN0, 1);
    TS_MARK(PH_COMB0, 0); if (IN(PH_COMB0)) { REP_LOOP(PH_COMB0) { phase_combine<false>(F, 1.0f, 0);  REP_SEAM(PH_COMB0) } } SEAM(PH_COMB0); TS_MARK(PH_COMB0, 1);
    TS_MARK(PH_POOL, 0); if (IN(PH_POOL)) { REP_LOOP(PH_POOL) { phase_pool(F);  REP_SEAM(PH_POOL) } } SEAM(PH_POOL); TS_MARK(PH_POOL, 1);
    TS_MARK(PH_PGEMM, 0); if (IN(PH_PGEMM)) { REP_LOOP(PH_PGEMM) { GroupSched s; s.nM = M / 256; s.nN = 4; s.G = F.G; s.c = (int)blockIdx.x; s.A = (const char*)WSP(bf16_t, B_POOLED); s.B = (const char*)WSP(bf16_t, W_POOL);
        s.astep = (size_t)256 * D * 2; s.bstep = btile_bytes(256); s.acol_bytes = 512; s.acol_shift = 0;
        EpiRes e{nullptr, WSP(bf16_t, WS_HB), WSP(bf16_t, WS_LO), WSP(float, WS_SSQ), INF(21), ffn_f8(1) ? F.ws + WS_X8 : nullptr, 1.f};
        gemm_phase(F.lds, D, 256, 256, s, e);  REP_SEAM(PH_PGEMM) } } SEAM(PH_PGEMM); TS_MARK(PH_PGEMM, 1);
    TS_MARK(PH_FUP1, 0); if (IN(PH_FUP1)) { REP_LOOP(PH_FUP1) { phase_ffn_up<1>(F, WSP(bf16_t, B_ACT), 0);  REP_SEAM(PH_FUP1) } } SEAM(PH_FUP1); TS_MARK(PH_FUP1, 1);
    TS_MARK(PH_FDN1, 0); if (IN(PH_FDN1)) { REP_LOOP(PH_FDN1) { phase_ffn_down<1>(F);  REP_SEAM(PH_FDN1) } } SEAM(PH_FDN1); TS_MARK(PH_FDN1, 1);
    TS_MARK(PH_GIN, 0); if (IN(PH_GIN)) { REP_LOOP(PH_GIN) { const DenseSched s = dense_sched(F, WSP(bf16_t, WS_HB), D, WSP(bf16_t, W_GM_IN), D, M / 256, 8);
        EpiSplit2<true, true> e{WSP(bf16_t, B_UB), WSP(bf16_t, B_VB2), WSP(float, WS_SSQ)};
        gemm_phase(F.lds, D, D, D, s, e);  REP_SEAM(PH_GIN) } } SEAM(PH_GIN); TS_MARK(PH_GIN, 1);
    TS_MARK(PH_GGATE, 0); if (IN(PH_GGATE)) { REP_LOOP(PH_GGATE) { phase_gmlp(F);  REP_SEAM(PH_GGATE) } } SEAM(PH_GGATE); TS_MARK(PH_GGATE, 1);
    TS_MARK(PH_GOUT, 0); if (IN(PH_GOUT)) { REP_LOOP(PH_GOUT) { const DenseSched s = dense_sched(F, WSP(bf16_t, B_UVB), D, WSP(bf16_t, W_GM_OUT), D, M / 256, 4);
        EpiRes e{nullptr, WSP(bf16_t, WS_HB), WSP(bf16_t, WS_LO), WSP(float, WS_SSQ), nullptr, nullptr, 1.f};
        gemm_phase(F.lds, D, D, D, s, e);  REP_SEAM(PH_GOUT) } } SEAM(PH_GOUT); TS_MARK(PH_GOUT, 1);
    TS_MARK(PH_ROUT1, 0); if (IN(PH_ROUT1)) { REP_LOOP(PH_ROUT1) { phase_router(F, 1);  REP_SEAM(PH_ROUT1) } } SEAM(PH_ROUT1); TS_MARK(PH_ROUT1, 1);
    TS_MARK(PH_GATH1, 0); if (IN(PH_GATH1)) { REP_LOOP(PH_GATH1) { phase_gather(F, 1);  REP_SEAM(PH_GATH1) } } SEAM(PH_GATH1); TS_MARK(PH_GATH1, 1);
    TS_MARK(PH_MUP1, 0); if (IN(PH_MUP1)) { REP_LOOP(PH_MUP1) { phase_moe_up<1>(F, 0);  REP_SEAM(PH_MUP1) } } SEAM(PH_MUP1); TS_MARK(PH_MUP1, 1);
    TS_MARK(PH_MDN1, 0); if (IN(PH_MDN1)) { REP_LOOP(PH_MDN1) { phase_moe_down<1>(F);  REP_SEAM(PH_MDN1) } } SEAM(PH_MDN1); TS_MARK(PH_MDN1, 1);
#ifdef TS_LO
    float ts_scale = 1.0f; { const unsigned dt = __hip_atomic_load(WSP(unsigned, WS_CTL) + 2060, __ATOMIC_RELAXED, __HIP_MEMORY_SCOPE_AGENT); ts_scale = 1.0f + sqrtf((float)dt * 0.01f * 1e-5f); }
    if (IN(PH_FINAL)) { phase_combine<true>(F, ts_scale, 1); }
#else
    if (IN(PH_FINAL)) { phase_combine<true>(F, 1.0f, 1); }
#endif
#undef IN
#undef SEAM
}
}
extern "C" void kernel_launch(void* const* d_in, const int* in_sizes, int n_in, void* d_out, int out_size, void* d_ws, size_t ws_size, hipStream_t stream) {
    (void)in_sizes; (void)out_size;
    static int grid = 0;
    if (grid == 0) {
        int dev = 0, cus = 0;
        if (n_in != 35 || ws_size < fk::WS_SK + (size_t)fk::MOE_MAXROWS * fk::D * 2) { fprintf(stderr, "kernel_launch: unexpected inputs / workspace (%d inputs, %zu bytes)\n", n_in, ws_size); grid = -1; return; }
        if (hipGetDevice(&dev) != hipSuccess || hipDeviceGetAttribute(&cus, hipDeviceAttributeMultiprocessorCount, dev) != hipSuccess) { grid = -1; return; }
        if (hipFuncSetAttribute((const void*)fk::fused_fwd, hipFuncAttributeMaxDynamicSharedMemorySize, fk::LDS_BYTES) != hipSuccess) { grid = -1; return; }
        int per_cu = 0; (void)hipOccupancyMaxActiveBlocksPerMultiprocessor(&per_cu, (const void*)fk::fused_fwd, fk::NTHR, fk::LDS_BYTES); (void)hipGetLastError();
        if (cus != 256) { fprintf(stderr, "kernel_launch: built for a 256-CU device (got %d CUs)\n", cus); grid = -1; return; }
        grid = cus;
    }
    if (grid < 0) return;
    (void)hipMemsetAsync((char*)d_ws + fk::WS_CTL, 0, fk::CTL_ZERO_BYTES, stream);
    fk::Args a{}; for (int i = 0; i < 35; ++i) a.in[i] = d_in[i];
    a.out = (float*)d_out; a.ws = (unsigned char*)d_ws; a.hsrc = (float*)d_in[0]; a.ph_lo = 0; a.ph_hi = fk::PH_N; a.wmask = 0x3FFFFu; a.lmask = 0xFu;
#ifdef REP_PHASE
    a.nrep = REP_N;
#else
    a.nrep = 1;
#endif
    hipLaunchKernelGGL(fk::fused_fwd, dim3(grid), dim3(fk::NTHR), fk::LDS_BYTES, stream, a);
}
```

```cpp
#include <hip/hip_runtime.h>
#include <cstdio>
#include <cstdint>
#include <cmath>
#define HB_ONLY 1
#define MOE_F8 3
#define FFN_F8 2
namespace fk {
#define LAS __attribute__((address_space(3)))
#define GAS __attribute__((address_space(1)))
typedef unsigned short bf16_t;
typedef short bf16x8 __attribute__((ext_vector_type(8)));
typedef short s16x4 __attribute__((ext_vector_type(4)));
typedef float f32x4 __attribute__((ext_vector_type(4)));
typedef float f32x2 __attribute__((ext_vector_type(2)));
typedef float f32x16 __attribute__((ext_vector_type(16)));
typedef unsigned u32x4 __attribute__((ext_vector_type(4)));
typedef unsigned u32x2 __attribute__((ext_vector_type(2)));
typedef __bf16 bf16x2_t __attribute__((ext_vector_type(2)));
typedef int i32x4 __attribute__((ext_vector_type(4)));
typedef int i32x8 __attribute__((ext_vector_type(8)));
#ifndef MOE_F8
#define MOE_F8 2
#endif
__host__ __device__ constexpr bool moe_f8(int l) { return ((MOE_F8 >> l) & 1) != 0; }
#ifndef FFN_F8
#define FFN_F8 0
#endif
__host__ __device__ constexpr bool ffn_f8(int l) { return ((FFN_F8 >> l) & 1) != 0; }
constexpr float F8_SX = 8.f, F8_SW = 64.f, F8_SA = 8.f;
__device__ __forceinline__ unsigned pk_fp8x4(float a, float b, float c, float d) {
    a = __builtin_amdgcn_fmed3f(a, -448.f, 448.f); b = __builtin_amdgcn_fmed3f(b, -448.f, 448.f); c = __builtin_amdgcn_fmed3f(c, -448.f, 448.f); d = __builtin_amdgcn_fmed3f(d, -448.f, 448.f);
    int r = __builtin_amdgcn_cvt_pk_fp8_f32(a, b, 0, false); r = __builtin_amdgcn_cvt_pk_fp8_f32(c, d, r, true); return (unsigned)r;
}

constexpr int D = 1024, NB = 4, S = 4096, M = NB * S, FF = 3584, NE = 8, NH = 16;
constexpr int MOE_MAXP = 136, MOE_MAXROWS = MOE_MAXP * 256;
constexpr float RMS_EPS = 1e-6f, LN_EPS = 1e-5f;
constexpr int NWAVES = 8, NTHR = 512;
constexpr int LDS_BYTES = 147456, MISC_OFF = LDS_BYTES - 256;

constexpr size_t MiB = 1u << 20;
#ifndef FAST_BASE_MIB
#define FAST_BASE_MIB 0
#endif
constexpr size_t FB = (size_t)FAST_BASE_MIB * MiB;
constexpr size_t WS_CTL = FB, CTL_ZERO_BYTES = 1 * MiB;
constexpr size_t WS_SSQ = FB + 1 * MiB;
constexpr size_t WS_SLOT24 = FB + 2 * MiB;
constexpr size_t WS_ROPE = FB + 4 * MiB;
constexpr size_t WS_SP8 = FB + 6 * MiB;
constexpr size_t WS_ROUTW = FB + 6 * MiB + 65536;
constexpr size_t WS_WGBASE = FB + 6 * MiB + 262144;
constexpr size_t WS_RSTD = FB + 6 * MiB + 524288;
constexpr size_t WS_TOKINFO = FB + 7 * MiB;
constexpr size_t WS_TOKG = FB + 7 * MiB + 262144;
constexpr size_t WS_DEST = FB + 7 * MiB + 393216;
constexpr size_t WS_ROWTOK = FB + 7 * MiB + 524288;
constexpr size_t WS_ROWSCALE = FB + 8 * MiB;
constexpr size_t WS_ROWGATE = FB + 8 * MiB + 262144;
constexpr size_t WS_CARRY = FB + 9 * MiB;
constexpr size_t WS_HB = FB + 12 * MiB;
constexpr size_t WS_LO = FB + 44 * MiB;
constexpr size_t WS_X8 = WS_LO;
#ifndef HB_ONLY
#define HB_ONLY 0
#endif
static_assert(FFN_F8 == 0 || HB_ONLY, "the fp8 stream copy lives in the lo-half buffer");
constexpr size_t WS_W = FB + 76 * MiB;
constexpr size_t W_MLA_IN = WS_W, W_UQ = WS_W + 2 * MiB, W_UKV = W_UQ + 2 * MiB, W_O = W_UKV + 2 * MiB, W_LRU_IN = W_O + 3 * MiB, W_LRU_G = W_LRU_IN + 5 * MiB,
                 W_LRU_OUT = W_LRU_G + 2 * MiB, W_POOL = W_LRU_OUT + 3 * MiB, W_GM_IN = W_POOL + 1 * MiB, W_GM_S = W_GM_IN + 5 * MiB, W_GM_OUT = W_GM_S + 131072;
constexpr size_t WSTRIDE = 21 * MiB + 96 * 1024;
constexpr size_t WDOWN_OFF = 14 * MiB;
constexpr size_t W_FFN = WS_W + 32 * MiB;
constexpr size_t W_MOE = W_FFN + 2 * WSTRIDE + MiB;
constexpr size_t WS_BIG = FB + 492 * MiB;
static_assert(W_GM_OUT + 4 * MiB <= W_FFN && W_MOE + 16 * WSTRIDE <= WS_BIG, "weight map");
constexpr size_t B_LAT = WS_BIG, B_Q = WS_BIG + 24 * MiB, B_KB = WS_BIG + 72 * MiB, B_VB = WS_BIG + 120 * MiB, B_OB = WS_BIG + 152 * MiB;
constexpr size_t B_ACT = WS_BIG;
constexpr size_t B_GATEB = WS_BIG, B_XBR = WS_BIG + 32 * MiB, B_XCB = WS_BIG + 64 * MiB, B_AF = WS_BIG + 96 * MiB, B_BF = WS_BIG + 160 * MiB, B_YB = WS_BIG + 224 * MiB;
constexpr size_t B_XG = WS_BIG, B_OUTM = WS_BIG, B_ACTM = WS_BIG + 68 * MiB;
constexpr size_t B_POOLED = WS_BIG;
constexpr size_t B_UB = WS_BIG, B_VB2 = WS_BIG + 32 * MiB, B_UVB = WS_BIG + 64 * MiB;
constexpr size_t WS_END = WS_BIG + 306 * MiB;
constexpr size_t WS_SK = WS_END;
constexpr int CW_TMO = 0, CW_BAR = 4096, CW_MOECNT = 16384, CW_SK = 32768;
#ifndef MDN_STREAMK
#define MDN_STREAMK 1
#endif
#ifndef MUP_GATHER
#define MUP_GATHER 0
#endif

__device__ __forceinline__ unsigned pk2(float lo, float hi) { f32x2 v = {lo, hi}; bf16x2_t b = __builtin_convertvector(v, bf16x2_t); return __builtin_bit_cast(unsigned, b); }
__device__ __forceinline__ float bf2f(unsigned short b) { return __uint_as_float((unsigned)b << 16); }
__device__ __forceinline__ float bflo(unsigned w) { return __uint_as_float(w << 16); }
__device__ __forceinline__ float bfhi(unsigned w) { return __uint_as_float(w & 0xffff0000u); }
__device__ __forceinline__ float fast_exp2(float x) { return __builtin_amdgcn_exp2f(x); }
__device__ __forceinline__ float fast_rcp(float x) { return __builtin_amdgcn_rcpf(x); }
__device__ __forceinline__ float sigmoid_f(float x) { return fast_rcp(1.0f + fast_exp2(-1.4426950408889634f * x)); }
__device__ __forceinline__ float silu_f(float x) { return x * sigmoid_f(x); }
__device__ __forceinline__ float gelu_tanh_f(float x) { const float u = 0.7978845608028654f * (x + 0.044715f * x * x * x); return x * sigmoid_f(2.0f * u); }
__device__ __forceinline__ float wave_sum(float v) {
#pragma unroll
    for (int o = 1; o < 64; o <<= 1) v += __shfl_xor(v, o);
    return v;
}
__device__ __forceinline__ float hsum4(f32x4 a) { return (a.x + a.y) + (a.z + a.w); }
__device__ __forceinline__ float rstd16(const float* ssq, int row) {
    const f32x4* p = (const f32x4*)(ssq + (size_t)row * 16); const f32x4 a = p[0], b = p[1], c = p[2], d = p[3];
    const float s = (hsum4(a) + hsum4(b)) + (hsum4(c) + hsum4(d)); return 1.0f / sqrtf(s * (1.0f / 1024.0f) + RMS_EPS);
}

#ifndef BAR_FLAT
#define BAR_FLAT 0
#endif
#define XB_TMO      128
#define XB_XCNT(j)  (256  + 64 * (j))
#define XB_XSUB(j)  (1280 + 64 * (j))
#define XB_XGEN(j)  (2304 + 64 * (j))
#define XB_TOP      3328
#define XB_TOPGEN   3392
#define XCD_BAR_WORDS 3456
#define XB_SPIN_CAP (1u << 18)
__device__ __forceinline__ unsigned xb_ld(unsigned* p)              { return __hip_atomic_load(p, __ATOMIC_RELAXED, __HIP_MEMORY_SCOPE_AGENT); }
__device__ __forceinline__ unsigned xb_add(unsigned* p, unsigned v) { return __hip_atomic_fetch_add(p, v, __ATOMIC_RELAXED, __HIP_MEMORY_SCOPE_AGENT); }
__device__ __forceinline__ unsigned xb_xcc_id() { return (unsigned)__builtin_amdgcn_s_getreg((3 << 11) | 20) & 0xFu; }
#define XB_SPIN(cond, bar) do { unsigned _sp = 0; while (cond) { __builtin_amdgcn_s_sleep(1); \
    if ((++_sp & 255u) == 0u) { if (xb_ld(&(bar)[XB_TMO])) break; if (_sp > XB_SPIN_CAP) { atomicAdd(&(bar)[XB_TMO], 1u); break; } } } } while (0)
struct XcdBarrier { unsigned* bar; unsigned x; volatile LAS unsigned* st; };
__device__ __forceinline__ XcdBarrier xcd_barrier_post(unsigned* bar, volatile LAS unsigned* st) {
    XcdBarrier b; b.bar = bar; b.x = xb_xcc_id(); b.st = st;
    if (threadIdx.x == 0) (void)xb_add(&bar[XB_XCNT(b.x)], 1u);
    return b;
}
__device__ __forceinline__ void xcd_barrier_complete(unsigned* bar, unsigned x, unsigned& nloc, unsigned& nx) {
    const unsigned G = gridDim.x * gridDim.y * gridDim.z;
    unsigned sum, cnt, mine, sp = 0u;
    for (;;) {
        sum = 0u; cnt = 0u; mine = 0u;
#pragma unroll
        for (unsigned j = 0; j < 16; ++j) { const unsigned c = xb_ld(&bar[XB_XCNT(j)]); sum += c; cnt += (c > 0u) ? 1u : 0u; mine = (j == x) ? c : mine; }
        if (sum == G) break;
        __builtin_amdgcn_s_sleep(1);
        if ((++sp & 255u) == 0u) { if (xb_ld(&bar[XB_TMO])) break; if (sp > XB_SPIN_CAP) { atomicAdd(&bar[XB_TMO], 1u); break; } }
    }
    nloc = mine > 0u ? mine : 1u; nx = cnt > 0u ? cnt : 1u;
}
__device__ __forceinline__ void xcd_barrier(const XcdBarrier& b) {
    asm volatile("s_waitcnt vmcnt(0)" ::: "memory");
    __syncthreads();
    if (threadIdx.x == 0) {
        unsigned* bar = b.bar;
        __builtin_amdgcn_s_waitcnt(0);
        unsigned nloc = b.st[0], nx = b.st[1];
        if (nloc == 0u) { xcd_barrier_complete(bar, b.x, nloc, nx); b.st[0] = nloc; b.st[1] = nx; }
        const unsigned old = xb_add(&bar[XB_XSUB(b.x)], 1u);
        const unsigned gen = old / nloc;
#if BAR_FLAT
        if (old + 1u == (gen + 1u) * nloc) { __builtin_amdgcn_fence(__ATOMIC_RELEASE, "agent"); asm volatile("s_waitcnt vmcnt(0)" ::: "memory"); (void)xb_add(&bar[XB_TOP], 1u); }
        { const unsigned target = (gen + 1u) * nx; XB_SPIN(xb_ld(&bar[XB_TOP]) < target, bar); }
        __builtin_amdgcn_fence(__ATOMIC_ACQUIRE, "agent");
        asm volatile("s_waitcnt vmcnt(0)" ::: "memory");
#else
        if (old + 1u == (gen + 1u) * nloc) {
            __builtin_amdgcn_fence(__ATOMIC_RELEASE, "agent");
            asm volatile("s_waitcnt vmcnt(0)" ::: "memory");
            const unsigned og = xb_add(&bar[XB_TOP], 1u);
            const unsigned tg = og / nx;
            if (og + 1u == (tg + 1u) * nx) xb_add(&bar[XB_TOPGEN], 1u);
            else XB_SPIN(xb_ld(&bar[XB_TOPGEN]) == tg, bar);
            __builtin_amdgcn_fence(__ATOMIC_ACQUIRE, "agent");
            xb_add(&bar[XB_XGEN(b.x)], 1u);
            asm volatile("s_waitcnt vmcnt(0)" ::: "memory");
        } else {
            XB_SPIN(xb_ld(&bar[XB_XGEN(b.x)]) == gen, bar);
            __builtin_amdgcn_fence(__ATOMIC_ACQUIRE, "agent");
            asm volatile("s_waitcnt vmcnt(0)" ::: "memory");
        }
#endif
    }
    __syncthreads();
}

#ifdef EXTRA_LIGHT
__device__ __forceinline__ void xcd_barrier_light(const XcdBarrier& b) {
    asm volatile("s_waitcnt vmcnt(0)" ::: "memory");
    __syncthreads();
    if (threadIdx.x == 0) {
        unsigned* bar = b.bar;
        __builtin_amdgcn_s_waitcnt(0);
        unsigned nloc = b.st[0], nx = b.st[1];
        if (nloc == 0u) { xcd_barrier_complete(bar, b.x, nloc, nx); b.st[0] = nloc; b.st[1] = nx; }
        const unsigned old = xb_add(&bar[XB_XSUB(b.x)], 1u);
        const unsigned gen = old / nloc;
        if (old + 1u == (gen + 1u) * nloc) {

            asm volatile("s_waitcnt vmcnt(0)" ::: "memory");
            const unsigned og = xb_add(&bar[XB_TOP], 1u);
            const unsigned tg = og / nx;
            if (og + 1u == (tg + 1u) * nx) xb_add(&bar[XB_TOPGEN], 1u);
            else XB_SPIN(xb_ld(&bar[XB_TOPGEN]) == tg, bar);

            xb_add(&bar[XB_XGEN(b.x)], 1u);
            asm volatile("s_waitcnt vmcnt(0)" ::: "memory");
        } else {
            XB_SPIN(xb_ld(&bar[XB_XGEN(b.x)]) == gen, bar);

            asm volatile("s_waitcnt vmcnt(0)" ::: "memory");
        }
    }
    __syncthreads();
}

#endif
#ifndef WLAYOUT
#define WLAYOUT 0
#endif
constexpr int BM = 256, BK = 64, HALF = 128, HTB = HALF * BK * 2, STAGE_BYTES = 8 * HTB, NXCD = 8, WGM = 8;
__device__ __forceinline__ int lds_byte(int r, int c) { const int st = (r >> 4) * 2 + (c >> 5), rr = r & 15, cc = c & 31, ob = rr * 64 + cc * 2; return st * 1024 + (ob ^ (((ob >> 9) & 1) << 5)); }
__device__ __forceinline__ void stage_rc(int b, int& R, int& C) { const int st = b / 1024, sb = b % 1024, swz = sb ^ (((sb >> 9) & 1) << 5); R = (st >> 1) * 16 + swz / 64; C = (st & 1) * 32 + (swz % 64) / 2; }
__device__ __forceinline__ int perm32(int rho) { const int n = rho >> 4, i = rho & 15; return 8 * (i >> 2) + 4 * n + (i & 3); }

__device__ __forceinline__ const char* uni_ptr(const char* p) { const unsigned long long v = (unsigned long long)p; const unsigned lo = __builtin_amdgcn_readfirstlane((unsigned)v), hi = __builtin_amdgcn_readfirstlane((unsigned)(v >> 32)); return (const char*)(((unsigned long long)hi << 32) | lo); }
#ifndef BPAD
#define BPAD 0
#endif
static_assert(WLAYOUT == 0 && BPAD == 0, "the weight map is sized for the row-major layout");
__host__ __device__ constexpr size_t btile_bytes(int K) {
#if WLAYOUT
    return (size_t)(K / 64 + 1) * 32768;
#else
    return (size_t)(K + BPAD) * 512;
#endif
}
struct GUnit { int pm, pn; const char* A; const char* B; int ex; int nkt, kind, slot; };
__device__ __forceinline__ bool tile_order(int i, int G, int c, int nM, int nN, int& pm, int& pn) {
    const int nwg = nM * nN; const long L = (long)i * G + c; if (L >= nwg) return false;
    int wgid = (int)L; { const int q = nwg / NXCD, r = nwg % NXCD, xcd = wgid % NXCD, off = wgid / NXCD; wgid = (xcd < r ? xcd * (q + 1) : r * (q + 1) + (xcd - r) * q) + off; }
    const int nig = WGM * nN, gid = wgid / nig, fm = gid * WGM, gsz = (nM - fm) < WGM ? (nM - fm) : WGM;
    pm = fm + ((wgid % nig) % gsz); pn = (wgid % nig) / gsz; return true;
}
struct DenseSched {
    int nM, nN, G, c; const char* A; const char* B; size_t astep, bstep;
    __device__ __forceinline__ bool next(int i, GUnit& u) const { if (!tile_order(i, G, c, nM, nN, u.pm, u.pn)) return false; u.A = A + (size_t)u.pm * astep; u.B = B + (size_t)u.pn * bstep; u.ex = 0; u.nkt = 0; u.kind = 0; u.slot = 0; return true; }
};
struct GroupSched {
    int nM, nN, G, c; const char* A; const char* B; size_t astep, bstep; int acol_bytes, acol_shift;
    __device__ __forceinline__ bool next(int i, GUnit& u) const { if (!tile_order(i, G, c, nM, nN, u.pm, u.pn)) return false;
        u.A = A + (size_t)u.pm * astep + (size_t)(u.pn >> acol_shift) * acol_bytes; u.B = B + (size_t)u.pn * bstep; u.ex = 0; u.nkt = 0; u.kind = 0; u.slot = 0; return true; }
};
struct MoeSched {
    int nM, nN, G, c; const char* A; const char* B; size_t astep, bstep, estep; int pend[NE];
    __device__ __forceinline__ bool next(int i, GUnit& u) const { if (!tile_order(i, G, c, nM, nN, u.pm, u.pn)) return false;
        int e = 0;
#pragma unroll
        for (int k = 0; k < NE - 1; ++k) e += (u.pm >= pend[k]) ? 1 : 0;
        u.ex = e; u.A = A + (size_t)u.pm * astep; u.B = B + (size_t)e * estep + (size_t)u.pn * bstep; u.nkt = 0; u.kind = 0; u.slot = 0; return true; }
};
struct SKSched {
    int NP, P, s0, s1, x, r, j; const char* A; const char* B; size_t astep, bstep, estep; int pend[NE];
    __device__ __forceinline__ bool next(int i, GUnit& u) const {
        const int rem = s0 % P; int start;
        if (rem != 0) start = (i == 0) ? s0 : (s0 - rem + P) + (i - 1) * P; else start = s0 + i * P;
        if (start >= s1) return false;
        const int sp = start / P, k0 = start - sp * P; const int endp = (sp + 1) * P < s1 ? (sp + 1) * P : s1; const int len = endp - start;
        const int pm = sp * 8 + r; if (pm >= NP) return false;
        int e = 0;
#pragma unroll
        for (int k = 0; k < NE - 1; ++k) e += (pm >= pend[k]) ? 1 : 0;
        u.pm = pm; u.pn = j; u.ex = e; u.A = A + (size_t)pm * astep + (size_t)k0 * 65536; u.B = B + (size_t)e * estep + (size_t)j * bstep + (size_t)k0 * 256;
        u.nkt = 2 * len; u.kind = k0 > 0 ? 1 : (len < P ? 2 : 0); u.slot = (u.kind == 1 ? x - 1 : x) * 32 + r * 4 + j; return true; }
};

typedef f32x4 AccArr[2][2][4][2];
template <class T, class = void> struct epi_has_post { static constexpr bool value = false; };
template <class T> struct epi_has_post<T, decltype((void)T::POST)> { static constexpr bool value = T::POST; };
struct SKCtx { unsigned char* buf; unsigned* flags; unsigned* tmo; };
__device__ __forceinline__ void sk_store(const SKCtx& sk, const AccArr& acc, int slot, int tid, int lane) {
    const __amdgpu_buffer_rsrc_t rs = __builtin_amdgcn_make_buffer_rsrc(sk.buf + (size_t)slot * 262144, 0, 262144, 0x00020000);
#pragma unroll
    for (int a = 0; a < 2; ++a)
#pragma unroll
        for (int b = 0; b < 2; ++b)
#pragma unroll
            for (int m = 0; m < 4; ++m)
#pragma unroll
                for (int n = 0; n < 2; ++n) __builtin_amdgcn_raw_buffer_store_b128(__builtin_bit_cast(u32x4, acc[a][b][m][n]), rs, (unsigned)((((a * 2 + b) * 4 + m) * 2 + n) * 8192 + tid * 16), 0, 17);
    asm volatile("s_waitcnt vmcnt(0)" ::: "memory");
    __builtin_amdgcn_fence(__ATOMIC_RELEASE, "agent"); asm volatile("s_waitcnt vmcnt(0)" ::: "memory");
    if (lane == 0) __hip_atomic_fetch_add(sk.flags + 16 * slot, 1u, __ATOMIC_RELAXED, __HIP_MEMORY_SCOPE_AGENT);
}
__device__ __forceinline__ void sk_load_init(const SKCtx& sk, AccArr& acc, int slot, int tid) {
    { unsigned sp = 0; while (__builtin_amdgcn_readfirstlane(__hip_atomic_load(sk.flags + 16 * slot, __ATOMIC_RELAXED, __HIP_MEMORY_SCOPE_AGENT)) < 8u) { __builtin_amdgcn_s_sleep(2);
        if (++sp > (1u << 22)) { if (threadIdx.x == 0) __hip_atomic_store(sk.tmo, 1u, __ATOMIC_RELAXED, __HIP_MEMORY_SCOPE_AGENT); break; } } }
    __builtin_amdgcn_fence(__ATOMIC_ACQUIRE, "agent"); asm volatile("s_waitcnt vmcnt(0)" ::: "memory");
    const __amdgpu_buffer_rsrc_t rs = __builtin_amdgcn_make_buffer_rsrc(sk.buf + (size_t)slot * 262144, 0, 262144, 0x00020000);
    const unsigned vo = (unsigned)tid * 16u;
#pragma unroll
    for (int a = 0; a < 2; ++a)
#pragma unroll
        for (int b = 0; b < 2; ++b)
#pragma unroll
            for (int m = 0; m < 4; ++m)
#pragma unroll
                for (int n = 0; n < 2; ++n) acc[a][b][m][n] = __builtin_bit_cast(f32x4, __builtin_amdgcn_raw_buffer_load_b128(rs, vo, (unsigned)((((a * 2 + b) * 4 + m) * 2 + n) * 8192), 17));
    asm volatile("s_waitcnt vmcnt(0)" ::: "memory");
}
template <class Epi, class Sched, bool SK = false, bool ALIGN = true, bool GA = false, bool F8 = false>
__device__ __forceinline__ void gemm_phase(LAS unsigned char* lds, const int lda, const int nbr, const int K, const Sched& S, const Epi& E, const SKCtx sk = SKCtx{nullptr, nullptr, nullptr}, const size_t kpairA = 256, const int* gidx = nullptr) {
    const int tid = threadIdx.x, wid = __builtin_amdgcn_readfirstlane(tid >> 6), lane = tid & 63, wr = wid >> 2, wc = wid & 3, fr = lane & 15, fq = lane >> 4;
    const int nt_full = K / BK;
    unsigned voffA[2], voffB[2];
#pragma unroll
    for (int i = 0; i < 2; ++i) { int R, C; stage_rc(tid * 16 + i * 8192, R, C); const int Rb = Epi::PERM ? ((R & ~31) + perm32(R & 31)) : R;
        voffA[i] = (kpairA == 65536) ? (F8 ? (unsigned)(((C >> 4) * 256 + R) * 32 + (C & 15) * 2) : (unsigned)(((C >> 5) * 256 + R) * 64 + (C & 31) * 2)) : (unsigned)(R * lda + C) * 2u;
#if WLAYOUT
        voffB[i] = (unsigned)((C >> 3) * 256 + Rb) * 16u; }
#else
        voffB[i] = (unsigned)(Rb * (nbr + BPAD) + C) * 2u; }
#endif
    const size_t kstep = (kpairA == 65536) ? (size_t)32768 : (size_t)(BK * 2);
#if WLAYOUT
    const size_t hstepA = (size_t)HALF * lda * 2, hstepB = (size_t)HALF * 16, kstepB = (size_t)32768; (void)nbr;
#else
    const size_t hstepA = (kpairA == 65536) ? (size_t)HALF * (F8 ? 32 : 64) : (size_t)HALF * lda * 2, hstepB = (size_t)HALF * (nbr + BPAD) * 2, kstepB = (size_t)(BK * 2);
#endif
    const unsigned ldsw = (unsigned)wid * 1024u;
    const int aoff = lds_byte(wr * 64 + fr, fq * 8), boff = lds_byte(wc * 32 + fr, fq * 8);
#define PG8_SA(b, h) (((b) * 2 + (h)) * HTB)
#define PG8_SB(b, h) ((4 + (b) * 2 + (h)) * HTB)
#define PG8_STAGE(bufoff, gbase, voff) do { _Pragma("unroll") for (int _i = 0; _i < 2; ++_i) \
        __builtin_amdgcn_global_load_lds((const unsigned*)((const char*)(gbase) + (voff)[_i]), (LAS unsigned*)(lds + (bufoff) + ldsw + _i * 8192), 16, 0, 0); } while (0)
#define PG8_LDA(dst, b, h) do { _Pragma("unroll") for (int m = 0; m < 4; ++m) _Pragma("unroll") for (int k = 0; k < 2; ++k) dst[m][k] = *(const LAS bf16x8*)(lds + PG8_SA(b, h) + aoff + m * 2048 + k * 1024); } while (0)
#define PG8_LDB(dst, b, h) do { _Pragma("unroll") for (int n = 0; n < 2; ++n) _Pragma("unroll") for (int k = 0; k < 2; ++k) dst[n][k] = *(const LAS bf16x8*)(lds + PG8_SB(b, h) + boff + n * 2048 + k * 1024); } while (0)
#define PG8_CAT8(x) __builtin_shufflevector(__builtin_bit_cast(i32x4, (x)[0]), __builtin_bit_cast(i32x4, (x)[1]), 0, 1, 2, 3, 4, 5, 6, 7)
#define PG8_MMA(ai, bj, At, Bt) do { __builtin_amdgcn_s_setprio(1); _Pragma("unroll") for (int m = 0; m < 4; ++m) _Pragma("unroll") for (int n = 0; n < 2; ++n) { \
        if constexpr (F8) asm volatile("v_mfma_f32_16x16x128_f8f6f4 %0, %1, %2, %0" : "+v"(acc[ai][bj][m][n]) : "v"(PG8_CAT8(Bt[n])), "v"(PG8_CAT8(At[m])));     \
        else { _Pragma("unroll") for (int k = 0; k < 2; ++k) acc[ai][bj][m][n] = __builtin_amdgcn_mfma_f32_16x16x32_bf16(Bt[n][k], At[m][k], acc[ai][bj][m][n], 0, 0, 0); } } __builtin_amdgcn_s_setprio(0); } while (0)
#define PG8_WAIT_V(n) asm volatile("s_waitcnt vmcnt(" #n ")" ::: "memory")
#define PG8_WAIT_L(n) asm volatile("s_waitcnt lgkmcnt(" #n ")" ::: "memory")
#define PG8_BAR __builtin_amdgcn_s_barrier()
#define PG8_SCHED __builtin_amdgcn_sched_barrier(0)
    GUnit cur, nxt; int ui = 0;
    if (!S.next(0, cur)) return;
    unsigned vc[2][2] = {{0u, 0u}, {0u, 0u}}, vn[2][2] = {{0u, 0u}, {0u, 0u}};
    int gR[2], gC[2];
#pragma unroll
    for (int i = 0; i < 2; ++i) stage_rc(tid * 16 + i * 8192, gR[i], gC[i]);
#define PG8_GOFF(dst, pm_) do { if constexpr (GA) { _Pragma("unroll") for (int h_ = 0; h_ < 2; ++h_) _Pragma("unroll") for (int i_ = 0; i_ < 2; ++i_) \
        dst[h_][i_] = (unsigned)gidx[(pm_) * BM + h_ * HALF + gR[i_]] * (unsigned)(lda * 2) + (unsigned)(gC[i_] * 2); } } while (0)
    PG8_GOFF(vc, cur.pm);
    f32x4 acc[2][2][4][2];
#pragma unroll
    for (int a = 0; a < 2; ++a)
#pragma unroll
        for (int b = 0; b < 2; ++b)
#pragma unroll
            for (int m = 0; m < 4; ++m)
#pragma unroll
                for (int n = 0; n < 2; ++n) acc[a][b][m][n] = (f32x4){0.f, 0.f, 0.f, 0.f};
    bf16x8 At[4][2], B0[2][2], B1[2][2];
    const char* cA = uni_ptr(cur.A); const char* cB = uni_ptr(cur.B); int nt = SK ? __builtin_amdgcn_readfirstlane(cur.nkt) : nt_full;
    PG8_STAGE(PG8_SB(0, 0), cB, voffB); PG8_STAGE(PG8_SB(0, 1), cB + hstepB, voffB); PG8_STAGE(PG8_SA(0, 0), cA, (GA ? vc[0] : voffA)); PG8_STAGE(PG8_SA(0, 1), cA + (GA ? 0 : hstepA), (GA ? vc[1] : voffA));
    if (wr == 1) PG8_BAR;
    PG8_WAIT_V(2); PG8_BAR;
    PG8_STAGE(PG8_SB(1, 0), cB + kstepB, voffB); PG8_STAGE(PG8_SA(1, 0), cA + kstep, (GA ? vc[0] : voffA)); PG8_STAGE(PG8_SB(1, 1), cB + hstepB + kstepB, voffB);
    PG8_WAIT_V(6); PG8_BAR;
    for (;;) {
        const bool has_next = S.next(ui + 1, nxt);
        const char* nA = has_next ? uni_ptr(nxt.A) : cA; const char* nB = has_next ? uni_ptr(nxt.B) : cB;
        if (has_next) PG8_GOFF(vn, nxt.pm);
#pragma clang loop unroll(disable)
        for (int t = 0; t < nt; t += 2) {
            const bool last = (t == nt - 2);
            const char* a1 = cA + (size_t)(t >> 1) * kpairA + kstep;
            const char* a2 = last ? nA : cA + (size_t)((t >> 1) + 1) * kpairA; const char* b2 = last ? nB : cB + (size_t)(t + 2) * kstepB;
            const char* a3 = a2 + kstep; const char* b3 = b2 + kstepB;
            unsigned va2[2][2];
#pragma unroll
            for (int h_ = 0; h_ < 2; ++h_)
#pragma unroll
                for (int i_ = 0; i_ < 2; ++i_) va2[h_][i_] = GA ? ((last && has_next) ? vn[h_][i_] : vc[h_][i_]) : voffA[i_];
            const size_t hA = GA ? 0 : hstepA;
            PG8_LDB(B0, 0, 0); PG8_LDB(B1, 0, 1); PG8_SCHED; PG8_LDA(At, 0, 0); PG8_STAGE(PG8_SA(1, 1), a1 + hA, (GA ? vc[1] : voffA));
            if (Epi::NSTORE == 8 && t == 0 && ui > 0) PG8_WAIT_V(16); else PG8_WAIT_V(8);
            PG8_WAIT_L(0); PG8_BAR; PG8_MMA(0, 0, At, B0); PG8_MMA(0, 1, At, B1); PG8_BAR; PG8_SCHED;
            PG8_LDA(At, 0, 1); PG8_STAGE(PG8_SB(0, 0), b2, voffB); PG8_STAGE(PG8_SB(0, 1), b2 + hstepB, voffB); PG8_STAGE(PG8_SA(0, 0), a2, va2[0]);
            if (Epi::NSTORE == 8 && t == 0 && ui > 0) PG8_WAIT_V(16); else PG8_WAIT_V(8);
            PG8_WAIT_L(0); PG8_BAR; PG8_MMA(1, 0, At, B0); PG8_MMA(1, 1, At, B1); PG8_BAR; PG8_SCHED;
            PG8_LDB(B0, 1, 0); PG8_LDB(B1, 1, 1); PG8_SCHED; PG8_LDA(At, 1, 0); PG8_STAGE(PG8_SA(0, 1), a2 + hA, va2[1]);
            PG8_WAIT_V(8); PG8_WAIT_L(0); PG8_BAR; PG8_MMA(0, 0, At, B0); PG8_MMA(0, 1, At, B1); PG8_BAR; PG8_SCHED;
            PG8_LDA(At, 1, 1); PG8_STAGE(PG8_SB(1, 0), b3, voffB); PG8_STAGE(PG8_SB(1, 1), b3 + hstepB, voffB); PG8_STAGE(PG8_SA(1, 0), a3, va2[0]);
            PG8_WAIT_V(8); PG8_WAIT_L(0); PG8_BAR; PG8_MMA(1, 0, At, B0); PG8_MMA(1, 1, At, B1); PG8_BAR; PG8_SCHED;
        }
        if constexpr (F8) asm volatile("s_nop 7\n\ts_nop 7\n\ts_nop 3" ::: "memory");
        if constexpr (ALIGN) { if (wr == 0) PG8_BAR; }
        const LAS float* aux = (const LAS float*)(lds + STAGE_BYTES);
        const int kind = SK ? __builtin_amdgcn_readfirstlane(cur.kind) : 0, slot = SK ? __builtin_amdgcn_readfirstlane(cur.slot) : 0;
        (void)kind; (void)slot; (void)sk;
        {
        if constexpr (Epi::ROWSCALE) { if (tid < 256) ((LAS float*)(lds + STAGE_BYTES))[tid] = E.rowscale(cur.pm * BM + tid); PG8_WAIT_L(0); PG8_BAR; }
        E(acc, cur, wr, wc, fr, fq, aux);
        if constexpr (epi_has_post<Epi>::value) { PG8_WAIT_V(0); PG8_BAR; E.post(cur, tid); }
        }
        if (!has_next) break;
        {
#pragma unroll
        for (int a = 0; a < 2; ++a)
#pragma unroll
            for (int b = 0; b < 2; ++b)
#pragma unroll
                for (int m = 0; m < 4; ++m)
#pragma unroll
                    for (int n = 0; n < 2; ++n) acc[a][b][m][n] = (f32x4){0.f, 0.f, 0.f, 0.f};
        }
        cur = nxt; cA = nA; cB = nB; ++ui;
        if constexpr (GA) { _Pragma("unroll") for (int h_ = 0; h_ < 2; ++h_) _Pragma("unroll") for (int i_ = 0; i_ < 2; ++i_) vc[h_][i_] = vn[h_][i_]; } if constexpr (SK) nt = __builtin_amdgcn_readfirstlane(cur.nkt);
        if constexpr (ALIGN) { if (wr == 1) PG8_BAR; }
    }
    PG8_WAIT_V(0);
    if constexpr (!ALIGN) { if (wr == 0) PG8_BAR; }
    PG8_BAR;
#undef PG8_GOFF
#undef PG8_SA
#undef PG8_SB
#undef PG8_STAGE
#undef PG8_LDA
#undef PG8_LDB
#undef PG8_MMA
#undef PG8_CAT8
#undef PG8_WAIT_V
#undef PG8_WAIT_L
#undef PG8_BAR
#undef PG8_SCHED
}
typedef f32x4 AccT[2][2][4][2];
__device__ __forceinline__ void st_bf16x8(bf16_t* p, f32x4 v0, f32x4 v1) { u32x4 w; w.x = pk2(v0[0], v0[1]); w.y = pk2(v0[2], v0[3]); w.z = pk2(v1[0], v1[1]); w.w = pk2(v1[2], v1[3]); *(u32x4*)p = w; }
#ifndef ACT_STORE_POL
#define ACT_STORE_POL 0
#endif
__device__ __forceinline__ void st_bf16x8_pol(bf16_t* p, f32x4 v0, f32x4 v1, int pol) {
    u32x4 w; w.x = pk2(v0[0], v0[1]); w.y = pk2(v0[2], v0[3]); w.z = pk2(v1[0], v1[1]); w.w = pk2(v1[2], v1[3]);
    if (pol == 4) asm volatile("global_store_dwordx4 %0, %1, off sc1" :: "v"(p), "v"(w) : "memory");
    else if (pol == 5) asm volatile("global_store_dwordx4 %0, %1, off nt" :: "v"(p), "v"(w) : "memory");
    else *(u32x4*)p = w;
}
__device__ __forceinline__ void st_bf16x4(bf16_t* p, f32x4 v) { u32x2 w; w.x = pk2(v[0], v[1]); w.y = pk2(v[2], v[3]); *(u32x2*)p = w; }
__device__ __forceinline__ float sumsq4(f32x4 v) { return (v[0] * v[0] + v[1] * v[1]) + (v[2] * v[2] + v[3] * v[3]); }
__device__ __forceinline__ float red_fq(float s) { s += __shfl_xor(s, 16); s += __shfl_xor(s, 32); return s; }
__device__ __forceinline__ void rope_rot(f32x4& x1, f32x4& x2, const float* cs  ) {
    const f32x4 t0 = *(const f32x4*)cs, t1 = *(const f32x4*)(cs + 4);
    const f32x4 c = {t0[0], t0[2], t1[0], t1[2]}, s = {t0[1], t0[3], t1[1], t1[3]};
    const f32x4 y1 = x1 * c - x2 * s, y2 = x2 * c + x1 * s; x1 = y1; x2 = y2;
}

struct EpiLat {
    static constexpr bool PERM = true, ROWSCALE = true; static constexpr int NSTORE = 0;
    bf16_t* lat; float* slot24; const float* ssq; bf16_t* kb; const float* rope;
    __device__ __forceinline__ float rowscale(int row) const { return rstd16(ssq, row); }
    __device__ __forceinline__ void operator()(const AccT& acc, const GUnit& u, int wr, int wc, int fr, int fq, const LAS float* aux) const {
#pragma unroll
        for (int ai = 0; ai < 2; ++ai)
#pragma unroll
            for (int m = 0; m < 4; ++m) { const int row = u.pm * BM + ai * HALF + wr * 64 + m * 16 + fr; const float rs = aux[ai * HALF + wr * 64 + m * 16 + fr];
#pragma unroll
                for (int bj = 0; bj < 2; ++bj) { const int cb = u.pn * BM + bj * HALF + wc * 32;
                    f32x4 v0 = acc[ai][bj][m][0] * rs, v1 = acc[ai][bj][m][1] * rs;
                    if (cb < 640) { st_bf16x8(lat + (size_t)row * 768 + cb + 8 * fq, v0, v1);
                        const float ss = red_fq(sumsq4(v0) + sumsq4(v1)); if (fq == 0) slot24[(size_t)row * 24 + u.pn * 8 + bj * 4 + wc] = ss; }
                    else if (cb == 640) { rope_rot(v0, v1, rope + (size_t)row * 32 + 8 * fq);
                        u32x4 w; w.x = pk2(v0[0], v0[1]); w.y = pk2(v0[2], v0[3]); w.z = pk2(v1[0], v1[1]); w.w = pk2(v1[2], v1[3]);
                        bf16_t* kp = kb + (size_t)row * 1536 + 64 + 8 * fq;
#pragma unroll
                        for (int hh = 0; hh < NH; ++hh) *(u32x4*)(kp + hh * 96) = w; } } }
    }
};
struct EpiQ {
    static constexpr bool PERM = true, ROWSCALE = true; static constexpr int NSTORE = 0;
    bf16_t* q; const float* slot24; const float* rope;
    __device__ __forceinline__ float rowscale(int row) const { const f32x4* sp = (const f32x4*)(slot24 + (size_t)row * 24); const float ss = (hsum4(sp[0]) + hsum4(sp[1])) + hsum4(sp[2]); return 1.0f / sqrtf(ss * (1.0f / 384.0f) + RMS_EPS); }
    __device__ __forceinline__ void operator()(const AccT& acc, const GUnit& u, int wr, int wc, int fr, int fq, const LAS float* aux) const {
#pragma unroll
        for (int ai = 0; ai < 2; ++ai)
#pragma unroll
            for (int m = 0; m < 4; ++m) { const int row = u.pm * BM + ai * HALF + wr * 64 + m * 16 + fr;
                const float rs = aux[ai * HALF + wr * 64 + m * 16 + fr];
#pragma unroll
                for (int bj = 0; bj < 2; ++bj) { const int cb = u.pn * BM + bj * HALF + wc * 32; const int gb = cb >> 5;
                    f32x4 v0 = acc[ai][bj][m][0] * rs, v1 = acc[ai][bj][m][1] * rs;
                    if (gb % 3 == 2) rope_rot(v0, v1, rope + (size_t)row * 32 + 8 * fq);
                    st_bf16x8(q + (size_t)row * 1536 + cb + 8 * fq, v0, v1); } }
    }
};
struct EpiKV {
    static constexpr bool PERM = true, ROWSCALE = true; static constexpr int NSTORE = 0;
    bf16_t* kb; bf16_t* vb; const float* slot24;
    __device__ __forceinline__ float rowscale(int row) const { const f32x4* sp = (const f32x4*)(slot24 + (size_t)row * 24 + 12); const float ss = hsum4(sp[0]) + hsum4(sp[1]); return 1.0f / sqrtf(ss * (1.0f / 256.0f) + RMS_EPS); }
    __device__ __forceinline__ void operator()(const AccT& acc, const GUnit& u, int wr, int wc, int fr, int fq, const LAS float* aux) const {
#pragma unroll
        for (int ai = 0; ai < 2; ++ai)
#pragma unroll
            for (int m = 0; m < 4; ++m) { const int row = u.pm * BM + ai * HALF + wr * 64 + m * 16 + fr;
                const float rs = aux[ai * HALF + wr * 64 + m * 16 + fr];
#pragma unroll
                for (int bj = 0; bj < 2; ++bj) { const int head = u.pn * 2 + bj;
                    const f32x4 v0 = acc[ai][bj][m][0] * rs, v1 = acc[ai][bj][m][1] * rs;
                    bf16_t* p = (wc < 2) ? kb + (size_t)row * 1536 + head * 96 + wc * 32 + 8 * fq : vb + (size_t)row * 1024 + head * 64 + (wc - 2) * 32 + 8 * fq;
                    st_bf16x8(p, v0, v1); } }
    }
};
#ifndef HB_ONLY
#define HB_ONLY 0
#endif
__device__ __forceinline__ f32x4 hilo_ld(const bf16_t* hi, const bf16_t* lo, size_t off) { const u32x2 a = *(const u32x2*)(hi + off);
#if HB_ONLY
    (void)lo; return (f32x4){bflo(a.x), bfhi(a.x), bflo(a.y), bfhi(a.y)}; }
#else
    const u32x2 b = *(const u32x2*)(lo + off);
    return (f32x4){bflo(a.x) + bflo(b.x), bfhi(a.x) + bfhi(b.x), bflo(a.y) + bflo(b.y), bfhi(a.y) + bfhi(b.y)}; }
#endif
__device__ __forceinline__ void hilo_st(bf16_t* hi, bf16_t* lo, size_t off, f32x4 o) { u32x2 h; h.x = pk2(o[0], o[1]); h.y = pk2(o[2], o[3]);
#if HB_ONLY
    (void)lo; *(u32x2*)(hi + off) = h; }
#else
    const f32x4 r = o - (f32x4){bflo(h.x), bfhi(h.x), bflo(h.y), bfhi(h.y)}; u32x2 l; l.x = pk2(r[0], r[1]); l.y = pk2(r[2], r[3]); *(u32x2*)(hi + off) = h; *(u32x2*)(lo + off) = l; }
#endif
struct EpiRes {
    static constexpr bool PERM = false, ROWSCALE = false; static constexpr int NSTORE = 0;
    const float* basef; bf16_t* hb; bf16_t* lo; float* ssq; const float* colscale; unsigned char* x8; float ascale;
    __device__ __forceinline__ void operator()(const AccT& acc, const GUnit& u, int wr, int wc, int fr, int fq, const LAS float* aux) const {
#pragma unroll
        for (int ai = 0; ai < 2; ++ai)
#pragma unroll
            for (int m = 0; m < 4; ++m) { const int row = u.pm * BM + ai * HALF + wr * 64 + m * 16 + fr; float ss = 0.f;
#pragma unroll
                for (int bj = 0; bj < 2; ++bj)
#pragma unroll
                    for (int n = 0; n < 2; ++n) { const int col = u.pn * BM + bj * HALF + wc * 32 + n * 16 + 4 * fq; const size_t off = (size_t)row * D + col;
                        f32x4 a = acc[ai][bj][m][n] * ascale; if (colscale) a = a * *(const f32x4*)(colscale + col);
                        const f32x4 o = (basef ? *(const f32x4*)(basef + off) : hilo_ld(hb, lo, off)) + a; hilo_st(hb, lo, off, o); ss += sumsq4(o);
                        if (x8) *(unsigned*)(x8 + off) = pk_fp8x4(o[0], o[1], o[2], o[3]); }
                ss = red_fq(ss); if (fq == 0) ssq[(size_t)row * 16 + u.pn * 4 + wc] = ss; }
    }
};
template <bool MOE, bool F8 = false> struct EpiSwiglu {
    static constexpr bool PERM = true, ROWSCALE = true; static constexpr int NSTORE = 8;
    bf16_t* act; const float* rowsrc; int var; float rmul;
    __device__ __forceinline__ float rowscale(int row) const { return (MOE ? rowsrc[row] : rstd16(rowsrc, row)) * rmul; }
    __device__ __forceinline__ void operator()(const AccT& acc, const GUnit& u, int wr, int wc, int fr, int fq, const LAS float* aux) const {
        if (var == 1) return;
        char* blk = (char*)act + (size_t)__builtin_amdgcn_readfirstlane(u.pm * (FF / 128) + u.pn) * (F8 ? 32768 : 65536);
        const unsigned lo = F8 ? (unsigned)((wc * 256 + wr * 64 + fr) * 32 + fq * 8) : (unsigned)((wc * 256 + wr * 64 + fr) * 64 + fq * 16);
#pragma unroll
        for (int ai = 0; ai < 2; ++ai)
#pragma unroll
            for (int m = 0; m < 4; ++m) { const float rs = aux[ai * HALF + wr * 64 + m * 16 + fr];
                f32x4 o[2];
                const float ke = rs * -1.4426950408889634f, s2 = rs * rs * (F8 ? F8_SA : 1.f);
#pragma unroll
                for (int n = 0; n < 2; ++n) { const f32x4 t = acc[ai][0][m][n] * ke, gu = (acc[ai][0][m][n] * acc[ai][1][m][n]) * s2;
                    const f32x4 d = (f32x4){fast_exp2(t[0]), fast_exp2(t[1]), fast_exp2(t[2]), fast_exp2(t[3])} + 1.0f;
                    o[n] = gu * (f32x4){fast_rcp(d[0]), fast_rcp(d[1]), fast_rcp(d[2]), fast_rcp(d[3])}; }
                if constexpr (F8) { u32x2 q; q.x = pk_fp8x4(o[0][0], o[0][1], o[0][2], o[0][3]); q.y = pk_fp8x4(o[1][0], o[1][1], o[1][2], o[1][3]);
                    *(u32x2*)(blk + lo + (unsigned)((ai * HALF + m * 16) * 32)) = q; }
                else st_bf16x8_pol((bf16_t*)(blk + lo + (unsigned)((ai * HALF + m * 16) * 64)), o[0], o[1], ACT_STORE_POL); }
    }
};
struct EpiMoeDown {
    static constexpr bool PERM = true, ROWSCALE = true; static constexpr int NSTORE = 0;
    bf16_t* out; const float* rowgate; bf16_t* out2;
    __device__ __forceinline__ float rowscale(int row) const { return rowgate[row]; }
    __device__ __forceinline__ void operator()(const AccT& acc, const GUnit& u, int wr, int wc, int fr, int fq, const LAS float* aux) const {
#pragma unroll
        for (int ai = 0; ai < 2; ++ai)
#pragma unroll
            for (int m = 0; m < 4; ++m) { const int row = u.pm * BM + ai * HALF + wr * 64 + m * 16 + fr; const float g = aux[ai * HALF + wr * 64 + m * 16 + fr];
#pragma unroll
                for (int bj = 0; bj < 2; ++bj) st_bf16x8((u.kind == 1 ? out2 : out) + (size_t)row * D + u.pn * BM + bj * HALF + wc * 32 + 8 * fq, acc[ai][bj][m][0] * g, acc[ai][bj][m][1] * g); }
    }
};
template <bool GELU0, bool GELU1> struct EpiSplit2 {
    static constexpr bool PERM = true, ROWSCALE = true; static constexpr int NSTORE = 0;
    bf16_t* o0; bf16_t* o1; const float* ssq;
    __device__ __forceinline__ float rowscale(int row) const { return rstd16(ssq, row); }
    __device__ __forceinline__ void operator()(const AccT& acc, const GUnit& u, int wr, int wc, int fr, int fq, const LAS float* aux) const {
        const bool second = u.pn >= 4; bf16_t* ob = second ? o1 : o0; const int ct = (u.pn & 3) * BM; const bool gl = second ? GELU1 : GELU0;
#pragma unroll
        for (int ai = 0; ai < 2; ++ai)
#pragma unroll
            for (int m = 0; m < 4; ++m) { const int row = u.pm * BM + ai * HALF + wr * 64 + m * 16 + fr; const float rs = aux[ai * HALF + wr * 64 + m * 16 + fr];
#pragma unroll
                for (int bj = 0; bj < 2; ++bj) { f32x4 v0 = acc[ai][bj][m][0] * rs, v1 = acc[ai][bj][m][1] * rs;
                    if (gl) {
#pragma unroll
                        for (int i = 0; i < 4; ++i) { v0[i] = gelu_tanh_f(v0[i]); v1[i] = gelu_tanh_f(v1[i]); } }
                    st_bf16x8(ob + (size_t)row * D + ct + bj * HALF + wc * 32 + 8 * fq, v0, v1); } }
    }
};
__device__ __forceinline__ float one_minus_exp(float x) {
    const float t = -x * (1.0f + x * (0.5f + x * 0.16666667f));
    const float e = 1.0f - fast_exp2(1.4426950408889634f * x); return x > -0.0078125f ? t : e;
}
struct EpiLruGate {
    static constexpr bool PERM = false, ROWSCALE = false, POST = true; static constexpr int NSTORE = 0;
    unsigned* ab; const bf16_t* xcb; const float* ba; const float* bx; const float* sp8; f32x2* carry;
    __device__ __forceinline__ void post(const GUnit& u, int tid) const {
        const int chunk = tid >> 7, c = u.pn * HALF + (tid & 127); const size_t r0 = (size_t)(u.pm * BM + chunk * 64);
        float A = 1.f, H = 0.f; const unsigned* p = ab + r0 * D + c;
#pragma unroll 1
        for (int t0 = 0; t0 < 64; t0 += 32) { unsigned w[32];
#pragma unroll
            for (int q = 0; q < 32; ++q) w[q] = p[(size_t)(t0 + q) * D];
#pragma unroll
            for (int q = 0; q < 32; ++q) { const float a = fast_exp2(bflo(w[q])), bb = bfhi(w[q]); A *= a; H = a * H + bb; } }
        carry[(r0 >> 6) * D + c] = (f32x2){A, H};
    }
    __device__ __forceinline__ void operator()(const AccT& acc, const GUnit& u, int wr, int wc, int fr, int fq, const LAS float* aux) const {
#pragma unroll
        for (int n = 0; n < 2; ++n) { const int c = u.pn * HALF + wc * 32 + n * 16 + 4 * fq;
            const f32x4 vba = *(const f32x4*)(ba + c), vbx = *(const f32x4*)(bx + c), vsp = *(const f32x4*)(sp8 + c);
#pragma unroll
            for (int ai = 0; ai < 2; ++ai)
#pragma unroll
                for (int m = 0; m < 4; ++m) { const int row = u.pm * BM + ai * HALF + wr * 64 + m * 16 + fr; const size_t off = (size_t)row * D + c;
                    const u32x2 xw = *(const u32x2*)(xcb + off); const f32x4 xc = {bflo(xw.x), bfhi(xw.x), bflo(xw.y), bfhi(xw.y)};
                    const f32x4 rp = acc[ai][0][m][n] + vba, ip = acc[ai][1][m][n] + vbx; f32x4 a, b;
#pragma unroll
                    for (int i = 0; i < 4; ++i) { const float la = -vsp[i] * sigmoid_f(rp[i]); a[i] = 1.4426950408889634f * la; b[i] = __builtin_amdgcn_sqrtf(one_minus_exp(2.0f * la)) * (sigmoid_f(ip[i]) * xc[i]); }
                    u32x4 w; w.x = pk2(a[0], b[0]); w.y = pk2(a[1], b[1]); w.z = pk2(a[2], b[2]); w.w = pk2(a[3], b[3]); *(u32x4*)(ab + off) = w; } }
    }
};
struct Args { const void* in[35]; float* out; unsigned char* ws; float* hsrc; int ph_lo, ph_hi; unsigned wmask, lmask; int nrep, pad; };
struct Frame {
    LAS unsigned char* lds; unsigned char* ws; const void* const* in; float* h;
    int tid, lane, wave, vcu, G, gw, NGW;
};
#define WSP(T, off) ((T*)(F.ws + (off)))
#define INF(i) ((const float*)F.in[i])

enum { MODE_ID = 0, MODE_GU = 1, MODE_ROPEQ = 2, MODE_ROPELAT = 3 };
struct Fam { const float* src; const float* g; bf16_t* dst; int Ksrc, Kdst, N, Npad, ldt, mode, row_off, ksrc_off; float scale; int f8; };
__device__ __forceinline__ int rope_pos(int d) { return 8 * ((d >> 2) & 3) + 4 * (d >> 4) + (d & 3); }
__device__ __forceinline__ int map_row(int mode, int n) {
    if (mode == MODE_GU) return ((n >> 7) << 8) + (n & 127);
    if (mode == MODE_ROPEQ) { const int head = n / 96, loc = n - head * 96; return loc >= 64 ? head * 96 + 64 + rope_pos(loc - 64) : n; }
    if (mode == MODE_ROPELAT) return (n >= 640 && n < 672) ? 640 + rope_pos(n - 640) : n;
    return n;
}
#if WLAYOUT
__device__ __forceinline__ void conv_item(const Fam& f, int item, int lane) {
    const int nblk = (f.Npad + 63) >> 6, kb = item / nblk, nb = item - kb * nblk, k0 = 64 * kb, n = nb * 64 + lane;
    float v[64];
    const bool okn = n < f.N;
#pragma unroll
    for (int r = 0; r < 64; ++r) { const int srow = k0 + r - f.ksrc_off; v[r] = 0.f; if (okn && srow >= 0 && srow < f.Ksrc) v[r] = f.src[(size_t)srow * f.N + n]; }
#pragma unroll
    for (int r = 0; r < 64; ++r) { const int srow = k0 + r - f.ksrc_off; const float gk = (f.g && srow >= 0 && srow < f.Ksrc) ? f.g[srow] * f.scale : f.scale; v[r] *= gk; }
    if (n < f.Npad) {
        const int drow = map_row(f.mode, n) + f.row_off;
        bf16_t* dp = f.dst + ((size_t)(drow >> 8) * (btile_bytes(f.Kdst) / 2)) + ((size_t)(8 * kb) * 256 + (drow & 255)) * 8;
#pragma unroll
        for (int q = 0; q < 8; ++q) { u32x4 o; o.x = pk2(v[8 * q + 0], v[8 * q + 1]); o.y = pk2(v[8 * q + 2], v[8 * q + 3]); o.z = pk2(v[8 * q + 4], v[8 * q + 5]); o.w = pk2(v[8 * q + 6], v[8 * q + 7]);
            *(u32x4*)(dp + (size_t)q * 2048) = o; } }
}
#else
#ifdef CONV_NT
#define CONV_LD(p) __builtin_nontemporal_load(p)
#else
#define CONV_LD(p) (*(p))
#endif
__device__ __forceinline__ void conv_load(const Fam& f, int item, int lane, f32x4 (&v)[16]) {
    const int nblk = f.Npad / 64, kb = item / nblk, nb = item - kb * nblk, k0 = 64 * kb, n0 = 64 * nb;
    const int col = n0 + 4 * (lane & 15);
#pragma unroll
    for (int i = 0; i < 16; ++i) { const int kk = 4 * i + (lane >> 4), srow = k0 + kk - f.ksrc_off;
        v[i] = (f32x4){0.f, 0.f, 0.f, 0.f};
        if (srow >= 0 && srow < f.Ksrc && col < f.N) v[i] = CONV_LD((const f32x4*)(f.src + (size_t)srow * f.N + col)); }
}
__device__ __forceinline__ void conv_store(const Fam& f, LAS float* scr, int item, int lane, const f32x4 (&v)[16]) {
    const int nblk = f.Npad / 64, kb = item / nblk, nb = item - kb * nblk, k0 = 64 * kb, n0 = 64 * nb;
#pragma unroll
    for (int i = 0; i < 16; ++i) { const int kk = 4 * i + (lane >> 4); LAS float* s = scr + kk * 65 + 4 * (lane & 15); s[0] = v[i][0]; s[1] = v[i][1]; s[2] = v[i][2]; s[3] = v[i][3]; }
    asm volatile("s_waitcnt lgkmcnt(0)" ::: "memory");
    const int c = lane & 7; float gk[8];
#pragma unroll
    for (int t = 0; t < 8; ++t) { const int srow = k0 + 8 * c + t - f.ksrc_off; gk[t] = (f.g && srow >= 0 && srow < f.Ksrc) ? f.g[srow] * f.scale : f.scale; }
#pragma unroll
    for (int j = 0; j < 8; ++j) { const int n = (lane >> 3) + 8 * j; const LAS float* s = scr + (8 * c) * 65 + n;
        u32x4 o; o.x = pk2(s[0 * 65] * gk[0], s[1 * 65] * gk[1]); o.y = pk2(s[2 * 65] * gk[2], s[3 * 65] * gk[3]); o.z = pk2(s[4 * 65] * gk[4], s[5 * 65] * gk[5]); o.w = pk2(s[6 * 65] * gk[6], s[7 * 65] * gk[7]);
        const int drow = map_row(f.mode, n0 + n) + f.row_off;
        if (f.f8) { u32x2 q; q.x = pk_fp8x4(s[0 * 65] * gk[0], s[1 * 65] * gk[1], s[2 * 65] * gk[2], s[3 * 65] * gk[3]); q.y = pk_fp8x4(s[4 * 65] * gk[4], s[5 * 65] * gk[5], s[6 * 65] * gk[6], s[7 * 65] * gk[7]);
            *(u32x2*)((char*)f.dst + (size_t)drow * f.ldt + k0 + 8 * c) = q; }
        else *(u32x4*)(f.dst + (size_t)drow * f.ldt + k0 + 8 * c) = o; }
    asm volatile("s_waitcnt lgkmcnt(0)" ::: "memory");
}
#endif
constexpr int NFAM = 17;
__device__ __forceinline__ int fam_count(int f) { return (f == 5 || f == 6) ? 8 : (f == 8) ? 4 : (f >= 11 && f <= 13) ? 2 : (f >= 14) ? 16 : 1; }
__device__ __forceinline__ Fam get_fam(const Frame& F, int f, int j) {
    Fam r; r.g = nullptr; r.mode = MODE_ID; r.row_off = 0; r.ksrc_off = 0; r.scale = 1.f; r.f8 = 0;
    const float* norm_mix = INF(2); const float* norm_ffn = INF(3);
    switch (f) {
    case 0: r.src = INF(5); r.g = norm_mix; r.dst = WSP(bf16_t, W_MLA_IN); r.Ksrc = r.Kdst = 1024; r.N = 672; r.Npad = 768; r.ldt = 768; r.mode = MODE_ROPELAT; break;
    case 1: r.src = INF(8); r.g = INF(6); r.dst = WSP(bf16_t, W_UQ); r.Ksrc = r.Kdst = 384; r.N = r.Npad = 1536; r.ldt = 1536; r.mode = MODE_ROPEQ; r.scale = 0.10206207261596575f * 1.4426950408889634f; break;
    case 2: r.src = INF(9); r.g = INF(7); r.dst = WSP(bf16_t, W_UKV); r.Ksrc = r.Kdst = 256; r.N = r.Npad = 2048; r.ldt = 2048; break;
    case 3: r.src = INF(10); r.dst = WSP(bf16_t, W_O); r.Ksrc = r.Kdst = 1024; r.N = r.Npad = 1024; r.ldt = 1024; break;
    case 4: r.src = INF(11); r.g = norm_mix + 1024; r.dst = WSP(bf16_t, W_LRU_IN); r.Ksrc = r.Kdst = 1024; r.N = r.Npad = 2048; r.ldt = 2048; break;
    case 5: case 6: r.src = INF(f == 5 ? 14 : 16) + (size_t)j * 16384; r.dst = WSP(bf16_t, W_LRU_G) + (size_t)j * (btile_bytes(256) / 2); r.Ksrc = 128; r.Kdst = 256; r.N = r.Npad = 128; r.ldt = 256; r.row_off = (f == 6) ? 128 : 0; r.ksrc_off = (j & 1) * 128; break;
    case 7: r.src = INF(19); r.dst = WSP(bf16_t, W_LRU_OUT); r.Ksrc = r.Kdst = 1024; r.N = r.Npad = 1024; r.ldt = 1024; break;
    case 8: r.src = INF(20) + (size_t)j * 65536; r.dst = WSP(bf16_t, W_POOL) + (size_t)j * (btile_bytes(256) / 2); r.Ksrc = r.Kdst = 256; r.N = r.Npad = 256; r.ldt = 256; break;
    case 9: r.src = INF(22); r.g = norm_mix + 3072; r.dst = WSP(bf16_t, W_GM_IN); r.Ksrc = r.Kdst = 1024; r.N = r.Npad = 2048; r.ldt = 2048; break;
    case 10: r.src = INF(27); r.dst = WSP(bf16_t, W_GM_OUT); r.Ksrc = r.Kdst = 1024; r.N = r.Npad = 1024; r.ldt = 1024; break;
    case 11: case 12: r.src = INF(f == 11 ? 28 : 29) + (size_t)j * D * FF; r.g = norm_ffn + 2048 * j; r.dst = (bf16_t*)(F.ws + W_FFN + (size_t)j * WSTRIDE); r.Ksrc = r.Kdst = 1024; r.N = r.Npad = FF; r.ldt = 2 * FF; r.mode = MODE_GU; r.row_off = (f == 12) ? 128 : 0; if (ffn_f8(j)) { r.f8 = 1; r.scale = F8_SW; } break;
    case 13: r.src = INF(30) + (size_t)j * D * FF; r.dst = (bf16_t*)(F.ws + W_FFN + (size_t)j * WSTRIDE + WDOWN_OFF); r.Ksrc = r.Kdst = FF; r.N = r.Npad = 1024; r.ldt = 1024; if (ffn_f8(j)) { r.f8 = 1; r.scale = F8_SW; } break;
    case 14: case 15: r.src = INF(f == 14 ? 32 : 33) + (size_t)j * D * FF; r.g = norm_ffn + 1024 + 2048 * (j >> 3); r.dst = (bf16_t*)(F.ws + W_MOE + (size_t)j * WSTRIDE); r.Ksrc = r.Kdst = 1024; r.N = r.Npad = FF; r.ldt = 2 * FF; r.mode = MODE_GU; r.row_off = (f == 15) ? 128 : 0; if (moe_f8(j >> 3)) { r.f8 = 1; r.scale = F8_SW; } break;
    default: r.src = INF(34) + (size_t)j * D * FF; r.dst = (bf16_t*)(F.ws + W_MOE + (size_t)j * WSTRIDE + WDOWN_OFF); r.Ksrc = r.Kdst = FF; r.N = r.Npad = 1024; r.ldt = 1024; if (moe_f8(j >> 3)) { r.f8 = 1; r.scale = F8_SW; } break;
    }
#if !WLAYOUT
    r.ldt = r.Kdst + BPAD;
#endif
    return r;
}
__device__ __forceinline__ void stats_row(const Frame& F, const float* src, int row, float* rstd_out) {
    const f32x4* xr = (const f32x4*)(src + (size_t)row * D) + F.lane; f32x4 v[4]; float s = 0.f;
#pragma unroll
    for (int j = 0; j < 4; ++j) { v[j] = xr[64 * j]; s += sumsq4(v[j]); }
    s = wave_sum(s);
    bf16_t* hb = WSP(bf16_t, WS_HB) + (size_t)row * D + 4 * F.lane;
#pragma unroll
    for (int j = 0; j < 4; ++j) st_bf16x4(hb + 256 * j, v[j]);
    if (F.lane < 16) WSP(float, WS_SSQ)[(size_t)row * 16 + F.lane] = F.lane == 0 ? s : 0.f;
    if (rstd_out && F.lane == 0) rstd_out[row] = 1.0f / sqrtf(s * (1.0f / 1024.0f) + RMS_EPS);
}
__device__ __forceinline__ void phase_prologue(const Frame& F, unsigned wmask, unsigned lmask, const float* hsrc) {
#if WLAYOUT
    int base = 0;
    for (int f = 0; f < NFAM; ++f) { if (!((wmask >> f) & 1u)) continue;
        const int cnt = fam_count(f);
        for (int j = 0; j < cnt; ++j) {
            if (f >= 11 && f <= 13 && !((lmask >> j) & 1u)) continue;
            if (f >= 14 && !((lmask >> (2 + (j >> 3))) & 1u)) continue;
            const Fam fm = get_fam(F, f, j); const int nitems = (fm.Kdst / 64) * ((fm.Npad + 63) >> 6);
            for (int it = (F.gw + F.NGW - base % F.NGW) % F.NGW; it < nitems; it += F.NGW) conv_item(fm, it, F.lane);
            base += nitems; } }
#else
    { LAS float* scr = (LAS float*)(F.lds + F.wave * 16640);
      int cf = -1, cj = 0, cbase = 0, cn = 0; Fam cfm;
      auto seek = [&](int g) -> bool {
          while (cf < NFAM && (cf < 0 || g >= cbase + cn)) {
              if (cf >= 0) { cbase += cn; ++cj; if (cj >= fam_count(NFAM - 1 - cf)) { ++cf; cj = 0; } } else { cf = 0; cj = 0; }
              cn = 0;
              while (cf < NFAM) { const int rf = NFAM - 1 - cf;
                  const bool en = ((wmask >> rf) & 1u) && !(rf >= 11 && rf <= 13 && !((lmask >> cj) & 1u)) && !(rf >= 14 && !((lmask >> (2 + (cj >> 3))) & 1u));
                  if (en) break; ++cj; if (cj >= fam_count(rf)) { ++cf; cj = 0; } }
              if (cf < NFAM) { cfm = get_fam(F, NFAM - 1 - cf, cj); cn = (cfm.Kdst / 64) * (cfm.Npad / 64); } }
          return cf < NFAM; };
      f32x4 va[16], vb[16]; Fam fa, fb; int ia = 0, ib = 0; int p = F.gw;
      bool ha = seek(2 * p); if (ha) { fa = cfm; ia = 2 * p - cbase; conv_load(fa, ia, F.lane, va); }
      while (ha) {
          const bool hb = seek(2 * p + 1); if (hb) { fb = cfm; ib = 2 * p + 1 - cbase; conv_load(fb, ib, F.lane, vb); }
          conv_store(fa, scr, ia, F.lane, va);
          p += F.NGW;
          ha = seek(2 * p); if (ha) { fa = cfm; ia = 2 * p - cbase; conv_load(fa, ia, F.lane, va); }
          if (hb) conv_store(fb, scr, ib, F.lane, vb); } }
#endif
    const int gt = F.vcu * NTHR + F.tid, NT = F.G * NTHR;
    if ((wmask >> 17) & 1u) {
        for (int i = gt; i < M * 16; i += NT) { const int row = i >> 4, j = i & 15; const float inv = powf(10000.0f, -(float)j / 16.0f); const float ang = (float)((const int*)F.in[1])[row] * inv;
            WSP(float, WS_ROPE)[2 * i] = cosf(ang); WSP(float, WS_ROPE)[2 * i + 1] = sinf(ang); }
        for (int i = gt; i < D; i += NT) WSP(float, WS_SP8)[i] = 8.0f * log1pf(expf(-INF(18)[i]));
        for (int i = gt; i < 2 * D * NE; i += NT) { const int l = i / (D * NE), c = (i / NE) % D; WSP(float, WS_ROUTW)[i] = INF(3)[(1 + 2 * l) * D + c] * INF(31)[i]; }
        for (int i = gt; i < 4 * 128 * 128; i += NT) { const int t = (i >> 7) & 127, s = i & 127; WSP(bf16_t, W_GM_S)[i] = (bf16_t)(pk2(s <= t ? INF(25)[i] : 0.f, 0.f) & 0xffffu); }
    }
    if (hsrc) for (int row = F.gw; row < M; row += F.NGW) stats_row(F, hsrc, row, WSP(float, WS_RSTD));
}

__device__ __forceinline__ void phase_conv(const Frame& F) {
    const bf16_t* xbr = WSP(bf16_t, B_XBR); bf16_t* xcb = WSP(bf16_t, B_XCB); const float* cw = INF(12); const float* cb = INF(13);
    const int gt = F.vcu * NTHR + F.tid, NT = F.G * NTHR;
    for (int i = gt; i < (M / 4) * (D / 8); i += NT) { const int r0 = (i >> 7) * 4, c = (i & 127) * 8, t0 = r0 & (S - 1);
        u32x4 w[7];
#pragma unroll
        for (int q = 0; q < 7; ++q) { w[q] = (u32x4){0u, 0u, 0u, 0u}; if (t0 - 3 + q >= 0) w[q] = *(const u32x4*)(xbr + (size_t)(r0 - 3 + q) * D + c); }
        f32x4 wv[4][2]; const f32x4 b0 = *(const f32x4*)(cb + c), b1 = *(const f32x4*)(cb + c + 4);
#pragma unroll
        for (int jj = 0; jj < 4; ++jj) { wv[jj][0] = *(const f32x4*)(cw + jj * D + c); wv[jj][1] = *(const f32x4*)(cw + jj * D + c + 4); }
#pragma unroll
        for (int rr = 0; rr < 4; ++rr) { f32x4 a0 = b0, a1 = b1;
#pragma unroll
            for (int jj = 0; jj < 4; ++jj) { const u32x4 x = w[rr + jj];
                a0 += wv[jj][0] * (f32x4){bflo(x.x), bfhi(x.x), bflo(x.y), bfhi(x.y)}; a1 += wv[jj][1] * (f32x4){bflo(x.z), bfhi(x.z), bflo(x.w), bfhi(x.w)}; }
            u32x4 o; o.x = pk2(a0[0], a0[1]); o.y = pk2(a0[2], a0[3]); o.z = pk2(a1[0], a1[1]); o.w = pk2(a1[2], a1[3]);
            *(u32x4*)(xcb + (size_t)(r0 + rr) * D + c) = o; } }
}
__device__ __forceinline__ void phase_scan1(const Frame& F) {
    const unsigned* ab = WSP(unsigned, B_AF); f32x2* carry = WSP(f32x2, WS_CARRY);
    const int gt = F.vcu * NTHR + F.tid, NT = F.G * NTHR;
    for (int i = gt; i < NB * 64 * D; i += NT) { const int c = i & (D - 1), ch = (i >> 10) & 63, b = i >> 16; const size_t r0 = ((size_t)b * S + ch * 64) * D + c;
        float A = 1.f, H = 0.f;
#pragma unroll 8
        for (int t = 0; t < 64; ++t) { const unsigned w = ab[r0 + (size_t)t * D]; const float a = fast_exp2(bflo(w)), bb = bfhi(w); A *= a; H = a * H + bb; }
        carry[i] = (f32x2){A, H}; }
}
__device__ __forceinline__ void phase_scan2(const Frame& F) {
    const u32x2* ab = WSP(u32x2, B_AF); const f32x4* carry = WSP(f32x4, WS_CARRY);
    const unsigned* gate = WSP(unsigned, B_GATEB); unsigned* yb = WSP(unsigned, B_YB);
    const int gt = F.vcu * NTHR + F.tid, NT = F.G * NTHR;
    for (int i = gt; i < NB * 64 * (D / 2); i += NT) { const int c2 = i & (D / 2 - 1), ch = (i >> 9) & 63, b = i >> 15; const size_t r0 = (((size_t)b * S + ch * 64) * D) / 2 + c2;
        float H0 = 0.f, H1 = 0.f;
        for (int k0 = 0; k0 < ch; k0 += 16) { f32x4 cv[16];
#pragma unroll
            for (int q = 0; q < 16; ++q) { const int k = (k0 + q) < 63 ? (k0 + q) : 63; cv[q] = carry[((size_t)(b * 64 + k) * D) / 2 + c2]; }
#pragma unroll
            for (int q = 0; q < 16; ++q) if (k0 + q < ch) { H0 = cv[q][0] * H0 + cv[q][1]; H1 = cv[q][2] * H1 + cv[q][3]; } }
#pragma unroll 1
        for (int t0 = 0; t0 < 64; t0 += 16) { u32x2 w[16]; unsigned g[16];
#pragma unroll
            for (int q = 0; q < 16; ++q) { const size_t o = r0 + (size_t)(t0 + q) * (D / 2); w[q] = ab[o]; g[q] = gate[o]; }
#pragma unroll
            for (int q = 0; q < 16; ++q) { const size_t o = r0 + (size_t)(t0 + q) * (D / 2);
                H0 = fast_exp2(bflo(w[q].x)) * H0 + bfhi(w[q].x); H1 = fast_exp2(bflo(w[q].y)) * H1 + bfhi(w[q].y);
                yb[o] = pk2(H0 * bflo(g[q]), H1 * bfhi(g[q])); } }
    }
}
__device__ __forceinline__ void phase_router(const Frame& F, int l) {
    const float* rw = WSP(float, WS_ROUTW) + (size_t)l * D * NE; const bf16_t* hhi = WSP(bf16_t, WS_HB); const bf16_t* hlo = WSP(bf16_t, WS_LO);
    LAS int* se = (LAS int*)F.lds;
    unsigned* gcnt = WSP(unsigned, WS_CTL) + CW_MOECNT + 64 * l;
    const int tpw = (M + F.G - 1) / F.G;
    const int t0 = (int)blockIdx.x * tpw;
    for (int k = F.wave; k < tpw; k += NWAVES) { const int tok = t0 + k; if (tok >= M) break;
        float s[8];
#pragma unroll
        for (int e = 0; e < 8; ++e) s[e] = 0.f;
        float ss = 0.f;
#pragma unroll
        for (int j = 0; j < 4; ++j) { const int c0 = 256 * j + 4 * F.lane; const f32x4 x = hilo_ld(hhi, hlo, (size_t)tok * D + c0); ss += sumsq4(x);
#pragma unroll
            for (int i = 0; i < 4; ++i) { const f32x4 w0 = *(const f32x4*)(rw + (size_t)(c0 + i) * 8), w1 = *(const f32x4*)(rw + (size_t)(c0 + i) * 8 + 4);
                s[0] += x[i] * w0[0]; s[1] += x[i] * w0[1]; s[2] += x[i] * w0[2]; s[3] += x[i] * w0[3]; s[4] += x[i] * w1[0]; s[5] += x[i] * w1[1]; s[6] += x[i] * w1[2]; s[7] += x[i] * w1[3]; } }
        ss = wave_sum(ss);
#pragma unroll
        for (int e = 0; e < 8; ++e) s[e] = wave_sum(s[e]);
        const float rs = 1.0f / sqrtf(ss * (1.0f / 1024.0f) + RMS_EPS);
        int e1 = 0; float v1 = s[0];
#pragma unroll
        for (int e = 1; e < 8; ++e) if (s[e] > v1) { v1 = s[e]; e1 = e; }
        int e2 = 0; float v2 = -INFINITY;
#pragma unroll
        for (int e = 0; e < 8; ++e) if (e != e1 && s[e] > v2) { v2 = s[e]; e2 = e; }
        const float g1 = 1.0f / (1.0f + expf((v2 - v1) * rs));
        if (F.lane == 0) { se[2 * k] = e1; se[2 * k + 1] = e2; WSP(f32x2, WS_TOKG)[tok] = (f32x2){g1, 1.0f - g1}; WSP(float, WS_RSTD)[tok] = rs; }
    }
    __syncthreads();
    if (F.wave == 0) { const int tok = t0 + F.lane; const bool valid = F.lane < tpw && tok < M;
        const int e1 = valid ? se[2 * F.lane] : -1, e2 = valid ? se[2 * F.lane + 1] : -1; int lr1 = 0, lr2 = 0;
        const unsigned long long lt = (1ull << F.lane) - 1ull;
#pragma unroll
        for (int e = 0; e < 8; ++e) { const unsigned long long m1 = __ballot(e1 == e), m2 = __ballot(e2 == e);
            const int before = __popcll(m1 & lt) + __popcll(m2 & lt); if (e1 == e) lr1 = before; if (e2 == e) lr2 = before;
            const int tot = __popcll(m1) + __popcll(m2);
            if (F.lane == e) { if (tot) (void)__hip_atomic_fetch_add(gcnt + e, (unsigned)tot, __ATOMIC_RELAXED, __HIP_MEMORY_SCOPE_AGENT); WSP(int, WS_WGBASE)[blockIdx.x * 8 + e] = tot; } }
        if (valid) { int* ti = WSP(int, WS_TOKINFO) + 4 * (size_t)tok; ti[0] = e1; ti[1] = lr1; ti[2] = e2; ti[3] = lr2; }
    }
    __syncthreads();
}
__device__ __forceinline__ int moe_layout(const Frame& F, int l, int* pstart_rows, int* pend) {
    const unsigned* gcnt = WSP(unsigned, WS_CTL) + CW_MOECNT + 64 * l; int p = 0;
#pragma unroll
    for (int e = 0; e < NE; ++e) { const int c = (int)__hip_atomic_load(gcnt + e, __ATOMIC_RELAXED, __HIP_MEMORY_SCOPE_AGENT); pstart_rows[e] = p * 256; p += (c + 255) >> 8; pend[e] = p; }
    return p;
}
__device__ __forceinline__ void phase_gather(const Frame& F, int l) {
    int ps[NE], pe[NE]; (void)moe_layout(F, l, ps, pe);
    const int tpw = (M + F.G - 1) / F.G;
    LAS int* lbase = (LAS int*)F.lds;
    { const int e = F.wave; int v[4]; int run = 0;
#pragma unroll
      for (int q = 0; q < 4; ++q) { const int w = 4 * F.lane + q; v[q] = w < F.G ? WSP(int, WS_WGBASE)[w * 8 + e] : 0; }
      const int tot4 = (v[0] + v[1]) + (v[2] + v[3]); int incl = tot4;
#pragma unroll
      for (int o = 1; o < 64; o <<= 1) { const int t = __shfl_up(incl, o); if (F.lane >= o) incl += t; }
      run = incl - tot4;
#pragma unroll
      for (int q = 0; q < 4; ++q) { const int w = 4 * F.lane + q; if (w < F.G) lbase[w * 8 + e] = run; run += v[q]; } }
    __syncthreads();
    int* rowtok = WSP(int, WS_ROWTOK);
    for (int tok = F.gw; tok < M; tok += F.NGW) { const int wg = tok / tpw;
        const int* ti = WSP(int, WS_TOKINFO) + 4 * (size_t)tok; const int e1 = ti[0], lr1 = ti[1], e2 = ti[2], lr2 = ti[3];
        int d1 = 0, d2 = 0;
#pragma unroll
        for (int e = 0; e < NE; ++e) { const int b = lbase[wg * 8 + e]; if (e == e1) d1 = ps[e] + b + lr1; if (e == e2) d2 = ps[e] + b + lr2; }
#if !MUP_GATHER
        { const u32x4* src = (const u32x4*)(WSP(bf16_t, WS_HB) + (size_t)tok * D) + F.lane; const u32x4 a = src[0], b = src[64]; bf16_t* xg = WSP(bf16_t, B_XG);
          if (moe_f8(l)) {
              const float q = WSP(float, WS_RSTD)[tok] * F8_SX; u32x2 pa, pb;
              pa.x = pk_fp8x4(bflo(a.x) * q, bfhi(a.x) * q, bflo(a.y) * q, bfhi(a.y) * q); pa.y = pk_fp8x4(bflo(a.z) * q, bfhi(a.z) * q, bflo(a.w) * q, bfhi(a.w) * q);
              pb.x = pk_fp8x4(bflo(b.x) * q, bfhi(b.x) * q, bflo(b.y) * q, bfhi(b.y) * q); pb.y = pk_fp8x4(bflo(b.z) * q, bfhi(b.z) * q, bflo(b.w) * q, bfhi(b.w) * q);
              u32x2* o1 = (u32x2*)((char*)xg + (size_t)d1 * D) + F.lane; u32x2* o2 = (u32x2*)((char*)xg + (size_t)d2 * D) + F.lane; o1[0] = pa; o1[64] = pb; o2[0] = pa; o2[64] = pb;
          } else {
          u32x4* o1 = (u32x4*)(xg + (size_t)d1 * D) + F.lane; u32x4* o2 = (u32x4*)(xg + (size_t)d2 * D) + F.lane; o1[0] = a; o1[64] = b; o2[0] = a; o2[64] = b; } }
#endif
        if (F.lane == 0) { const f32x2 g = WSP(f32x2, WS_TOKG)[tok]; const float rs = WSP(float, WS_RSTD)[tok];
            rowtok[d1] = tok; rowtok[d2] = tok;
            const float rsc = moe_f8(l) ? 1.f / (F8_SX * F8_SW) : rs, gsc = moe_f8(l) ? 1.f / (F8_SA * F8_SW) : 1.f;
            WSP(float, WS_ROWSCALE)[d1] = rsc; WSP(float, WS_ROWSCALE)[d2] = rsc; WSP(float, WS_ROWGATE)[d1] = g.x * gsc; WSP(float, WS_ROWGATE)[d2] = g.y * gsc;
            WSP(int, WS_DEST)[2 * tok] = d1; WSP(int, WS_DEST)[2 * tok + 1] = d2; }
    }
    if (blockIdx.x < NE) {
        const int e = (int)blockIdx.x; const int cnt = (int)__hip_atomic_load(WSP(unsigned, WS_CTL) + CW_MOECNT + 64 * l + e, __ATOMIC_RELAXED, __HIP_MEMORY_SCOPE_AGENT);
        int pse = 0, pee = 0;
#pragma unroll
        for (int k = 0; k < NE; ++k) if (k == e) { pse = ps[k]; pee = pe[k] * 256; }
        for (int r = pse + cnt + F.tid; r < pee; r += NTHR) { rowtok[r] = 0; WSP(float, WS_ROWSCALE)[r] = 0.f; WSP(float, WS_ROWGATE)[r] = 0.f; } }
}
__device__ __forceinline__ unsigned sk_split_mask(const Frame& F, int l) {
#if MDN_STREAMK
    if (F.G != 256) return 0u;
    int ps[NE], pe[NE]; const int NP = moe_layout(F, l, ps, pe); const int P = moe_f8(l) ? FF / 256 : FF / 128, T = ((NP + 7) >> 3) * P; unsigned m = 0u;
#pragma unroll
    for (int x = 1; x < 8; ++x) { const int s = (x * T) >> 3; if (s % P) m |= 1u << (s / P); }
    return m;
#else
    return 0u;
#endif
}
template <bool FINAL> __device__ __forceinline__ void phase_combine(const Frame& F, const float oscale, const int l) {
    const bf16_t* om = WSP(bf16_t, B_OUTM); const bf16_t* om2 = (const bf16_t*)(F.ws + WS_SK); const float* gfin = INF(4);
#ifdef SK_E1
    const unsigned smask = 0u; (void)l;
#else
    const unsigned smask = sk_split_mask(F, l);
#endif
    for (int tok = F.gw; tok < M; tok += F.NGW) {
        const int* ti = WSP(int, WS_TOKINFO) + 4 * (size_t)tok; const int e1 = ti[0], e2 = ti[2]; int d1 = WSP(int, WS_DEST)[2 * tok], d2 = WSP(int, WS_DEST)[2 * tok + 1];
        if (e2 < e1) { const int t = d1; d1 = d2; d2 = t; }
        f32x4 v[4]; float s = 0.f;
#pragma unroll
        for (int j = 0; j < 4; ++j) { const int c = 256 * j + 4 * F.lane; const f32x4 x = hilo_ld(WSP(bf16_t, WS_HB), WSP(bf16_t, WS_LO), (size_t)tok * D + c);
            const u32x2 a = *(const u32x2*)(om + (size_t)d1 * D + c), b = *(const u32x2*)(om + (size_t)d2 * D + c);
            f32x4 ya = (f32x4){bflo(a.x), bfhi(a.x), bflo(a.y), bfhi(a.y)}, yb = (f32x4){bflo(b.x), bfhi(b.x), bflo(b.y), bfhi(b.y)};
            if ((smask >> (d1 >> 11)) & 1u) { const u32x2 a2 = *(const u32x2*)(om2 + (size_t)d1 * D + c); ya += (f32x4){bflo(a2.x), bfhi(a2.x), bflo(a2.y), bfhi(a2.y)}; }
            if ((smask >> (d2 >> 11)) & 1u) { const u32x2 b2 = *(const u32x2*)(om2 + (size_t)d2 * D + c); yb += (f32x4){bflo(b2.x), bfhi(b2.x), bflo(b2.y), bfhi(b2.y)}; }
            v[j] = x + (ya + yb); s += sumsq4(v[j]); }
        s = wave_sum(s); const float rs = 1.0f / sqrtf(s * (1.0f / 1024.0f) + RMS_EPS);
        if (FINAL) {
#pragma unroll
            for (int j = 0; j < 4; ++j) { const int c = 256 * j + 4 * F.lane; *(f32x4*)(F.h + (size_t)tok * D + c) = v[j] * (rs * oscale) * *(const f32x4*)(gfin + c); }
        } else {
#pragma unroll
            for (int j = 0; j < 4; ++j) { const int c = 256 * j + 4 * F.lane; hilo_st(WSP(bf16_t, WS_HB), WSP(bf16_t, WS_LO), (size_t)tok * D + c, v[j]); }
            if (F.lane < 16) WSP(float, WS_SSQ)[(size_t)tok * 16 + F.lane] = F.lane == 0 ? s : 0.f;
            if (F.lane == 0) WSP(float, WS_RSTD)[tok] = rs;
        }
    }
}
__device__ __forceinline__ void phase_pool(const Frame& F) {
    const float* rstd = WSP(float, WS_RSTD); const float* g = INF(2) + 2 * D; bf16_t* po = WSP(bf16_t, B_POOLED);
    const int gt = F.vcu * NTHR + F.tid, NT = F.G * NTHR;
    for (int i = gt; i < (M / 32) * (D / 4); i += NT) { const int c = (i & 255) * 4, rb = (i >> 8) * 32, t0 = rb & (S - 1); const int w = 2 << (c >> 8);
        const f32x4 gv = *(const f32x4*)(g + c); f32x4 sum = {0.f, 0.f, 0.f, 0.f};
        const int warm = t0 < w - 1 ? t0 : w - 1;
        const bf16_t* hhi = WSP(bf16_t, WS_HB); const bf16_t* hlo = WSP(bf16_t, WS_LO);
        for (int k = warm; k >= 1; --k) sum += hilo_ld(hhi, hlo, (size_t)(rb - k) * D + c) * rstd[rb - k];
#pragma unroll 1
        for (int r0 = 0; r0 < 32; r0 += 8) { f32x4 sv[8], ov[8];
#pragma unroll
            for (int q = 0; q < 8; ++q) { const int row = rb + r0 + q; const bool has = t0 + r0 + q + 1 >= w; const int ro = has ? row - w + 1 : row;
                sv[q] = hilo_ld(hhi, hlo, (size_t)row * D + c) * rstd[row]; ov[q] = hilo_ld(hhi, hlo, (size_t)ro * D + c) * (has ? rstd[ro] : 0.f); }
#pragma unroll
            for (int q = 0; q < 8; ++q) { const int row = rb + r0 + q, t = t0 + r0 + q; sum += sv[q];
                const int n = t + 1 < w ? t + 1 : w;
                const f32x4 o = (sum * (1.0f / (float)n) - sv[q]) * gv; st_bf16x4(po + (size_t)row * D + c, o);
                sum -= ov[q]; } }
    }
}
typedef short v4i16_t __attribute__((ext_vector_type(4)));
__device__ __forceinline__ int crow(int r, int hi) { return (r & 3) + 8 * (r >> 2) + 4 * hi; }
__device__ __forceinline__ s16x4 vtr(const LAS unsigned char* p) { return __builtin_bit_cast(s16x4, __builtin_amdgcn_ds_read_tr16_b64_v4i16((LAS v4i16_t*)p)); }
__device__ __forceinline__ bf16x8 pack8(const f32x16& p, int b) { u32x4 w; w.x = pk2(p[b], p[b + 1]); w.y = pk2(p[b + 2], p[b + 3]); w.z = pk2(p[b + 4], p[b + 5]); w.w = pk2(p[b + 6], p[b + 7]); return __builtin_bit_cast(bf16x8, w); }
__device__ __forceinline__ void glds16s(const char* base  , unsigned voff, unsigned lds_dst  ) { unsigned keep;
    asm volatile("s_mov_b32 %0, m0\n\ts_mov_b32 m0, %3\n\ts_nop 0\n\tglobal_load_lds_dwordx4 %1, %2\n\ts_mov_b32 m0, %0" : "=&s"(keep) : "v"(voff), "s"(base), "s"(lds_dst) : "memory"); }
#ifndef ATT_THR
#define ATT_THR 8.0f
#endif
constexpr int AT_KROW = 208, AT_KBYTES = 13 * 1024  , AT_VBYTES = 8192, AT_KOFF = 0, AT_VOFF = 3 * AT_KBYTES, AT_WSF = 3 * AT_KBYTES + 3 * AT_VBYTES;
__device__ __forceinline__ void attn_unit(const Frame& F, int bh, int qb, const int att_var) {
    const int b = bh >> 4, h = bh & 15, lane = F.lane, r = lane & 31, hh = lane >> 5, wid = F.wave, tid = F.tid;
    const bf16_t* Q = WSP(bf16_t, B_Q); const bf16_t* KB = WSP(bf16_t, B_KB); const bf16_t* VB = WSP(bf16_t, B_VB); bf16_t* OB = WSP(bf16_t, B_OB);
    const size_t rowbase = (size_t)b * S; const int q0 = qb * 256; const int qrow = q0 + 32 * wid + r;
    bf16x8 qf[6];
    { const bf16_t* qp = Q + (rowbase + qrow) * 1536 + h * 96 + 8 * hh;
#pragma unroll
      for (int ks = 0; ks < 6; ++ks) qf[ks] = *(const bf16x8*)(qp + 16 * ks); }
    const int NT = 4 * (qb + 1);
    const int kc0 = wid * 64 + lane, kc1 = 512 + wid * 64 + lane;
    const int kr0 = kc0 / 13, kq0 = kc0 - kr0 * 13, kr1 = kc1 / 13, kq1 = kc1 - kr1 * 13; const bool has1 = wid < 5;
    const unsigned koff0 = (unsigned)(kr0 * 3072 + (kq0 < 12 ? kq0 : 11) * 16), koff1 = (unsigned)((kr1 < 64 ? kr1 : 63) * 3072 + (kq1 < 12 ? kq1 : 11) * 16);
    const int vc = wid * 64 + lane, vdh = vc >> 8, vrow = (vc >> 2) & 63, vq = vc & 3;
    const unsigned voff = (unsigned)(vrow * 2048 + vdh * 64 + vq * 16);
    const char* Kt0 = (const char*)(KB + rowbase * 1536 + h * 96); const char* Vt0 = (const char*)(VB + rowbase * 1024 + h * 64);
    LAS unsigned char* lds = F.lds; LAS float* wsf = (LAS float*)(lds + AT_WSF) + wid * 64; const unsigned lds0 = (unsigned)(size_t)lds;
#define AT_DMA_K(t, slot) do { const char* kt_ = uni_ptr(Kt0 + (size_t)(t) * (64 * 3072)); const unsigned kl_ = (unsigned)__builtin_amdgcn_readfirstlane((int)(lds0 + (slot) * AT_KBYTES + wid * 1024)); glds16s(kt_, koff0, kl_); \
        if (has1) glds16s(kt_, koff1, kl_ + 8192u); } while (0)
#define AT_DMA_V(t, slot) do { const char* vt_ = uni_ptr(Vt0 + (size_t)(t) * (64 * 2048)); glds16s(vt_, voff, (unsigned)__builtin_amdgcn_readfirstlane((int)(lds0 + AT_VOFF + (slot) * AT_VBYTES + wid * 1024))); } while (0)
    AT_DMA_K(0, 0); AT_DMA_V(0, 0); AT_DMA_K(1, 1); AT_DMA_V(1, 1); AT_DMA_K(2, 2);
    asm volatile("s_waitcnt vmcnt(0)" ::: "memory"); __builtin_amdgcn_s_barrier(); asm volatile("" ::: "memory");
    f32x16 o0, o1, osum;
#pragma unroll
    for (int i = 0; i < 16; ++i) { o0[i] = 0.f; o1[i] = 0.f; osum[i] = 0.f; }
    float mrun = 0.f, pend = 0.f;
    f32x16 negm;
#pragma unroll
    for (int i = 0; i < 16; ++i) negm[i] = 0.f;
    const bf16x8 ones = {0x3F80, 0x3F80, 0x3F80, 0x3F80, 0x3F80, 0x3F80, 0x3F80, 0x3F80};
    const int kfrag = AT_KOFF + r * AT_KROW + hh * 16;
    const int vfrag = AT_VOFF + ((lane >> 4) & 1) * 32 + (lane & 3) * 8 + (4 * hh + ((lane & 15) >> 2)) * 64;
    const int wmax = q0 + 32 * wid + 31;
#define AT_QK(P0, P1, slot) do { const LAS unsigned char* kb_ = lds + (slot) * AT_KBYTES + kfrag; \
        { const bf16x8 a0 = *(const LAS bf16x8*)(kb_), a1 = *(const LAS bf16x8*)(kb_ + 32 * AT_KROW); \
          P0 = __builtin_amdgcn_mfma_f32_32x32x16_bf16(a0, qf[0], negm, 0, 0, 0); P1 = __builtin_amdgcn_mfma_f32_32x32x16_bf16(a1, qf[0], negm, 0, 0, 0); } \
        _Pragma("unroll") for (int ks = 1; ks < 6; ++ks) { const bf16x8 a0 = *(const LAS bf16x8*)(kb_ + ks * 32), a1 = *(const LAS bf16x8*)(kb_ + 32 * AT_KROW + ks * 32); \
            P0 = __builtin_amdgcn_mfma_f32_32x32x16_bf16(a0, qf[ks], P0, 0, 0, 0); P1 = __builtin_amdgcn_mfma_f32_32x32x16_bf16(a1, qf[ks], P1, 0, 0, 0); } } while (0)
#define AT_PV1(o, d0, ks, pa) do { const s16x4 lo = vtr(vb + d0 * 4096 + ks * 1024), hi = vtr(vb + d0 * 4096 + ks * 1024 + 512); \
        o = __builtin_amdgcn_mfma_f32_32x32x16_bf16(pa, (bf16x8){lo[0], lo[1], lo[2], lo[3], hi[0], hi[1], hi[2], hi[3]}, o, 0, 0, 0); } while (0)
#define AT_SOFT(P0, P1, t) do { \
        if (__any(pend != 0.f)) { _Pragma("unroll") for (int i = 0; i < 16; ++i) { P0[i] -= pend; P1[i] -= pend; } } pend = 0.f; \
        if ((t) >= NT - 4) { const int kb0 = (t) * 64; _Pragma("unroll") for (int i = 0; i < 16; ++i) { const int kv = kb0 + crow(i, hh); if (kv > qrow) P0[i] = -INFINITY; if (kv + 32 > qrow) P1[i] = -INFINITY; } } \
        float mx = fmaxf(fmaxf(P0[0], P1[0]), fmaxf(P0[1], P1[1])); _Pragma("unroll") for (int i = 2; i < 16; i += 2) mx = fmaxf(mx, fmaxf(fmaxf(P0[i], P1[i]), fmaxf(P0[i + 1], P1[i + 1]))); \
        mx = fmaxf(mx, __shfl_xor(mx, 32)); \
        if ((t) == 0 || __any(mx > ATT_THR)) { const float dl = (t) == 0 ? mx : fmaxf(mx, 0.f); mrun += dl; pend = dl; const float alpha = fast_exp2(-dl); { const float nm_ = -mrun; _Pragma("unroll") for (int i = 0; i < 16; ++i) negm[i] = nm_; } \
            _Pragma("unroll") for (int i = 0; i < 16; ++i) { P0[i] -= dl; P1[i] -= dl; } \
            if ((t) != 0) { if (hh == 0) wsf[r] = alpha; \
                _Pragma("unroll") for (int i = 0; i < 16; ++i) { const float al = wsf[crow(i, hh)]; o0[i] *= al; o1[i] *= al; osum[i] *= al; } } } \
        _Pragma("unroll") for (int i = 0; i < 16; ++i) { P0[i] = fast_exp2(P0[i]); P1[i] = fast_exp2(P1[i]); } \
        pk0 = pack8(P0, 0); pk1 = pack8(P0, 8); pk2_ = pack8(P1, 0); pk3 = pack8(P1, 8); } while (0)
#define AT_PV(sv) do { const LAS unsigned char* vb = lds + (sv) * AT_VBYTES + vfrag; \
        AT_PV1(o0, 0, 0, pk0); AT_PV1(o1, 1, 0, pk0); osum = __builtin_amdgcn_mfma_f32_32x32x16_bf16(pk0, ones, osum, 0, 0, 0); \
        AT_PV1(o0, 0, 1, pk1); AT_PV1(o1, 1, 1, pk1); osum = __builtin_amdgcn_mfma_f32_32x32x16_bf16(pk1, ones, osum, 0, 0, 0); \
        AT_PV1(o0, 0, 2, pk2_); AT_PV1(o1, 1, 2, pk2_); osum = __builtin_amdgcn_mfma_f32_32x32x16_bf16(pk2_, ones, osum, 0, 0, 0); \
        AT_PV1(o0, 0, 3, pk3); AT_PV1(o1, 1, 3, pk3); osum = __builtin_amdgcn_mfma_f32_32x32x16_bf16(pk3, ones, osum, 0, 0, 0); } while (0)
#define AT_H0(SQ0, SQ1, t) do { \
        const bool dK = (t) + 4 >= 3 && (t) + 4 < NT, dV = (t) + 2 >= 2 && (t) + 2 < NT; \
        if (dK) AT_DMA_K((t) + 4, s_b); \
        if (dV) AT_DMA_V((t) + 2, s_c); \
        if ((t) >= 0 && (t) * 64 <= wmax) AT_PV(s_a); \
        if ((t) + 2 < NT && ((t) + 2) * 64 <= wmax) AT_QK(SQ0, SQ1, s_c); \
        if (dK && dV) { if (has1) asm volatile("s_waitcnt vmcnt(3) lgkmcnt(0)" ::: "memory"); else asm volatile("s_waitcnt vmcnt(2) lgkmcnt(0)" ::: "memory"); } \
        else asm volatile("s_waitcnt vmcnt(0) lgkmcnt(0)" ::: "memory"); \
        __builtin_amdgcn_s_barrier(); asm volatile("" ::: "memory"); } while (0)
#define AT_H1(SS0, SS1, t) do { \
        if ((t) + 1 >= 0 && (t) + 1 < NT && ((t) + 1) * 64 <= wmax) AT_SOFT(SS0, SS1, (t) + 1); \
        asm volatile("s_waitcnt lgkmcnt(0)" ::: "memory"); __builtin_amdgcn_s_barrier(); asm volatile("" ::: "memory"); \
        { const int tmp_ = s_a; s_a = s_b; s_b = s_c; s_c = tmp_; } } while (0)
    f32x16 pA0, pA1, pB0, pB1; bf16x8 pk0, pk1, pk2_, pk3;
    pk0 = ones; pk1 = ones; pk2_ = ones; pk3 = ones;
    int s_a = 1, s_b = 2, s_c = 0;
    if (wid >= 4) { __builtin_amdgcn_s_barrier(); asm volatile("" ::: "memory"); }
    for (int t = -2; t < NT; t += 2) { AT_H0(pA0, pA1, t); AT_H1(pB0, pB1, t); AT_H0(pB0, pB1, t + 1); AT_H1(pA0, pA1, t + 1); }
    if (wid < 4) { __builtin_amdgcn_s_barrier(); asm volatile("" ::: "memory"); }
#undef AT_H0
#undef AT_H1
#undef AT_SOFT
#undef AT_PV
#undef AT_DMA_K
#undef AT_DMA_V
#undef AT_QK
#undef AT_PV1
    bf16_t* op = OB + (rowbase + q0 + 32 * wid) * 1024 + h * 64 + r;
#pragma unroll
    for (int i = 0; i < 16; ++i) { const int qr = crow(i, hh); const float rl = fast_rcp(osum[i]);
        op[(size_t)qr * 1024] = (bf16_t)(pk2(o0[i] * rl, 0.f) & 0xffffu); op[(size_t)qr * 1024 + 32] = (bf16_t)(pk2(o1[i] * rl, 0.f) & 0xffffu); }
    __syncthreads();
}
__device__ __forceinline__ void phase_attn(const Frame& F, const int att_var) {
    for (int pi = F.vcu; pi < 512; pi += F.G) { const int bh = pi >> 3, j = pi & 7; attn_unit(F, bh, j, att_var); attn_unit(F, bh, 15 - j, att_var); }
}

__device__ __forceinline__ void gmlp_unit(const Frame& F, int chunk, int g) {
    const int lane = F.lane, wid = F.wave, tid = F.tid, r = lane & 31, hh = lane >> 5;
    const bf16_t* vsrc = WSP(bf16_t, B_VB2); const bf16_t* usrc = WSP(bf16_t, B_UB); bf16_t* uv = WSP(bf16_t, B_UVB); const bf16_t* wsb = WSP(bf16_t, W_GM_S) + (size_t)g * 16384;
    const float* lng = INF(23); const float* lnb = INF(24); const float* bs = INF(26) + g * 128;
    LAS unsigned char* lds = F.lds; LAS f32x2* stat = (LAS f32x2*)(lds + 65536);
    const size_t row0 = (size_t)chunk * 128;
    for (int k = 0; k < 16; ++k) { const int rr = wid * 16 + k; const u32x4* p = (const u32x4*)(vsrc + (row0 + rr) * D) + lane; const u32x4 a = p[0], b2 = p[64];
        float x[16]; x[0] = bflo(a.x); x[1] = bfhi(a.x); x[2] = bflo(a.y); x[3] = bfhi(a.y); x[4] = bflo(a.z); x[5] = bfhi(a.z); x[6] = bflo(a.w); x[7] = bfhi(a.w);
        x[8] = bflo(b2.x); x[9] = bfhi(b2.x); x[10] = bflo(b2.y); x[11] = bfhi(b2.y); x[12] = bflo(b2.z); x[13] = bfhi(b2.z); x[14] = bflo(b2.w); x[15] = bfhi(b2.w);
        float s = 0.f;
#pragma unroll
        for (int i = 0; i < 16; ++i) s += x[i];
        const float mu = wave_sum(s) * (1.0f / 1024.0f); float q = 0.f;
#pragma unroll
        for (int i = 0; i < 16; ++i) { const float d = x[i] - mu; q += d * d; }
        const float var = wave_sum(q) * (1.0f / 1024.0f);
        if (lane == 0) stat[rr] = (f32x2){mu, 1.0f / sqrtf(var + LN_EPS)}; }
    __syncthreads();
#pragma unroll
    for (int k = 0; k < 8; ++k) { const int idx = tid + k * NTHR, s = idx >> 5, ch = idx & 31, c = g * 256 + ch * 8;
        const u32x4 w = *(const u32x4*)(vsrc + (row0 + s) * D + c); const f32x2 st = stat[s];
        const f32x4 g0 = *(const f32x4*)(lng + c), g1 = *(const f32x4*)(lng + c + 4), b0 = *(const f32x4*)(lnb + c), b1 = *(const f32x4*)(lnb + c + 4);
        f32x4 v0 = {bflo(w.x), bfhi(w.x), bflo(w.y), bfhi(w.y)}, v1 = {bflo(w.z), bfhi(w.z), bflo(w.w), bfhi(w.w)};
        v0 = (v0 - st.x) * st.y * g0 + b0; v1 = (v1 - st.x) * st.y * g1 + b1;
        u32x4 o; o.x = pk2(v0[0], v0[1]); o.y = pk2(v0[2], v0[3]); o.z = pk2(v1[0], v1[1]); o.w = pk2(v1[2], v1[3]);
        *(LAS u32x4*)(lds + (ch >> 2) * 8192 + s * 64 + (ch & 3) * 16) = o; }
    __syncthreads();
    bf16x8 bfr[8];
    { const LAS unsigned char* vb = lds + wid * 8192 + ((lane >> 4) & 1) * 32 + (lane & 3) * 8 + (8 * hh + ((lane & 15) >> 2)) * 64;
#pragma unroll
      for (int ks = 0; ks < 8; ++ks) { const s16x4 lo = vtr(vb + ks * 1024), hi = vtr(vb + ks * 1024 + 256); bfr[ks] = (bf16x8){lo[0], lo[1], lo[2], lo[3], hi[0], hi[1], hi[2], hi[3]}; } }
    __syncthreads();
    LAS bf16_t* ost = (LAS bf16_t*)(lds + wid * 8192);
#pragma unroll
    for (int mt = 0; mt < 4; ++mt) { f32x16 acc;
#pragma unroll
        for (int i = 0; i < 16; ++i) acc[i] = 0.f;
        const bf16_t* wp = wsb + (size_t)(32 * mt + r) * 128 + 8 * hh;
#pragma unroll
        for (int ks = 0; ks < 8; ++ks) if (ks <= 2 * mt + 1) { const bf16x8 a = *(const bf16x8*)(wp + 16 * ks); acc = __builtin_amdgcn_mfma_f32_32x32x16_bf16(a, bfr[ks], acc, 0, 0, 0); }
#pragma unroll
        for (int i = 0; i < 16; ++i) { const int t = 32 * mt + crow(i, hh); ost[t * 32 + r] = (bf16_t)(pk2(acc[i] + bs[t], 0.f) & 0xffffu); } }
    asm volatile("s_waitcnt lgkmcnt(0)" ::: "memory");
#pragma unroll
    for (int k = 0; k < 8; ++k) { const int t = 16 * k + (lane >> 2), ch = lane & 3; const size_t off = (row0 + t) * D + g * 256 + wid * 32 + ch * 8;
        const u32x4 v2 = *(const LAS u32x4*)(ost + t * 32 + ch * 8); const u32x4 uu = *(const u32x4*)(usrc + off); u32x4 o;
        o.x = pk2(bflo(uu.x) * bflo(v2.x), bfhi(uu.x) * bfhi(v2.x)); o.y = pk2(bflo(uu.y) * bflo(v2.y), bfhi(uu.y) * bfhi(v2.y));
        o.z = pk2(bflo(uu.z) * bflo(v2.z), bfhi(uu.z) * bfhi(v2.z)); o.w = pk2(bflo(uu.w) * bflo(v2.w), bfhi(uu.w) * bfhi(v2.w));
        *(u32x4*)(uv + off) = o; }
    __syncthreads();
}
__device__ __forceinline__ void phase_gmlp(const Frame& F) { for (int u = F.vcu; u < 512; u += F.G) gmlp_unit(F, u >> 2, u & 3); }
constexpr int PH_PRO = 0, PH_LAT = 1, PH_QKV = 2, PH_ATTN = 3, PH_WO = 4, PH_FUP0 = 5, PH_FDN0 = 6, PH_LIN = 7, PH_CONV = 8, PH_LGATE = 9, PH_SCAN1 = 10, PH_SCAN2 = 11, PH_LOUT = 12,
              PH_ROUT0 = 13, PH_GATH0 = 14, PH_MUP0 = 15, PH_MDN0 = 16, PH_COMB0 = 17, PH_POOL = 18, PH_PGEMM = 19, PH_FUP1 = 20, PH_FDN1 = 21, PH_GIN = 22, PH_GGATE = 23, PH_GOUT = 24,
              PH_ROUT1 = 25, PH_GATH1 = 26, PH_MUP1 = 27, PH_MDN1 = 28, PH_FINAL = 29, PH_N = 30;

__device__ __forceinline__ DenseSched dense_sched(const Frame& F, const void* A, int lda, const void* B, int ldb, int nM, int nN) {
    DenseSched s; s.nM = nM; s.nN = nN; s.G = F.G; s.c = (int)blockIdx.x; s.A = (const char*)A; s.B = (const char*)B; s.astep = (size_t)256 * lda * 2; s.bstep = btile_bytes(ldb); return s;
}
template <int L> __device__ __forceinline__ void phase_ffn_up(const Frame& F, bf16_t* actout, int var) {
    if constexpr (ffn_f8(L)) {
        const DenseSched s = dense_sched(F, F.ws + WS_X8, D / 2, F.ws + W_FFN + (size_t)L * WSTRIDE, D / 2, M / 256, 2 * FF / 256);
        EpiSwiglu<false, true> e{actout, WSP(float, WS_SSQ), var, 1.f / F8_SW};
        gemm_phase<EpiSwiglu<false, true>, DenseSched, false, true, false, true>(F.lds, D / 2, D / 2, D / 2, s, e);
        return;
    }
    const DenseSched s = dense_sched(F, WSP(bf16_t, WS_HB), D, F.ws + W_FFN + (size_t)L * WSTRIDE, D, M / 256, 2 * FF / 256);
    EpiSwiglu<false> e{actout, WSP(float, WS_SSQ), var, 1.f};
#if defined(REP_PHASE) && REP_VAR == 3
    if (var == 3) { gemm_phase<EpiSwiglu<false>, DenseSched, false, false>(F.lds, D, D, D, s, e); return; }
#endif
    gemm_phase(F.lds, D, D, D, s, e);
}
template <int L> __device__ __forceinline__ void phase_ffn_down(const Frame& F) {
    constexpr bool F8 = ffn_f8(L); constexpr int KD = F8 ? FF / 2 : FF;
    const DenseSched s = dense_sched(F, WSP(bf16_t, B_ACT), KD, F.ws + W_FFN + (size_t)L * WSTRIDE + WDOWN_OFF, KD, M / 256, D / 256);
    EpiRes e{nullptr, WSP(bf16_t, WS_HB), WSP(bf16_t, WS_LO), WSP(float, WS_SSQ), nullptr, nullptr, F8 ? 1.f / (F8_SA * F8_SW) : 1.f};
    gemm_phase<EpiRes, DenseSched, false, true, false, F8>(F.lds, 128, KD, KD, s, e, SKCtx{nullptr, nullptr, nullptr}, 65536);
}
__device__ __forceinline__ MoeSched moe_sched(const Frame& F, int l, const void* A, int lda, size_t wofs, int ldb, int nN) {
    MoeSched s; int ps[NE]; s.nM = moe_layout(F, l, ps, s.pend); s.nN = nN; s.G = F.G; s.c = (int)blockIdx.x; s.A = (const char*)A; s.B = (const char*)(F.ws + W_MOE + (size_t)l * 8 * WSTRIDE + wofs);
    s.astep = (size_t)256 * lda * 2; s.bstep = btile_bytes(ldb); s.estep = WSTRIDE; return s;
}
template <int L> __device__ __forceinline__ void phase_moe_up(const Frame& F, const int var) {
    if constexpr (moe_f8(L)) {
        EpiSwiglu<true, true> e{WSP(bf16_t, B_ACTM), WSP(float, WS_ROWSCALE), var, 1.f};
        const MoeSched s = moe_sched(F, L, WSP(bf16_t, B_XG), D / 2, 0, D / 2, 2 * FF / 256);
        gemm_phase<EpiSwiglu<true, true>, MoeSched, false, true, false, true>(F.lds, D / 2, D / 2, D / 2, s, e);
        return;
    }
    EpiSwiglu<true> e{WSP(bf16_t, B_ACTM), WSP(float, WS_ROWSCALE), var, 1.f};
#if MUP_GATHER
    MoeSched s = moe_sched(F, L, WSP(bf16_t, WS_HB), D, 0, D, 2 * FF / 256); s.astep = 0;
    gemm_phase<EpiSwiglu<true>, MoeSched, false, true, true>(F.lds, D, D, D, s, e, SKCtx{nullptr, nullptr, nullptr}, 256, WSP(int, WS_ROWTOK));
#else
    const MoeSched s = moe_sched(F, L, WSP(bf16_t, B_XG), D, 0, D, 2 * FF / 256);
    gemm_phase(F.lds, D, D, D, s, e);
#endif
}
template <int L> __device__ __forceinline__ void phase_moe_down(const Frame& F) {
    EpiMoeDown e{WSP(bf16_t, B_OUTM), WSP(float, WS_ROWGATE), (bf16_t*)(F.ws + WS_SK)};
#if MDN_STREAMK
    if (F.G == 256) {
        constexpr bool F8 = moe_f8(L); constexpr int KD = F8 ? FF / 2 : FF;
        SKSched s; int ps[NE]; s.NP = moe_layout(F, L, ps, s.pend); s.P = KD / 128; const int T = ((s.NP + 7) >> 3) * s.P;
        s.x = F.vcu >> 5; s.r = (F.vcu >> 2) & 7; s.j = F.vcu & 3; s.s0 = (s.x * T) >> 3; s.s1 = ((s.x + 1) * T) >> 3;
#ifdef SK_NOSPLIT
        s.s0 = (s.s0 / s.P) * s.P; s.s1 = (s.x == 7) ? T : (s.s1 / s.P) * s.P;
#endif
        s.A = (const char*)WSP(bf16_t, B_ACTM); s.B = (const char*)(F.ws + W_MOE + (size_t)L * 8 * WSTRIDE + WDOWN_OFF); s.astep = (size_t)256 * KD * 2; s.bstep = btile_bytes(KD); s.estep = WSTRIDE;
        const SKCtx sk{F.ws + WS_SK, WSP(unsigned, WS_CTL) + CW_SK + L * 4096, WSP(unsigned, WS_CTL) + CW_TMO};
        gemm_phase<EpiMoeDown, SKSched, true, true, false, F8>(F.lds, 128, KD, KD, s, e, sk, 65536);
        return;
    }
#endif
    { constexpr bool F8 = moe_f8(L); constexpr int KD = F8 ? FF / 2 : FF;
    const MoeSched s = moe_sched(F, L, WSP(bf16_t, B_ACTM), KD, WDOWN_OFF, KD, D / 256);
    gemm_phase<EpiMoeDown, MoeSched, false, true, false, F8>(F.lds, 128, KD, KD, s, e, SKCtx{nullptr, nullptr, nullptr}, 65536); }
}

__global__ void __launch_bounds__(NTHR, 2) fused_fwd(Args args) {
    extern __shared__ __attribute__((aligned(16))) unsigned char lds_raw[];
    Frame F;
    F.lds = (LAS unsigned char*)lds_raw; F.ws = args.ws; F.in = args.in; F.h = args.out;
    F.tid = threadIdx.x; F.lane = F.tid & 63; F.wave = __builtin_amdgcn_readfirstlane(F.tid >> 6);
    F.G = gridDim.x; { const int bx = blockIdx.x; F.vcu = (F.G % 8 == 0) ? (bx % 8) * (F.G / 8) + bx / 8 : bx; }
    F.gw = F.vcu * NWAVES + F.wave; F.NGW = F.G * NWAVES;
    volatile LAS unsigned* MISC = (volatile LAS unsigned*)(F.lds + MISC_OFF);
    if (F.tid < 64) MISC[F.tid] = 0u;
    __syncthreads();
    XcdBarrier bar = xcd_barrier_post(WSP(unsigned, WS_CTL) + CW_BAR, MISC + 8);
    const int lo = args.ph_lo, hi = args.ph_hi;
#ifdef TS_LO
#define TS_MARK(k, which) do { if (blockIdx.x == 0 && F.tid == 0 && (k) == (which ? TS_HI : TS_LO)) { const unsigned long long t_ = __builtin_amdgcn_s_memrealtime(); \
        if (which) { unsigned long long t0_ = ((unsigned long long*)(F.ws + WS_CTL))[1024]; __hip_atomic_store(WSP(unsigned, WS_CTL) + 2060, (unsigned)(t_ - t0_), __ATOMIC_RELAXED, __HIP_MEMORY_SCOPE_AGENT); } \
        else ((unsigned long long*)(F.ws + WS_CTL))[1024] = t_; } } while (0)
#else
#define TS_MARK(k, which)
#endif
#ifdef ONLY_PHASE
#define IN(k) ((k) == ONLY_PHASE && lo <= (k) && (k) < hi)
#else
#define IN(k) (lo <= (k) && (k) < hi)
#endif
#define SEAM(k) do { if (IN(k) && IN((k) + 1)) xcd_barrier(bar); } while (0)
#ifdef REP_PHASE
#define REP_LOOP(k) for (int _r = 0, _nr = ((k) == REP_PHASE ? args.nrep : 1); _r < _nr; ++_r)
#define REP_SEAM(k) if ((k) == REP_PHASE && _r + 1 < _nr) xcd_barrier(bar);
#define REP_H(k) (((k) == REP_PHASE && _r + 1 < _nr) ? (float*)(F.ws + WS_SK) : F.h)
#define REP_X(k) ((k) == REP_PHASE && _r + 1 < _nr)
#ifndef REP_VAR
#define REP_VAR 0
#endif
#else
#define REP_LOOP(k)
#define REP_SEAM(k)
#define REP_H(k) F.h
#define REP_X(k) false
#define REP_VAR 0
#endif

    TS_MARK(PH_PRO, 0); if (IN(PH_PRO)) { REP_LOOP(PH_PRO) { phase_prologue(F, args.wmask, args.lmask, args.hsrc);  REP_SEAM(PH_PRO) } } SEAM(PH_PRO); TS_MARK(PH_PRO, 1);
#ifdef EXTRA_BARRIERS
#ifdef EXTRA_LIGHT
    for (int q_ = 0; q_ < EXTRA_BARRIERS; ++q_) xcd_barrier_light(bar);
#else
    for (int q_ = 0; q_ < EXTRA_BARRIERS; ++q_) xcd_barrier(bar);
#endif
#endif
    TS_MARK(PH_LAT, 0); if (IN(PH_LAT)) { REP_LOOP(PH_LAT) { const DenseSched s = dense_sched(F, WSP(bf16_t, WS_HB), D, WSP(bf16_t, W_MLA_IN), D, M / 256, 3);
        EpiLat e{WSP(bf16_t, B_LAT), WSP(float, WS_SLOT24), WSP(float, WS_SSQ), WSP(bf16_t, B_KB), WSP(float, WS_ROPE)};
        gemm_phase(F.lds, D, D, D, s, e);  REP_SEAM(PH_LAT) } } SEAM(PH_LAT); TS_MARK(PH_LAT, 1);
    TS_MARK(PH_QKV, 0); if (IN(PH_QKV)) { REP_LOOP(PH_QKV) {
#ifndef SKIP_Q
        { const DenseSched s = dense_sched(F, WSP(bf16_t, B_LAT), 768, WSP(bf16_t, W_UQ), 384, M / 256, 6);
          EpiQ e{WSP(bf16_t, B_Q), WSP(float, WS_SLOT24), WSP(float, WS_ROPE)};
          gemm_phase(F.lds, 768, 384, 384, s, e); }
#endif
#ifndef SKIP_KV
        { const DenseSched s = dense_sched(F, WSP(bf16_t, B_LAT) + 384, 768, WSP(bf16_t, W_UKV), 256, M / 256, 8);
          EpiKV e{WSP(bf16_t, B_KB), WSP(bf16_t, B_VB), WSP(float, WS_SLOT24)};
          gemm_phase(F.lds, 768, 256, 256, s, e); }
#endif
         REP_SEAM(PH_QKV) } } SEAM(PH_QKV); TS_MARK(PH_QKV, 1);
    TS_MARK(PH_ATTN, 0); if (IN(PH_ATTN)) { REP_LOOP(PH_ATTN) { phase_attn(F, REP_X(PH_ATTN) ? REP_VAR : 0);  REP_SEAM(PH_ATTN) } } SEAM(PH_ATTN); TS_MARK(PH_ATTN, 1);
    TS_MARK(PH_WO, 0); if (IN(PH_WO)) { REP_LOOP(PH_WO) { const DenseSched s = dense_sched(F, WSP(bf16_t, B_OB), D, WSP(bf16_t, W_O), D, M / 256, 4);
        EpiRes e{HB_ONLY ? nullptr : INF(0), WSP(bf16_t, WS_HB), WSP(bf16_t, WS_LO), WSP(float, WS_SSQ), nullptr, ffn_f8(0) ? F.ws + WS_X8 : nullptr, 1.f};
        gemm_phase(F.lds, D, D, D, s, e);  REP_SEAM(PH_WO) } } SEAM(PH_WO); TS_MARK(PH_WO, 1);
    TS_MARK(PH_FUP0, 0); if (IN(PH_FUP0)) { REP_LOOP(PH_FUP0) { phase_ffn_up<0>(F, REP_X(PH_FUP0) ? (bf16_t*)(F.ws + WS_BIG + 128 * MiB) : WSP(bf16_t, B_ACT), REP_X(PH_FUP0) ? REP_VAR : 0);  REP_SEAM(PH_FUP0) } } SEAM(PH_FUP0); TS_MARK(PH_FUP0, 1);
    TS_MARK(PH_FDN0, 0); if (IN(PH_FDN0)) { REP_LOOP(PH_FDN0) { phase_ffn_down<0>(F);  REP_SEAM(PH_FDN0) } } SEAM(PH_FDN0); TS_MARK(PH_FDN0, 1);
    TS_MARK(PH_LIN, 0); if (IN(PH_LIN)) { REP_LOOP(PH_LIN) { const DenseSched s = dense_sched(F, WSP(bf16_t, WS_HB), D, WSP(bf16_t, W_LRU_IN), D, M / 256, 8);
        EpiSplit2<true, false> e{WSP(bf16_t, B_GATEB), WSP(bf16_t, B_XBR), WSP(float, WS_SSQ)};
        gemm_phase(F.lds, D, D, D, s, e);  REP_SEAM(PH_LIN) } } SEAM(PH_LIN); TS_MARK(PH_LIN, 1);
    TS_MARK(PH_CONV, 0); if (IN(PH_CONV)) { REP_LOOP(PH_CONV) { phase_conv(F);  REP_SEAM(PH_CONV) } } SEAM(PH_CONV); TS_MARK(PH_CONV, 1);
    TS_MARK(PH_LGATE, 0); if (IN(PH_LGATE)) { REP_LOOP(PH_LGATE) { GroupSched s; s.nM = M / 256; s.nN = 8; s.G = F.G; s.c = (int)blockIdx.x; s.A = (const char*)WSP(bf16_t, B_XCB); s.B = (const char*)WSP(bf16_t, W_LRU_G);
        s.astep = (size_t)256 * D * 2; s.bstep = btile_bytes(256); s.acol_bytes = 512; s.acol_shift = 1;
        EpiLruGate e{WSP(unsigned, B_AF), WSP(bf16_t, B_XCB), INF(15), INF(17), WSP(float, WS_SP8), WSP(f32x2, WS_CARRY)};
        gemm_phase(F.lds, D, 256, 256, s, e);  REP_SEAM(PH_LGATE) } } SEAM(PH_LGATE); TS_MARK(PH_LGATE, 1);
    TS_MARK(PH_SCAN2, 0); if (IN(PH_SCAN2)) { REP_LOOP(PH_SCAN2) { phase_scan2(F);  REP_SEAM(PH_SCAN2) } } SEAM(PH_SCAN2); TS_MARK(PH_SCAN2, 1);
    TS_MARK(PH_LOUT, 0); if (IN(PH_LOUT)) { REP_LOOP(PH_LOUT) { const DenseSched s = dense_sched(F, WSP(bf16_t, B_YB), D, WSP(bf16_t, W_LRU_OUT), D, M / 256, 4);
        EpiRes e{nullptr, WSP(bf16_t, WS_HB), WSP(bf16_t, WS_LO), WSP(float, WS_SSQ), nullptr, nullptr, 1.f};
        gemm_phase(F.lds, D, D, D, s, e);  REP_SEAM(PH_LOUT) } } SEAM(PH_LOUT); TS_MARK(PH_LOUT, 1);
    TS_MARK(PH_ROUT0, 0); if (IN(PH_ROUT0)) { REP_LOOP(PH_ROUT0) { phase_router(F, 0);  REP_SEAM(PH_ROUT0) } } SEAM(PH_ROUT0); TS_MARK(PH_ROUT0, 1);
    TS_MARK(PH_GATH0, 0); if (IN(PH_GATH0)) { REP_LOOP(PH_GATH0) { phase_gather(F, 0);  REP_SEAM(PH_GATH0) } } SEAM(PH_GATH0); TS_MARK(PH_GATH0, 1);
    TS_MARK(PH_MUP0, 0); if (IN(PH_MUP0)) { REP_LOOP(PH_MUP0) { phase_moe_up<0>(F, REP_X(PH_MUP0) ? REP_VAR : 0);  REP_SEAM(PH_MUP0) } } SEAM(PH_MUP0); TS_MARK(PH_MUP0, 1);
    TS_MARK(PH_MDN0, 0); if (IN(PH_MDN0)) { REP_LOOP(PH_MDN0) { phase_moe_down<0>(F);  REP_SEAM(PH_MDN0) } } SEAM(PH_MDN0); TS_MARK(PH_MDN0, 1);
    TS_MARK(PH_COMB0, 0); if (IN(PH_COMB0)) { REP_LOOP(PH_COMB0) { phase_combine<false>(F, 1.0f, 0);  REP_SEAM(PH_COMB0) } } SEAM(PH_COMB0); TS_MARK(PH_COMB0, 1);
    TS_MARK(PH_POOL, 0); if (IN(PH_POOL)) { REP_LOOP(PH_POOL) { phase_pool(F);  REP_SEAM(PH_POOL) } } SEAM(PH_POOL); TS_MARK(PH_POOL, 1);
    TS_MARK(PH_PGEMM, 0); if (IN(PH_PGEMM)) { REP_LOOP(PH_PGEMM) { GroupSched s; s.nM = M / 256; s.nN = 4; s.G = F.G; s.c = (int)blockIdx.x; s.A = (const char*)WSP(bf16_t, B_POOLED); s.B = (const char*)WSP(bf16_t, W_POOL);
        s.astep = (size_t)256 * D * 2; s.bstep = btile_bytes(256); s.acol_bytes = 512; s.acol_shift = 0;
        EpiRes e{nullptr, WSP(bf16_t, WS_HB), WSP(bf16_t, WS_LO), WSP(float, WS_SSQ), INF(21), ffn_f8(1) ? F.ws + WS_X8 : nullptr, 1.f};
        gemm_phase(F.lds, D, 256, 256, s, e);  REP_SEAM(PH_PGEMM) } } SEAM(PH_PGEMM); TS_MARK(PH_PGEMM, 1);
    TS_MARK(PH_FUP1, 0); if (IN(PH_FUP1)) { REP_LOOP(PH_FUP1) { phase_ffn_up<1>(F, WSP(bf16_t, B_ACT), 0);  REP_SEAM(PH_FUP1) } } SEAM(PH_FUP1); TS_MARK(PH_FUP1, 1);
    TS_MARK(PH_FDN1, 0); if (IN(PH_FDN1)) { REP_LOOP(PH_FDN1) { phase_ffn_down<1>(F);  REP_SEAM(PH_FDN1) } } SEAM(PH_FDN1); TS_MARK(PH_FDN1, 1);
    TS_MARK(PH_GIN, 0); if (IN(PH_GIN)) { REP_LOOP(PH_GIN) { const DenseSched s = dense_sched(F, WSP(bf16_t, WS_HB), D, WSP(bf16_t, W_GM_IN), D, M / 256, 8);
        EpiSplit2<true, true> e{WSP(bf16_t, B_UB), WSP(bf16_t, B_VB2), WSP(float, WS_SSQ)};
        gemm_phase(F.lds, D, D, D, s, e);  REP_SEAM(PH_GIN) } } SEAM(PH_GIN); TS_MARK(PH_GIN, 1);
    TS_MARK(PH_GGATE, 0); if (IN(PH_GGATE)) { REP_LOOP(PH_GGATE) { phase_gmlp(F);  REP_SEAM(PH_GGATE) } } SEAM(PH_GGATE); TS_MARK(PH_GGATE, 1);
    TS_MARK(PH_GOUT, 0); if (IN(PH_GOUT)) { REP_LOOP(PH_GOUT) { const DenseSched s = dense_sched(F, WSP(bf16_t, B_UVB), D, WSP(bf16_t, W_GM_OUT), D, M / 256, 4);
        EpiRes e{nullptr, WSP(bf16_t, WS_HB), WSP(bf16_t, WS_LO), WSP(float, WS_SSQ), nullptr, nullptr, 1.f};
        gemm_phase(F.lds, D, D, D, s, e);  REP_SEAM(PH_GOUT) } } SEAM(PH_GOUT); TS_MARK(PH_GOUT, 1);
    TS_MARK(PH_ROUT1, 0); if (IN(PH_ROUT1)) { REP_LOOP(PH_ROUT1) { phase_router(F, 1);  REP_SEAM(PH_ROUT1) } } SEAM(PH_ROUT1); TS_MARK(PH_ROUT1, 1);
    TS_MARK(PH_GATH1, 0); if (IN(PH_GATH1)) { REP_LOOP(PH_GATH1) { phase_gather(F, 1);  REP_SEAM(PH_GATH1) } } SEAM(PH_GATH1); TS_MARK(PH_GATH1, 1);
    TS_MARK(PH_MUP1, 0); if (IN(PH_MUP1)) { REP_LOOP(PH_MUP1) { phase_moe_up<1>(F, 0);  REP_SEAM(PH_MUP1) } } SEAM(PH_MUP1); TS_MARK(PH_MUP1, 1);
    TS_MARK(PH_MDN1, 0); if (IN(PH_MDN1)) { REP_LOOP(PH_MDN1) { phase_moe_down<1>(F);  REP_SEAM(PH_MDN1) } } SEAM(PH_MDN1); TS_MARK(PH_MDN1, 1);
#ifdef TS_LO
    float ts_scale = 1.0f; { const unsigned dt = __hip_atomic_load(WSP(unsigned, WS_CTL) + 2060, __ATOMIC_RELAXED, __HIP_MEMORY_SCOPE_AGENT); ts_scale = 1.0f + sqrtf((float)dt * 0.01f * 1e-5f); }
    if (IN(PH_FINAL)) { phase_combine<true>(F, ts_scale, 1); }
#else
    if (IN(PH_FINAL)) { phase_combine<true>(F, 1.0f, 1); }
#endif
#undef IN
#undef SEAM
}
}
extern "C" void kernel_launch(void* const* d_in, const int* in_sizes, int n_in, void* d_out, int out_size, void* d_ws, size_t ws_size, hipStream_t stream) {
    (void)in_sizes; (void)out_size;
    static int grid = 0;
    if (grid == 0) {
        int dev = 0, cus = 0;
        if (n_in != 35 || ws_size < fk::WS_SK + (size_t)fk::MOE_MAXROWS * fk::D * 2) { fprintf(stderr, "kernel_launch: unexpected inputs / workspace (%d inputs, %zu bytes)\n", n_in, ws_size); grid = -1; return; }
        if (hipGetDevice(&dev) != hipSuccess || hipDeviceGetAttribute(&cus, hipDeviceAttributeMultiprocessorCount, dev) != hipSuccess) { grid = -1; return; }
        if (hipFuncSetAttribute((const void*)fk::fused_fwd, hipFuncAttributeMaxDynamicSharedMemorySize, fk::LDS_BYTES) != hipSuccess) { grid = -1; return; }
        int per_cu = 0; (void)hipOccupancyMaxActiveBlocksPerMultiprocessor(&per_cu, (const void*)fk::fused_fwd, fk::NTHR, fk::LDS_BYTES); (void)hipGetLastError();
        if (cus != 256) { fprintf(stderr, "kernel_launch: built for a 256-CU device (got %d CUs)\n", cus); grid = -1; return; }
        grid = cus;
    }
    if (grid < 0) return;
    (void)hipMemsetAsync((char*)d_ws + fk::WS_CTL, 0, fk::CTL_ZERO_BYTES, stream);
    fk::Args a{}; for (int i = 0; i < 35; ++i) a.in[i] = d_in[i];
    a.out = (float*)d_out; a.ws = (unsigned char*)d_ws; a.hsrc = (float*)d_in[0]; a.ph_lo = 0; a.ph_hi = fk::PH_N; a.wmask = 0x3FFFFu; a.lmask = 0xFu;
#ifdef REP_PHASE
    a.nrep = REP_N;
#else
    a.nrep = 1;
#endif
    hipLaunchKernelGGL(fk::fused_fwd, dim3(grid), dim3(fk::NTHR), fk::LDS_BYTES, stream, a);
}
```

```cpp
#include <hip/hip_runtime.h>
#include <cstdio>
#include <cstdint>
#include <cmath>
#define HB_ONLY 1
#define MOE_F8 3
#define FFN_F8 2
#define CONV_NT 1
#define ACT_STORE_POL 5
#define BAR_FLAT 1
namespace fk {
#define LAS __attribute__((address_space(3)))
#define GAS __attribute__((address_space(1)))
typedef unsigned short bf16_t;
typedef short bf16x8 __attribute__((ext_vector_type(8)));
typedef short s16x4 __attribute__((ext_vector_type(4)));
typedef float f32x4 __attribute__((ext_vector_type(4)));
typedef float f32x2 __attribute__((ext_vector_type(2)));
typedef float f32x16 __attribute__((ext_vector_type(16)));
typedef unsigned u32x4 __attribute__((ext_vector_type(4)));
typedef unsigned u32x2 __attribute__((ext_vector_type(2)));
typedef __bf16 bf16x2_t __attribute__((ext_vector_type(2)));
typedef int i32x4 __attribute__((ext_vector_type(4)));
typedef int i32x8 __attribute__((ext_vector_type(8)));
#ifndef MOE_F8
#define MOE_F8 2
#endif
__host__ __device__ constexpr bool moe_f8(int l) { return ((MOE_F8 >> l) & 1) != 0; }
#ifndef FFN_F8
#define FFN_F8 0
#endif
__host__ __device__ constexpr bool ffn_f8(int l) { return ((FFN_F8 >> l) & 1) != 0; }
constexpr float F8_SX = 8.f, F8_SW = 64.f, F8_SA = 8.f;
__device__ __forceinline__ unsigned pk_fp8x4(float a, float b, float c, float d) {
    a = __builtin_amdgcn_fmed3f(a, -448.f, 448.f); b = __builtin_amdgcn_fmed3f(b, -448.f, 448.f); c = __builtin_amdgcn_fmed3f(c, -448.f, 448.f); d = __builtin_amdgcn_fmed3f(d, -448.f, 448.f);
    int r = __builtin_amdgcn_cvt_pk_fp8_f32(a, b, 0, false); r = __builtin_amdgcn_cvt_pk_fp8_f32(c, d, r, true); return (unsigned)r;
}

constexpr int D = 1024, NB = 4, S = 4096, M = NB * S, FF = 3584, NE = 8, NH = 16;
constexpr int MOE_MAXP = 136, MOE_MAXROWS = MOE_MAXP * 256;
constexpr float RMS_EPS = 1e-6f, LN_EPS = 1e-5f;
constexpr int NWAVES = 8, NTHR = 512;
constexpr int LDS_BYTES = 147456, MISC_OFF = LDS_BYTES - 256;

constexpr size_t MiB = 1u << 20;
#ifndef FAST_BASE_MIB
#define FAST_BASE_MIB 0
#endif
constexpr size_t FB = (size_t)FAST_BASE_MIB * MiB;
constexpr size_t WS_CTL = FB, CTL_ZERO_BYTES = 1 * MiB;
constexpr size_t WS_SSQ = FB + 1 * MiB;
constexpr size_t WS_SLOT24 = FB + 2 * MiB;
constexpr size_t WS_ROPE = FB + 4 * MiB;
constexpr size_t WS_SP8 = FB + 6 * MiB;
constexpr size_t WS_ROUTW = FB + 6 * MiB + 65536;
constexpr size_t WS_WGBASE = FB + 6 * MiB + 262144;
constexpr size_t WS_RSTD = FB + 6 * MiB + 524288;
constexpr size_t WS_TOKINFO = FB + 7 * MiB;
constexpr size_t WS_TOKG = FB + 7 * MiB + 262144;
constexpr size_t WS_DEST = FB + 7 * MiB + 393216;
constexpr size_t WS_ROWTOK = FB + 7 * MiB + 524288;
constexpr size_t WS_ROWSCALE = FB + 8 * MiB;
constexpr size_t WS_ROWGATE = FB + 8 * MiB + 262144;
constexpr size_t WS_CARRY = FB + 9 * MiB;
constexpr size_t WS_HB = FB + 12 * MiB;
constexpr size_t WS_LO = FB + 44 * MiB;
constexpr size_t WS_X8 = WS_LO;
#ifndef HB_ONLY
#define HB_ONLY 0
#endif
static_assert(FFN_F8 == 0 || HB_ONLY, "the fp8 stream copy lives in the lo-half buffer");
constexpr size_t WS_W = FB + 76 * MiB;
constexpr size_t W_MLA_IN = WS_W, W_UQ = WS_W + 2 * MiB, W_UKV = W_UQ + 2 * MiB, W_O = W_UKV + 2 * MiB, W_LRU_IN = W_O + 3 * MiB, W_LRU_G = W_LRU_IN + 5 * MiB,
                 W_LRU_OUT = W_LRU_G + 2 * MiB, W_POOL = W_LRU_OUT + 3 * MiB, W_GM_IN = W_POOL + 1 * MiB, W_GM_S = W_GM_IN + 5 * MiB, W_GM_OUT = W_GM_S + 131072;
constexpr size_t WSTRIDE = 21 * MiB + 96 * 1024;
constexpr size_t WDOWN_OFF = 14 * MiB;
constexpr size_t W_FFN = WS_W + 32 * MiB;
constexpr size_t W_MOE = W_FFN + 2 * WSTRIDE + MiB;
constexpr size_t WS_BIG = FB + 492 * MiB;
static_assert(W_GM_OUT + 4 * MiB <= W_FFN && W_MOE + 16 * WSTRIDE <= WS_BIG, "weight map");
constexpr size_t B_LAT = WS_BIG, B_Q = WS_BIG + 24 * MiB, B_KB = WS_BIG + 72 * MiB, B_VB = WS_BIG + 120 * MiB, B_OB = WS_BIG + 152 * MiB;
constexpr size_t B_ACT = WS_BIG;
constexpr size_t B_GATEB = WS_BIG, B_XBR = WS_BIG + 32 * MiB, B_XCB = WS_BIG + 64 * MiB, B_AF = WS_BIG + 96 * MiB, B_BF = WS_BIG + 160 * MiB, B_YB = WS_BIG + 224 * MiB;
constexpr size_t B_XG = WS_BIG, B_OUTM = WS_BIG, B_ACTM = WS_BIG + 68 * MiB;
constexpr size_t B_POOLED = WS_BIG;
constexpr size_t B_UB = WS_BIG, B_VB2 = WS_BIG + 32 * MiB, B_UVB = WS_BIG + 64 * MiB;
constexpr size_t WS_END = WS_BIG + 306 * MiB;
constexpr size_t WS_SK = WS_END;
constexpr int CW_TMO = 0, CW_BAR = 4096, CW_MOECNT = 16384, CW_SK = 32768;
#ifndef MDN_STREAMK
#define MDN_STREAMK 1
#endif
#ifndef MUP_GATHER
#define MUP_GATHER 0
#endif

__device__ __forceinline__ unsigned pk2(float lo, float hi) { f32x2 v = {lo, hi}; bf16x2_t b = __builtin_convertvector(v, bf16x2_t); return __builtin_bit_cast(unsigned, b); }
__device__ __forceinline__ float bf2f(unsigned short b) { return __uint_as_float((unsigned)b << 16); }
__device__ __forceinline__ float bflo(unsigned w) { return __uint_as_float(w << 16); }
__device__ __forceinline__ float bfhi(unsigned w) { return __uint_as_float(w & 0xffff0000u); }
__device__ __forceinline__ float fast_exp2(float x) { return __builtin_amdgcn_exp2f(x); }
__device__ __forceinline__ float fast_rcp(float x) { return __builtin_amdgcn_rcpf(x); }
__device__ __forceinline__ float sigmoid_f(float x) { return fast_rcp(1.0f + fast_exp2(-1.4426950408889634f * x)); }
__device__ __forceinline__ float silu_f(float x) { return x * sigmoid_f(x); }
__device__ __forceinline__ float gelu_tanh_f(float x) { const float u = 0.7978845608028654f * (x + 0.044715f * x * x * x); return x * sigmoid_f(2.0f * u); }
__device__ __forceinline__ float wave_sum(float v) {
#pragma unroll
    for (int o = 1; o < 64; o <<= 1) v += __shfl_xor(v, o);
    return v;
}
__device__ __forceinline__ float hsum4(f32x4 a) { return (a.x + a.y) + (a.z + a.w); }
__device__ __forceinline__ float rstd16(const float* ssq, int row) {
    const f32x4* p = (const f32x4*)(ssq + (size_t)row * 16); const f32x4 a = p[0], b = p[1], c = p[2], d = p[3];
    const float s = (hsum4(a) + hsum4(b)) + (hsum4(c) + hsum4(d)); return 1.0f / sqrtf(s * (1.0f / 1024.0f) + RMS_EPS);
}

#ifndef BAR_FLAT
#define BAR_FLAT 0
#endif
#define XB_TMO      128
#define XB_XCNT(j)  (256  + 64 * (j))
#define XB_XSUB(j)  (1280 + 64 * (j))
#define XB_XGEN(j)  (2304 + 64 * (j))
#define XB_TOP      3328
#define XB_TOPGEN   3392
#define XCD_BAR_WORDS 3456
#define XB_SPIN_CAP (1u << 18)
__device__ __forceinline__ unsigned xb_ld(unsigned* p)              { return __hip_atomic_load(p, __ATOMIC_RELAXED, __HIP_MEMORY_SCOPE_AGENT); }
__device__ __forceinline__ unsigned xb_add(unsigned* p, unsigned v) { return __hip_atomic_fetch_add(p, v, __ATOMIC_RELAXED, __HIP_MEMORY_SCOPE_AGENT); }
__device__ __forceinline__ unsigned xb_xcc_id() { return (unsigned)__builtin_amdgcn_s_getreg((3 << 11) | 20) & 0xFu; }
#define XB_SPIN(cond, bar) do { unsigned _sp = 0; while (cond) { __builtin_amdgcn_s_sleep(1); \
    if ((++_sp & 255u) == 0u) { if (xb_ld(&(bar)[XB_TMO])) break; if (_sp > XB_SPIN_CAP) { atomicAdd(&(bar)[XB_TMO], 1u); break; } } } } while (0)
struct XcdBarrier { unsigned* bar; unsigned x; volatile LAS unsigned* st; };
__device__ __forceinline__ XcdBarrier xcd_barrier_post(unsigned* bar, volatile LAS unsigned* st) {
    XcdBarrier b; b.bar = bar; b.x = xb_xcc_id(); b.st = st;
    if (threadIdx.x == 0) (void)xb_add(&bar[XB_XCNT(b.x)], 1u);
    return b;
}
__device__ __forceinline__ void xcd_barrier_complete(unsigned* bar, unsigned x, unsigned& nloc, unsigned& nx) {
    const unsigned G = gridDim.x * gridDim.y * gridDim.z;
    unsigned sum, cnt, mine, sp = 0u;
    for (;;) {
        sum = 0u; cnt = 0u; mine = 0u;
#pragma unroll
        for (unsigned j = 0; j < 16; ++j) { const unsigned c = xb_ld(&bar[XB_XCNT(j)]); sum += c; cnt += (c > 0u) ? 1u : 0u; mine = (j == x) ? c : mine; }
        if (sum == G) break;
        __builtin_amdgcn_s_sleep(1);
        if ((++sp & 255u) == 0u) { if (xb_ld(&bar[XB_TMO])) break; if (sp > XB_SPIN_CAP) { atomicAdd(&bar[XB_TMO], 1u); break; } }
    }
    nloc = mine > 0u ? mine : 1u; nx = cnt > 0u ? cnt : 1u;
}
__device__ __forceinline__ void xcd_barrier(const XcdBarrier& b) {
    asm volatile("s_waitcnt vmcnt(0)" ::: "memory");
    __syncthreads();
    if (threadIdx.x == 0) {
        unsigned* bar = b.bar;
        __builtin_amdgcn_s_waitcnt(0);
        unsigned nloc = b.st[0], nx = b.st[1];
        if (nloc == 0u) { xcd_barrier_complete(bar, b.x, nloc, nx); b.st[0] = nloc; b.st[1] = nx; }
        const unsigned old = xb_add(&bar[XB_XSUB(b.x)], 1u);
        const unsigned gen = old / nloc;
#if BAR_FLAT
        if (old + 1u == (gen + 1u) * nloc) { __builtin_amdgcn_fence(__ATOMIC_RELEASE, "agent"); asm volatile("s_waitcnt vmcnt(0)" ::: "memory"); (void)xb_add(&bar[XB_TOP], 1u); }
        { const unsigned target = (gen + 1u) * nx; XB_SPIN(xb_ld(&bar[XB_TOP]) < target, bar); }
        __builtin_amdgcn_fence(__ATOMIC_ACQUIRE, "agent");
        asm volatile("s_waitcnt vmcnt(0)" ::: "memory");
#else
        if (old + 1u == (gen + 1u) * nloc) {
            __builtin_amdgcn_fence(__ATOMIC_RELEASE, "agent");
            asm volatile("s_waitcnt vmcnt(0)" ::: "memory");
            const unsigned og = xb_add(&bar[XB_TOP], 1u);
            const unsigned tg = og / nx;
            if (og + 1u == (tg + 1u) * nx) xb_add(&bar[XB_TOPGEN], 1u);
            else XB_SPIN(xb_ld(&bar[XB_TOPGEN]) == tg, bar);
            __builtin_amdgcn_fence(__ATOMIC_ACQUIRE, "agent");
            xb_add(&bar[XB_XGEN(b.x)], 1u);
            asm volatile("s_waitcnt vmcnt(0)" ::: "memory");
        } else {
            XB_SPIN(xb_ld(&bar[XB_XGEN(b.x)]) == gen, bar);
            __builtin_amdgcn_fence(__ATOMIC_ACQUIRE, "agent");
            asm volatile("s_waitcnt vmcnt(0)" ::: "memory");
        }
#endif
    }
    __syncthreads();
}

#ifdef EXTRA_LIGHT
__device__ __forceinline__ void xcd_barrier_light(const XcdBarrier& b) {
    asm volatile("s_waitcnt vmcnt(0)" ::: "memory");
    __syncthreads();
    if (threadIdx.x == 0) {
        unsigned* bar = b.bar;
        __builtin_amdgcn_s_waitcnt(0);
        unsigned nloc = b.st[0], nx = b.st[1];
        if (nloc == 0u) { xcd_barrier_complete(bar, b.x, nloc, nx); b.st[0] = nloc; b.st[1] = nx; }
        const unsigned old = xb_add(&bar[XB_XSUB(b.x)], 1u);
        const unsigned gen = old / nloc;
        if (old + 1u == (gen + 1u) * nloc) {

            asm volatile("s_waitcnt vmcnt(0)" ::: "memory");
            const unsigned og = xb_add(&bar[XB_TOP], 1u);
            const unsigned tg = og / nx;
            if (og + 1u == (tg + 1u) * nx) xb_add(&bar[XB_TOPGEN], 1u);
            else XB_SPIN(xb_ld(&bar[XB_TOPGEN]) == tg, bar);

            xb_add(&bar[XB_XGEN(b.x)], 1u);
            asm volatile("s_waitcnt vmcnt(0)" ::: "memory");
        } else {
            XB_SPIN(xb_ld(&bar[XB_XGEN(b.x)]) == gen, bar);

            asm volatile("s_waitcnt vmcnt(0)" ::: "memory");
        }
    }
    __syncthreads();
}

#endif
#ifndef WLAYOUT
#define WLAYOUT 0
#endif
constexpr int BM = 256, BK = 64, HALF = 128, HTB = HALF * BK * 2, STAGE_BYTES = 8 * HTB, NXCD = 8, WGM = 8;
__device__ __forceinline__ int lds_byte(int r, int c) { const int st = (r >> 4) * 2 + (c >> 5), rr = r & 15, cc = c & 31, ob = rr * 64 + cc * 2; return st * 1024 + (ob ^ (((ob >> 9) & 1) << 5)); }
__device__ __forceinline__ void stage_rc(int b, int& R, int& C) { const int st = b / 1024, sb = b % 1024, swz = sb ^ (((sb >> 9) & 1) << 5); R = (st >> 1) * 16 + swz / 64; C = (st & 1) * 32 + (swz % 64) / 2; }
__device__ __forceinline__ int perm32(int rho) { const int n = rho >> 4, i = rho & 15; return 8 * (i >> 2) + 4 * n + (i & 3); }

__device__ __forceinline__ const char* uni_ptr(const char* p) { const unsigned long long v = (unsigned long long)p; const unsigned lo = __builtin_amdgcn_readfirstlane((unsigned)v), hi = __builtin_amdgcn_readfirstlane((unsigned)(v >> 32)); return (const char*)(((unsigned long long)hi << 32) | lo); }
#ifndef BPAD
#define BPAD 0
#endif
static_assert(WLAYOUT == 0 && BPAD == 0, "the weight map is sized for the row-major layout");
__host__ __device__ constexpr size_t btile_bytes(int K) {
#if WLAYOUT
    return (size_t)(K / 64 + 1) * 32768;
#else
    return (size_t)(K + BPAD) * 512;
#endif
}
struct GUnit { int pm, pn; const char* A; const char* B; int ex; int nkt, kind, slot; };
__device__ __forceinline__ bool tile_order(int i, int G, int c, int nM, int nN, int& pm, int& pn) {
    const int nwg = nM * nN; const long L = (long)i * G + c; if (L >= nwg) return false;
    int wgid = (int)L; { const int q = nwg / NXCD, r = nwg % NXCD, xcd = wgid % NXCD, off = wgid / NXCD; wgid = (xcd < r ? xcd * (q + 1) : r * (q + 1) + (xcd - r) * q) + off; }
    const int nig = WGM * nN, gid = wgid / nig, fm = gid * WGM, gsz = (nM - fm) < WGM ? (nM - fm) : WGM;
    pm = fm + ((wgid % nig) % gsz); pn = (wgid % nig) / gsz; return true;
}
struct DenseSched {
    int nM, nN, G, c; const char* A; const char* B; size_t astep, bstep;
    __device__ __forceinline__ bool next(int i, GUnit& u) const { if (!tile_order(i, G, c, nM, nN, u.pm, u.pn)) return false; u.A = A + (size_t)u.pm * astep; u.B = B + (size_t)u.pn * bstep; u.ex = 0; u.nkt = 0; u.kind = 0; u.slot = 0; return true; }
};
struct GroupSched {
    int nM, nN, G, c; const char* A; const char* B; size_t astep, bstep; int acol_bytes, acol_shift;
    __device__ __forceinline__ bool next(int i, GUnit& u) const { if (!tile_order(i, G, c, nM, nN, u.pm, u.pn)) return false;
        u.A = A + (size_t)u.pm * astep + (size_t)(u.pn >> acol_shift) * acol_bytes; u.B = B + (size_t)u.pn * bstep; u.ex = 0; u.nkt = 0; u.kind = 0; u.slot = 0; return true; }
};
struct MoeSched {
    int nM, nN, G, c; const char* A; const char* B; size_t astep, bstep, estep; int pend[NE];
    __device__ __forceinline__ bool next(int i, GUnit& u) const { if (!tile_order(i, G, c, nM, nN, u.pm, u.pn)) return false;
        int e = 0;
#pragma unroll
        for (int k = 0; k < NE - 1; ++k) e += (u.pm >= pend[k]) ? 1 : 0;
        u.ex = e; u.A = A + (size_t)u.pm * astep; u.B = B + (size_t)e * estep + (size_t)u.pn * bstep; u.nkt = 0; u.kind = 0; u.slot = 0; return true; }
};
struct SKSched {
    int NP, P, s0, s1, x, r, j; const char* A; const char* B; size_t astep, bstep, estep; int pend[NE];
    __device__ __forceinline__ bool next(int i, GUnit& u) const {
        const int rem = s0 % P; int start;
        if (rem != 0) start = (i == 0) ? s0 : (s0 - rem + P) + (i - 1) * P; else start = s0 + i * P;
        if (start >= s1) return false;
        const int sp = start / P, k0 = start - sp * P; const int endp = (sp + 1) * P < s1 ? (sp + 1) * P : s1; const int len = endp - start;
        const int pm = sp * 8 + r; if (pm >= NP) return false;
        int e = 0;
#pragma unroll
        for (int k = 0; k < NE - 1; ++k) e += (pm >= pend[k]) ? 1 : 0;
        u.pm = pm; u.pn = j; u.ex = e; u.A = A + (size_t)pm * astep + (size_t)k0 * 65536; u.B = B + (size_t)e * estep + (size_t)j * bstep + (size_t)k0 * 256;
        u.nkt = 2 * len; u.kind = k0 > 0 ? 1 : (len < P ? 2 : 0); u.slot = (u.kind == 1 ? x - 1 : x) * 32 + r * 4 + j; return true; }
};

typedef f32x4 AccArr[2][2][4][2];
template <class T, class = void> struct epi_has_post { static constexpr bool value = false; };
template <class T> struct epi_has_post<T, decltype((void)T::POST)> { static constexpr bool value = T::POST; };
struct SKCtx { unsigned char* buf; unsigned* flags; unsigned* tmo; };
__device__ __forceinline__ void sk_store(const SKCtx& sk, const AccArr& acc, int slot, int tid, int lane) {
    const __amdgpu_buffer_rsrc_t rs = __builtin_amdgcn_make_buffer_rsrc(sk.buf + (size_t)slot * 262144, 0, 262144, 0x00020000);
#pragma unroll
    for (int a = 0; a < 2; ++a)
#pragma unroll
        for (int b = 0; b < 2; ++b)
#pragma unroll
            for (int m = 0; m < 4; ++m)
#pragma unroll
                for (int n = 0; n < 2; ++n) __builtin_amdgcn_raw_buffer_store_b128(__builtin_bit_cast(u32x4, acc[a][b][m][n]), rs, (unsigned)((((a * 2 + b) * 4 + m) * 2 + n) * 8192 + tid * 16), 0, 17);
    asm volatile("s_waitcnt vmcnt(0)" ::: "memory");
    __builtin_amdgcn_fence(__ATOMIC_RELEASE, "agent"); asm volatile("s_waitcnt vmcnt(0)" ::: "memory");
    if (lane == 0) __hip_atomic_fetch_add(sk.flags + 16 * slot, 1u, __ATOMIC_RELAXED, __HIP_MEMORY_SCOPE_AGENT);
}
__device__ __forceinline__ void sk_load_init(const SKCtx& sk, AccArr& acc, int slot, int tid) {
    { unsigned sp = 0; while (__builtin_amdgcn_readfirstlane(__hip_atomic_load(sk.flags + 16 * slot, __ATOMIC_RELAXED, __HIP_MEMORY_SCOPE_AGENT)) < 8u) { __builtin_amdgcn_s_sleep(2);
        if (++sp > (1u << 22)) { if (threadIdx.x == 0) __hip_atomic_store(sk.tmo, 1u, __ATOMIC_RELAXED, __HIP_MEMORY_SCOPE_AGENT); break; } } }
    __builtin_amdgcn_fence(__ATOMIC_ACQUIRE, "agent"); asm volatile("s_waitcnt vmcnt(0)" ::: "memory");
    const __amdgpu_buffer_rsrc_t rs = __builtin_amdgcn_make_buffer_rsrc(sk.buf + (size_t)slot * 262144, 0, 262144, 0x00020000);
    const unsigned vo = (unsigned)tid * 16u;
#pragma unroll
    for (int a = 0; a < 2; ++a)
#pragma unroll
        for (int b = 0; b < 2; ++b)
#pragma unroll
            for (int m = 0; m < 4; ++m)
#pragma unroll
                for (int n = 0; n < 2; ++n) acc[a][b][m][n] = __builtin_bit_cast(f32x4, __builtin_amdgcn_raw_buffer_load_b128(rs, vo, (unsigned)((((a * 2 + b) * 4 + m) * 2 + n) * 8192), 17));
    asm volatile("s_waitcnt vmcnt(0)" ::: "memory");
}
template <class Epi, class Sched, bool SK = false, bool ALIGN = true, bool GA = false, bool F8 = false>
__device__ __forceinline__ void gemm_phase(LAS unsigned char* lds, const int lda, const int nbr, const int K, const Sched& S, const Epi& E, const SKCtx sk = SKCtx{nullptr, nullptr, nullptr}, const size_t kpairA = 256, const int* gidx = nullptr) {
    const int tid = threadIdx.x, wid = __builtin_amdgcn_readfirstlane(tid >> 6), lane = tid & 63, wr = wid >> 2, wc = wid & 3, fr = lane & 15, fq = lane >> 4;
    const int nt_full = K / BK;
    unsigned voffA[2], voffB[2];
#pragma unroll
    for (int i = 0; i < 2; ++i) { int R, C; stage_rc(tid * 16 + i * 8192, R, C); const int Rb = Epi::PERM ? ((R & ~31) + perm32(R & 31)) : R;
        voffA[i] = (kpairA == 65536) ? (F8 ? (unsigned)(((C >> 4) * 256 + R) * 32 + (C & 15) * 2) : (unsigned)(((C >> 5) * 256 + R) * 64 + (C & 31) * 2)) : (unsigned)(R * lda + C) * 2u;
#if WLAYOUT
        voffB[i] = (unsigned)((C >> 3) * 256 + Rb) * 16u; }
#else
        voffB[i] = (unsigned)(Rb * (nbr + BPAD) + C) * 2u; }
#endif
    const size_t kstep = (kpairA == 65536) ? (size_t)32768 : (size_t)(BK * 2);
#if WLAYOUT
    const size_t hstepA = (size_t)HALF * lda * 2, hstepB = (size_t)HALF * 16, kstepB = (size_t)32768; (void)nbr;
#else
    const size_t hstepA = (kpairA == 65536) ? (size_t)HALF * (F8 ? 32 : 64) : (size_t)HALF * lda * 2, hstepB = (size_t)HALF * (nbr + BPAD) * 2, kstepB = (size_t)(BK * 2);
#endif
    const unsigned ldsw = (unsigned)wid * 1024u;
    const int aoff = lds_byte(wr * 64 + fr, fq * 8), boff = lds_byte(wc * 32 + fr, fq * 8);
#define PG8_SA(b, h) (((b) * 2 + (h)) * HTB)
#define PG8_SB(b, h) ((4 + (b) * 2 + (h)) * HTB)
#define PG8_STAGE(bufoff, gbase, voff) do { _Pragma("unroll") for (int _i = 0; _i < 2; ++_i) \
        __builtin_amdgcn_global_load_lds((const unsigned*)((const char*)(gbase) + (voff)[_i]), (LAS unsigned*)(lds + (bufoff) + ldsw + _i * 8192), 16, 0, 0); } while (0)
#define PG8_LDA(dst, b, h) do { _Pragma("unroll") for (int m = 0; m < 4; ++m) _Pragma("unroll") for (int k = 0; k < 2; ++k) dst[m][k] = *(const LAS bf16x8*)(lds + PG8_SA(b, h) + aoff + m * 2048 + k * 1024); } while (0)
#define PG8_LDB(dst, b, h) do { _Pragma("unroll") for (int n = 0; n < 2; ++n) _Pragma("unroll") for (int k = 0; k < 2; ++k) dst[n][k] = *(const LAS bf16x8*)(lds + PG8_SB(b, h) + boff + n * 2048 + k * 1024); } while (0)
#define PG8_CAT8(x) __builtin_shufflevector(__builtin_bit_cast(i32x4, (x)[0]), __builtin_bit_cast(i32x4, (x)[1]), 0, 1, 2, 3, 4, 5, 6, 7)
#define PG8_MMA(ai, bj, At, Bt) do { __builtin_amdgcn_s_setprio(1); _Pragma("unroll") for (int m = 0; m < 4; ++m) _Pragma("unroll") for (int n = 0; n < 2; ++n) { \
        if constexpr (F8) asm volatile("v_mfma_f32_16x16x128_f8f6f4 %0, %1, %2, %0" : "+v"(acc[ai][bj][m][n]) : "v"(PG8_CAT8(Bt[n])), "v"(PG8_CAT8(At[m])));     \
        else { _Pragma("unroll") for (int k = 0; k < 2; ++k) acc[ai][bj][m][n] = __builtin_amdgcn_mfma_f32_16x16x32_bf16(Bt[n][k], At[m][k], acc[ai][bj][m][n], 0, 0, 0); } } __builtin_amdgcn_s_setprio(0); } while (0)
#define PG8_WAIT_V(n) asm volatile("s_waitcnt vmcnt(" #n ")" ::: "memory")
#define PG8_WAIT_L(n) asm volatile("s_waitcnt lgkmcnt(" #n ")" ::: "memory")
#define PG8_BAR __builtin_amdgcn_s_barrier()
#define PG8_SCHED __builtin_amdgcn_sched_barrier(0)
    GUnit cur, nxt; int ui = 0;
    if (!S.next(0, cur)) return;
    unsigned vc[2][2] = {{0u, 0u}, {0u, 0u}}, vn[2][2] = {{0u, 0u}, {0u, 0u}};
    int gR[2], gC[2];
#pragma unroll
    for (int i = 0; i < 2; ++i) stage_rc(tid * 16 + i * 8192, gR[i], gC[i]);
#define PG8_GOFF(dst, pm_) do { if constexpr (GA) { _Pragma("unroll") for (int h_ = 0; h_ < 2; ++h_) _Pragma("unroll") for (int i_ = 0; i_ < 2; ++i_) \
        dst[h_][i_] = (unsigned)gidx[(pm_) * BM + h_ * HALF + gR[i_]] * (unsigned)(lda * 2) + (unsigned)(gC[i_] * 2); } } while (0)
    PG8_GOFF(vc, cur.pm);
    f32x4 acc[2][2][4][2];
#pragma unroll
    for (int a = 0; a < 2; ++a)
#pragma unroll
        for (int b = 0; b < 2; ++b)
#pragma unroll
            for (int m = 0; m < 4; ++m)
#pragma unroll
                for (int n = 0; n < 2; ++n) acc[a][b][m][n] = (f32x4){0.f, 0.f, 0.f, 0.f};
    bf16x8 At[4][2], B0[2][2], B1[2][2];
    const char* cA = uni_ptr(cur.A); const char* cB = uni_ptr(cur.B); int nt = SK ? __builtin_amdgcn_readfirstlane(cur.nkt) : nt_full;
    PG8_STAGE(PG8_SB(0, 0), cB, voffB); PG8_STAGE(PG8_SB(0, 1), cB + hstepB, voffB); PG8_STAGE(PG8_SA(0, 0), cA, (GA ? vc[0] : voffA)); PG8_STAGE(PG8_SA(0, 1), cA + (GA ? 0 : hstepA), (GA ? vc[1] : voffA));
    if (wr == 1) PG8_BAR;
    PG8_WAIT_V(2); PG8_BAR;
    PG8_STAGE(PG8_SB(1, 0), cB + kstepB, voffB); PG8_STAGE(PG8_SA(1, 0), cA + kstep, (GA ? vc[0] : voffA)); PG8_STAGE(PG8_SB(1, 1), cB + hstepB + kstepB, voffB);
    PG8_WAIT_V(6); PG8_BAR;
    for (;;) {
        const bool has_next = S.next(ui + 1, nxt);
        const char* nA = has_next ? uni_ptr(nxt.A) : cA; const char* nB = has_next ? uni_ptr(nxt.B) : cB;
        if (has_next) PG8_GOFF(vn, nxt.pm);
#pragma clang loop unroll(disable)
        for (int t = 0; t < nt; t += 2) {
            const bool last = (t == nt - 2);
            const char* a1 = cA + (size_t)(t >> 1) * kpairA + kstep;
            const char* a2 = last ? nA : cA + (size_t)((t >> 1) + 1) * kpairA; const char* b2 = last ? nB : cB + (size_t)(t + 2) * kstepB;
            const char* a3 = a2 + kstep; const char* b3 = b2 + kstepB;
            unsigned va2[2][2];
#pragma unroll
            for (int h_ = 0; h_ < 2; ++h_)
#pragma unroll
                for (int i_ = 0; i_ < 2; ++i_) va2[h_][i_] = GA ? ((last && has_next) ? vn[h_][i_] : vc[h_][i_]) : voffA[i_];
            const size_t hA = GA ? 0 : hstepA;
            PG8_LDB(B0, 0, 0); PG8_LDB(B1, 0, 1); PG8_SCHED; PG8_LDA(At, 0, 0); PG8_STAGE(PG8_SA(1, 1), a1 + hA, (GA ? vc[1] : voffA));
            if (Epi::NSTORE == 8 && t == 0 && ui > 0) PG8_WAIT_V(16); else PG8_WAIT_V(8);
            PG8_WAIT_L(0); PG8_BAR; PG8_MMA(0, 0, At, B0); PG8_MMA(0, 1, At, B1); PG8_BAR; PG8_SCHED;
            PG8_LDA(At, 0, 1); PG8_STAGE(PG8_SB(0, 0), b2, voffB); PG8_STAGE(PG8_SB(0, 1), b2 + hstepB, voffB); PG8_STAGE(PG8_SA(0, 0), a2, va2[0]);
            if (Epi::NSTORE == 8 && t == 0 && ui > 0) PG8_WAIT_V(16); else PG8_WAIT_V(8);
            PG8_WAIT_L(0); PG8_BAR; PG8_MMA(1, 0, At, B0); PG8_MMA(1, 1, At, B1); PG8_BAR; PG8_SCHED;
            PG8_LDB(B0, 1, 0); PG8_LDB(B1, 1, 1); PG8_SCHED; PG8_LDA(At, 1, 0); PG8_STAGE(PG8_SA(0, 1), a2 + hA, va2[1]);
            PG8_WAIT_V(8); PG8_WAIT_L(0); PG8_BAR; PG8_MMA(0, 0, At, B0); PG8_MMA(0, 1, At, B1); PG8_BAR; PG8_SCHED;
            PG8_LDA(At, 1, 1); PG8_STAGE(PG8_SB(1, 0), b3, voffB); PG8_STAGE(PG8_SB(1, 1), b3 + hstepB, voffB); PG8_STAGE(PG8_SA(1, 0), a3, va2[0]);
            PG8_WAIT_V(8); PG8_WAIT_L(0); PG8_BAR; PG8_MMA(1, 0, At, B0); PG8_MMA(1, 1, At, B1); PG8_BAR; PG8_SCHED;
        }
        if constexpr (F8) asm volatile("s_nop 7\n\ts_nop 7\n\ts_nop 3" ::: "memory");
        if constexpr (ALIGN) { if (wr == 0) PG8_BAR; }
        const LAS float* aux = (const LAS float*)(lds + STAGE_BYTES);
        const int kind = SK ? __builtin_amdgcn_readfirstlane(cur.kind) : 0, slot = SK ? __builtin_amdgcn_readfirstlane(cur.slot) : 0;
        (void)kind; (void)slot; (void)sk;
        {
        if constexpr (Epi::ROWSCALE) { if (tid < 256) ((LAS float*)(lds + STAGE_BYTES))[tid] = E.rowscale(cur.pm * BM + tid); PG8_WAIT_L(0); PG8_BAR; }
        E(acc, cur, wr, wc, fr, fq, aux);
        if constexpr (epi_has_post<Epi>::value) { PG8_WAIT_V(0); PG8_BAR; E.post(cur, tid); }
        }
        if (!has_next) break;
        {
#pragma unroll
        for (int a = 0; a < 2; ++a)
#pragma unroll
            for (int b = 0; b < 2; ++b)
#pragma unroll
                for (int m = 0; m < 4; ++m)
#pragma unroll
                    for (int n = 0; n < 2; ++n) acc[a][b][m][n] = (f32x4){0.f, 0.f, 0.f, 0.f};
        }
        cur = nxt; cA = nA; cB = nB; ++ui;
        if constexpr (GA) { _Pragma("unroll") for (int h_ = 0; h_ < 2; ++h_) _Pragma("unroll") for (int i_ = 0; i_ < 2; ++i_) vc[h_][i_] = vn[h_][i_]; } if constexpr (SK) nt = __builtin_amdgcn_readfirstlane(cur.nkt);
        if constexpr (ALIGN) { if (wr == 1) PG8_BAR; }
    }
    PG8_WAIT_V(0);
    if constexpr (!ALIGN) { if (wr == 0) PG8_BAR; }
    PG8_BAR;
#undef PG8_GOFF
#undef PG8_SA
#undef PG8_SB
#undef PG8_STAGE
#undef PG8_LDA
#undef PG8_LDB
#undef PG8_MMA
#undef PG8_CAT8
#undef PG8_WAIT_V
#undef PG8_WAIT_L
#undef PG8_BAR
#undef PG8_SCHED
}
typedef f32x4 AccT[2][2][4][2];
__device__ __forceinline__ void st_bf16x8(bf16_t* p, f32x4 v0, f32x4 v1) { u32x4 w; w.x = pk2(v0[0], v0[1]); w.y = pk2(v0[2], v0[3]); w.z = pk2(v1[0], v1[1]); w.w = pk2(v1[2], v1[3]); *(u32x4*)p = w; }
#ifndef ACT_STORE_POL
#define ACT_STORE_POL 0
#endif
__device__ __forceinline__ void st_bf16x8_pol(bf16_t* p, f32x4 v0, f32x4 v1, int pol) {
    u32x4 w; w.x = pk2(v0[0], v0[1]); w.y = pk2(v0[2], v0[3]); w.z = pk2(v1[0], v1[1]); w.w = pk2(v1[2], v1[3]);
    if (pol == 4) asm volatile("global_store_dwordx4 %0, %1, off sc1" :: "v"(p), "v"(w) : "memory");
    else if (pol == 5) asm volatile("global_store_dwordx4 %0, %1, off nt" :: "v"(p), "v"(w) : "memory");
    else *(u32x4*)p = w;
}
__device__ __forceinline__ void st_bf16x4(bf16_t* p, f32x4 v) { u32x2 w; w.x = pk2(v[0], v[1]); w.y = pk2(v[2], v[3]); *(u32x2*)p = w; }
__device__ __forceinline__ float sumsq4(f32x4 v) { return (v[0] * v[0] + v[1] * v[1]) + (v[2] * v[2] + v[3] * v[3]); }
__device__ __forceinline__ float red_fq(float s) { s += __shfl_xor(s, 16); s += __shfl_xor(s, 32); return s; }
__device__ __forceinline__ void rope_rot(f32x4& x1, f32x4& x2, const float* cs  ) {
    const f32x4 t0 = *(const f32x4*)cs, t1 = *(const f32x4*)(cs + 4);
    const f32x4 c = {t0[0], t0[2], t1[0], t1[2]}, s = {t0[1], t0[3], t1[1], t1[3]};
    const f32x4 y1 = x1 * c - x2 * s, y2 = x2 * c + x1 * s; x1 = y1; x2 = y2;
}

struct EpiLat {
    static constexpr bool PERM = true, ROWSCALE = true; static constexpr int NSTORE = 0;
    bf16_t* lat; float* slot24; const float* ssq; bf16_t* kb; const float* rope;
    __device__ __forceinline__ float rowscale(int row) const { return rstd16(ssq, row); }
    __device__ __forceinline__ void operator()(const AccT& acc, const GUnit& u, int wr, int wc, int fr, int fq, const LAS float* aux) const {
#pragma unroll
        for (int ai = 0; ai < 2; ++ai)
#pragma unroll
            for (int m = 0; m < 4; ++m) { const int row = u.pm * BM + ai * HALF + wr * 64 + m * 16 + fr; const float rs = aux[ai * HALF + wr * 64 + m * 16 + fr];
#pragma unroll
                for (int bj = 0; bj < 2; ++bj) { const int cb = u.pn * BM + bj * HALF + wc * 32;
                    f32x4 v0 = acc[ai][bj][m][0] * rs, v1 = acc[ai][bj][m][1] * rs;
                    if (cb < 640) { st_bf16x8(lat + (size_t)row * 768 + cb + 8 * fq, v0, v1);
                        const float ss = red_fq(sumsq4(v0) + sumsq4(v1)); if (fq == 0) slot24[(size_t)row * 24 + u.pn * 8 + bj * 4 + wc] = ss; }
                    else if (cb == 640) { rope_rot(v0, v1, rope + (size_t)row * 32 + 8 * fq);
                        u32x4 w; w.x = pk2(v0[0], v0[1]); w.y = pk2(v0[2], v0[3]); w.z = pk2(v1[0], v1[1]); w.w = pk2(v1[2], v1[3]);
                        bf16_t* kp = kb + (size_t)row * 1536 + 64 + 8 * fq;
#pragma unroll
                        for (int hh = 0; hh < NH; ++hh) *(u32x4*)(kp + hh * 96) = w; } } }
    }
};
struct EpiQ {
    static constexpr bool PERM = true, ROWSCALE = true; static constexpr int NSTORE = 0;
    bf16_t* q; const float* slot24; const float* rope;
    __device__ __forceinline__ float rowscale(int row) const { const f32x4* sp = (const f32x4*)(slot24 + (size_t)row * 24); const float ss = (hsum4(sp[0]) + hsum4(sp[1])) + hsum4(sp[2]); return 1.0f / sqrtf(ss * (1.0f / 384.0f) + RMS_EPS); }
    __device__ __forceinline__ void operator()(const AccT& acc, const GUnit& u, int wr, int wc, int fr, int fq, const LAS float* aux) const {
#pragma unroll
        for (int ai = 0; ai < 2; ++ai)
#pragma unroll
            for (int m = 0; m < 4; ++m) { const int row = u.pm * BM + ai * HALF + wr * 64 + m * 16 + fr;
                const float rs = aux[ai * HALF + wr * 64 + m * 16 + fr];
#pragma unroll
                for (int bj = 0; bj < 2; ++bj) { const int cb = u.pn * BM + bj * HALF + wc * 32; const int gb = cb >> 5;
                    f32x4 v0 = acc[ai][bj][m][0] * rs, v1 = acc[ai][bj][m][1] * rs;
                    if (gb % 3 == 2) rope_rot(v0, v1, rope + (size_t)row * 32 + 8 * fq);
                    st_bf16x8(q + (size_t)row * 1536 + cb + 8 * fq, v0, v1); } }
    }
};
struct EpiKV {
    static constexpr bool PERM = true, ROWSCALE = true; static constexpr int NSTORE = 0;
    bf16_t* kb; bf16_t* vb; const float* slot24;
    __device__ __forceinline__ float rowscale(int row) const { const f32x4* sp = (const f32x4*)(slot24 + (size_t)row * 24 + 12); const float ss = hsum4(sp[0]) + hsum4(sp[1]); return 1.0f / sqrtf(ss * (1.0f / 256.0f) + RMS_EPS); }
    __device__ __forceinline__ void operator()(const AccT& acc, const GUnit& u, int wr, int wc, int fr, int fq, const LAS float* aux) const {
#pragma unroll
        for (int ai = 0; ai < 2; ++ai)
#pragma unroll
            for (int m = 0; m < 4; ++m) { const int row = u.pm * BM + ai * HALF + wr * 64 + m * 16 + fr;
                const float rs = aux[ai * HALF + wr * 64 + m * 16 + fr];
#pragma unroll
                for (int bj = 0; bj < 2; ++bj) { const int head = u.pn * 2 + bj;
                    const f32x4 v0 = acc[ai][bj][m][0] * rs, v1 = acc[ai][bj][m][1] * rs;
                    bf16_t* p = (wc < 2) ? kb + (size_t)row * 1536 + head * 96 + wc * 32 + 8 * fq : vb + (size_t)row * 1024 + head * 64 + (wc - 2) * 32 + 8 * fq;
                    st_bf16x8(p, v0, v1); } }
    }
};
#ifndef HB_ONLY
#define HB_ONLY 0
#endif
__device__ __forceinline__ f32x4 hilo_ld(const bf16_t* hi, const bf16_t* lo, size_t off) { const u32x2 a = *(const u32x2*)(hi + off);
#if HB_ONLY
    (void)lo; return (f32x4){bflo(a.x), bfhi(a.x), bflo(a.y), bfhi(a.y)}; }
#else
    const u32x2 b = *(const u32x2*)(lo + off);
    return (f32x4){bflo(a.x) + bflo(b.x), bfhi(a.x) + bfhi(b.x), bflo(a.y) + bflo(b.y), bfhi(a.y) + bfhi(b.y)}; }
#endif
__device__ __forceinline__ void hilo_st(bf16_t* hi, bf16_t* lo, size_t off, f32x4 o) { u32x2 h; h.x = pk2(o[0], o[1]); h.y = pk2(o[2], o[3]);
#if HB_ONLY
    (void)lo; *(u32x2*)(hi + off) = h; }
#else
    const f32x4 r = o - (f32x4){bflo(h.x), bfhi(h.x), bflo(h.y), bfhi(h.y)}; u32x2 l; l.x = pk2(r[0], r[1]); l.y = pk2(r[2], r[3]); *(u32x2*)(hi + off) = h; *(u32x2*)(lo + off) = l; }
#endif
struct EpiRes {
    static constexpr bool PERM = false, ROWSCALE = false; static constexpr int NSTORE = 0;
    const float* basef; bf16_t* hb; bf16_t* lo; float* ssq; const float* colscale; unsigned char* x8; float ascale;
    __device__ __forceinline__ void operator()(const AccT& acc, const GUnit& u, int wr, int wc, int fr, int fq, const LAS float* aux) const {
#pragma unroll
        for (int ai = 0; ai < 2; ++ai)
#pragma unroll
            for (int m = 0; m < 4; ++m) { const int row = u.pm * BM + ai * HALF + wr * 64 + m * 16 + fr; float ss = 0.f;
#pragma unroll
                for (int bj = 0; bj < 2; ++bj)
#pragma unroll
                    for (int n = 0; n < 2; ++n) { const int col = u.pn * BM + bj * HALF + wc * 32 + n * 16 + 4 * fq; const size_t off = (size_t)row * D + col;
                        f32x4 a = acc[ai][bj][m][n] * ascale; if (colscale) a = a * *(const f32x4*)(colscale + col);
                        const f32x4 o = (basef ? *(const f32x4*)(basef + off) : hilo_ld(hb, lo, off)) + a; hilo_st(hb, lo, off, o); ss += sumsq4(o);
                        if (x8) *(unsigned*)(x8 + off) = pk_fp8x4(o[0], o[1], o[2], o[3]); }
                ss = red_fq(ss); if (fq == 0) ssq[(size_t)row * 16 + u.pn * 4 + wc] = ss; }
    }
};
template <bool MOE, bool F8 = false> struct EpiSwiglu {
    static constexpr bool PERM = true, ROWSCALE = true; static constexpr int NSTORE = 8;
    bf16_t* act; const float* rowsrc; int var; float rmul;
    __device__ __forceinline__ float rowscale(int row) const { return (MOE ? rowsrc[row] : rstd16(rowsrc, row)) * rmul; }
    __device__ __forceinline__ void operator()(const AccT& acc, const GUnit& u, int wr, int wc, int fr, int fq, const LAS float* aux) const {
        if (var == 1) return;
        char* blk = (char*)act + (size_t)__builtin_amdgcn_readfirstlane(u.pm * (FF / 128) + u.pn) * (F8 ? 32768 : 65536);
        const unsigned lo = F8 ? (unsigned)((wc * 256 + wr * 64 + fr) * 32 + fq * 8) : (unsigned)((wc * 256 + wr * 64 + fr) * 64 + fq * 16);
#pragma unroll
        for (int ai = 0; ai < 2; ++ai)
#pragma unroll
            for (int m = 0; m < 4; ++m) { const float rs = aux[ai * HALF + wr * 64 + m * 16 + fr];
                f32x4 o[2];
                const float ke = rs * -1.4426950408889634f, s2 = rs * rs * (F8 ? F8_SA : 1.f);
#pragma unroll
                for (int n = 0; n < 2; ++n) { const f32x4 t = acc[ai][0][m][n] * ke, gu = (acc[ai][0][m][n] * acc[ai][1][m][n]) * s2;
                    const f32x4 d = (f32x4){fast_exp2(t[0]), fast_exp2(t[1]), fast_exp2(t[2]), fast_exp2(t[3])} + 1.0f;
                    o[n] = gu * (f32x4){fast_rcp(d[0]), fast_rcp(d[1]), fast_rcp(d[2]), fast_rcp(d[3])}; }
                if constexpr (F8) { u32x2 q; q.x = pk_fp8x4(o[0][0], o[0][1], o[0][2], o[0][3]); q.y = pk_fp8x4(o[1][0], o[1][1], o[1][2], o[1][3]);
                    if (ACT_STORE_POL == 5) __builtin_nontemporal_store(q, (u32x2*)(blk + lo + (unsigned)((ai * HALF + m * 16) * 32))); else *(u32x2*)(blk + lo + (unsigned)((ai * HALF + m * 16) * 32)) = q; }
                else st_bf16x8_pol((bf16_t*)(blk + lo + (unsigned)((ai * HALF + m * 16) * 64)), o[0], o[1], ACT_STORE_POL); }
    }
};
struct EpiMoeDown {
    static constexpr bool PERM = true, ROWSCALE = true; static constexpr int NSTORE = 0;
    bf16_t* out; const float* rowgate; bf16_t* out2;
    __device__ __forceinline__ float rowscale(int row) const { return rowgate[row]; }
    __device__ __forceinline__ void operator()(const AccT& acc, const GUnit& u, int wr, int wc, int fr, int fq, const LAS float* aux) const {
#pragma unroll
        for (int ai = 0; ai < 2; ++ai)
#pragma unroll
            for (int m = 0; m < 4; ++m) { const int row = u.pm * BM + ai * HALF + wr * 64 + m * 16 + fr; const float g = aux[ai * HALF + wr * 64 + m * 16 + fr];
#pragma unroll
                for (int bj = 0; bj < 2; ++bj) st_bf16x8((u.kind == 1 ? out2 : out) + (size_t)row * D + u.pn * BM + bj * HALF + wc * 32 + 8 * fq, acc[ai][bj][m][0] * g, acc[ai][bj][m][1] * g); }
    }
};
template <bool GELU0, bool GELU1> struct EpiSplit2 {
    static constexpr bool PERM = true, ROWSCALE = true; static constexpr int NSTORE = 0;
    bf16_t* o0; bf16_t* o1; const float* ssq; float* lns;
    __device__ __forceinline__ float rowscale(int row) const { return rstd16(ssq, row); }
    __device__ __forceinline__ void operator()(const AccT& acc, const GUnit& u, int wr, int wc, int fr, int fq, const LAS float* aux) const {
        const bool second = u.pn >= 4; bf16_t* ob = second ? o1 : o0; const int ct = (u.pn & 3) * BM; const bool gl = second ? GELU1 : GELU0; const bool st = second && lns != nullptr;
#pragma unroll
        for (int ai = 0; ai < 2; ++ai)
#pragma unroll
            for (int m = 0; m < 4; ++m) { const int row = u.pm * BM + ai * HALF + wr * 64 + m * 16 + fr; const float rs = aux[ai * HALF + wr * 64 + m * 16 + fr]; float sm = 0.f, sq = 0.f;
#pragma unroll
                for (int bj = 0; bj < 2; ++bj) { f32x4 v0 = acc[ai][bj][m][0] * rs, v1 = acc[ai][bj][m][1] * rs;
                    if (gl) {
#pragma unroll
                        for (int i = 0; i < 4; ++i) { v0[i] = gelu_tanh_f(v0[i]); v1[i] = gelu_tanh_f(v1[i]); } }
                    st_bf16x8(ob + (size_t)row * D + ct + bj * HALF + wc * 32 + 8 * fq, v0, v1);
                    if (st) { const f32x4 t = v0 + v1; sm += (t[0] + t[1]) + (t[2] + t[3]); sq += sumsq4(v0) + sumsq4(v1); } }
                if (st) { sm = red_fq(sm); sq = red_fq(sq); if (fq == 0) { float* p0 = lns + (size_t)row * 16 + (u.pn & 3) * 4 + wc; p0[0] = sm; p0[(size_t)M * 16] = sq; } } }
    }
};
__device__ __forceinline__ float one_minus_exp(float x) {
    const float t = -x * (1.0f + x * (0.5f + x * 0.16666667f));
    const float e = 1.0f - fast_exp2(1.4426950408889634f * x); return x > -0.0078125f ? t : e;
}
struct EpiLruGate {
    static constexpr bool PERM = false, ROWSCALE = false, POST = true; static constexpr int NSTORE = 0;
    unsigned* ab; const bf16_t* xcb; const float* ba; const float* bx; const float* sp8; f32x2* carry;
    __device__ __forceinline__ void post(const GUnit& u, int tid) const {
        const int chunk = tid >> 7, c = u.pn * HALF + (tid & 127); const size_t r0 = (size_t)(u.pm * BM + chunk * 64);
        float A = 1.f, H = 0.f; const unsigned* p = ab + r0 * D + c;
#pragma unroll 1
        for (int t0 = 0; t0 < 64; t0 += 32) { unsigned w[32];
#pragma unroll
            for (int q = 0; q < 32; ++q) w[q] = p[(size_t)(t0 + q) * D];
#pragma unroll
            for (int q = 0; q < 32; ++q) { const float a = fast_exp2(bflo(w[q])), bb = bfhi(w[q]); A *= a; H = a * H + bb; } }
        carry[(r0 >> 6) * D + c] = (f32x2){A, H};
    }
    __device__ __forceinline__ void operator()(const AccT& acc, const GUnit& u, int wr, int wc, int fr, int fq, const LAS float* aux) const {
#pragma unroll
        for (int n = 0; n < 2; ++n) { const int c = u.pn * HALF + wc * 32 + n * 16 + 4 * fq;
            const f32x4 vba = *(const f32x4*)(ba + c), vbx = *(const f32x4*)(bx + c), vsp = *(const f32x4*)(sp8 + c);
#pragma unroll
            for (int ai = 0; ai < 2; ++ai)
#pragma unroll
                for (int m = 0; m < 4; ++m) { const int row = u.pm * BM + ai * HALF + wr * 64 + m * 16 + fr; const size_t off = (size_t)row * D + c;
                    const u32x2 xw = *(const u32x2*)(xcb + off); const f32x4 xc = {bflo(xw.x), bfhi(xw.x), bflo(xw.y), bfhi(xw.y)};
                    const f32x4 rp = acc[ai][0][m][n] + vba, ip = acc[ai][1][m][n] + vbx; f32x4 a, b;
#pragma unroll
                    for (int i = 0; i < 4; ++i) { const float la = -vsp[i] * sigmoid_f(rp[i]); a[i] = 1.4426950408889634f * la; b[i] = __builtin_amdgcn_sqrtf(one_minus_exp(2.0f * la)) * (sigmoid_f(ip[i]) * xc[i]); }
                    u32x4 w; w.x = pk2(a[0], b[0]); w.y = pk2(a[1], b[1]); w.z = pk2(a[2], b[2]); w.w = pk2(a[3], b[3]); *(u32x4*)(ab + off) = w; } }
    }
};
struct Args { const void* in[35]; float* out; unsigned char* ws; float* hsrc; int ph_lo, ph_hi; unsigned wmask, lmask; int nrep, pad; };
struct Frame {
    LAS unsigned char* lds; unsigned char* ws; const void* const* in; float* h;
    int tid, lane, wave, vcu, G, gw, NGW;
};
#define WSP(T, off) ((T*)(F.ws + (off)))
#define INF(i) ((const float*)F.in[i])

enum { MODE_ID = 0, MODE_GU = 1, MODE_ROPEQ = 2, MODE_ROPELAT = 3 };
struct Fam { const float* src; const float* g; bf16_t* dst; int Ksrc, Kdst, N, Npad, ldt, mode, row_off, ksrc_off; float scale; int f8; };
__device__ __forceinline__ int rope_pos(int d) { return 8 * ((d >> 2) & 3) + 4 * (d >> 4) + (d & 3); }
__device__ __forceinline__ int map_row(int mode, int n) {
    if (mode == MODE_GU) return ((n >> 7) << 8) + (n & 127);
    if (mode == MODE_ROPEQ) { const int head = n / 96, loc = n - head * 96; return loc >= 64 ? head * 96 + 64 + rope_pos(loc - 64) : n; }
    if (mode == MODE_ROPELAT) return (n >= 640 && n < 672) ? 640 + rope_pos(n - 640) : n;
    return n;
}
#if WLAYOUT
__device__ __forceinline__ void conv_item(const Fam& f, int item, int lane) {
    const int nblk = (f.Npad + 63) >> 6, kb = item / nblk, nb = item - kb * nblk, k0 = 64 * kb, n = nb * 64 + lane;
    float v[64];
    const bool okn = n < f.N;
#pragma unroll
    for (int r = 0; r < 64; ++r) { const int srow = k0 + r - f.ksrc_off; v[r] = 0.f; if (okn && srow >= 0 && srow < f.Ksrc) v[r] = f.src[(size_t)srow * f.N + n]; }
#pragma unroll
    for (int r = 0; r < 64; ++r) { const int srow = k0 + r - f.ksrc_off; const float gk = (f.g && srow >= 0 && srow < f.Ksrc) ? f.g[srow] * f.scale : f.scale; v[r] *= gk; }
    if (n < f.Npad) {
        const int drow = map_row(f.mode, n) + f.row_off;
        bf16_t* dp = f.dst + ((size_t)(drow >> 8) * (btile_bytes(f.Kdst) / 2)) + ((size_t)(8 * kb) * 256 + (drow & 255)) * 8;
#pragma unroll
        for (int q = 0; q < 8; ++q) { u32x4 o; o.x = pk2(v[8 * q + 0], v[8 * q + 1]); o.y = pk2(v[8 * q + 2], v[8 * q + 3]); o.z = pk2(v[8 * q + 4], v[8 * q + 5]); o.w = pk2(v[8 * q + 6], v[8 * q + 7]);
            *(u32x4*)(dp + (size_t)q * 2048) = o; } }
}
#else
#ifdef CONV_NT
#define CONV_LD(p) __builtin_nontemporal_load(p)
#else
#define CONV_LD(p) (*(p))
#endif
__device__ __forceinline__ void conv_load(const Fam& f, int item, int lane, f32x4 (&v)[16]) {
    const int nblk = f.Npad / 64, kb = item / nblk, nb = item - kb * nblk, k0 = 64 * kb, n0 = 64 * nb;
    const int col = n0 + 4 * (lane & 15);
#pragma unroll
    for (int i = 0; i < 16; ++i) { const int kk = 4 * i + (lane >> 4), srow = k0 + kk - f.ksrc_off;
        v[i] = (f32x4){0.f, 0.f, 0.f, 0.f};
        if (srow >= 0 && srow < f.Ksrc && col < f.N) v[i] = CONV_LD((const f32x4*)(f.src + (size_t)srow * f.N + col)); }
}
__device__ __forceinline__ void conv_store(const Fam& f, LAS float* scr, int item, int lane, const f32x4 (&v)[16]) {
    const int nblk = f.Npad / 64, kb = item / nblk, nb = item - kb * nblk, k0 = 64 * kb, n0 = 64 * nb;
#pragma unroll
    for (int i = 0; i < 16; ++i) { const int kk = 4 * i + (lane >> 4); LAS float* s = scr + kk * 65 + 4 * (lane & 15); s[0] = v[i][0]; s[1] = v[i][1]; s[2] = v[i][2]; s[3] = v[i][3]; }
    asm volatile("s_waitcnt lgkmcnt(0)" ::: "memory");
    const int c = lane & 7; float gk[8];
#pragma unroll
    for (int t = 0; t < 8; ++t) { const int srow = k0 + 8 * c + t - f.ksrc_off; gk[t] = (f.g && srow >= 0 && srow < f.Ksrc) ? f.g[srow] * f.scale : f.scale; }
#pragma unroll
    for (int j = 0; j < 8; ++j) { const int n = (lane >> 3) + 8 * j; const LAS float* s = scr + (8 * c) * 65 + n;
        u32x4 o; o.x = pk2(s[0 * 65] * gk[0], s[1 * 65] * gk[1]); o.y = pk2(s[2 * 65] * gk[2], s[3 * 65] * gk[3]); o.z = pk2(s[4 * 65] * gk[4], s[5 * 65] * gk[5]); o.w = pk2(s[6 * 65] * gk[6], s[7 * 65] * gk[7]);
        const int drow = map_row(f.mode, n0 + n) + f.row_off;
        if (f.f8) { u32x2 q; q.x = pk_fp8x4(s[0 * 65] * gk[0], s[1 * 65] * gk[1], s[2 * 65] * gk[2], s[3 * 65] * gk[3]); q.y = pk_fp8x4(s[4 * 65] * gk[4], s[5 * 65] * gk[5], s[6 * 65] * gk[6], s[7 * 65] * gk[7]);
            *(u32x2*)((char*)f.dst + (size_t)drow * f.ldt + k0 + 8 * c) = q; }
        else *(u32x4*)(f.dst + (size_t)drow * f.ldt + k0 + 8 * c) = o; }
    asm volatile("s_waitcnt lgkmcnt(0)" ::: "memory");
}
#endif
constexpr int NFAM = 17;
__device__ __forceinline__ int fam_count(int f) { return (f == 5 || f == 6) ? 8 : (f == 8) ? 4 : (f >= 11 && f <= 13) ? 2 : (f >= 14) ? 16 : 1; }
__device__ __forceinline__ Fam get_fam(const Frame& F, int f, int j) {
    Fam r; r.g = nullptr; r.mode = MODE_ID; r.row_off = 0; r.ksrc_off = 0; r.scale = 1.f; r.f8 = 0;
    const float* norm_mix = INF(2); const float* norm_ffn = INF(3);
    switch (f) {
    case 0: r.src = INF(5); r.g = norm_mix; r.dst = WSP(bf16_t, W_MLA_IN); r.Ksrc = r.Kdst = 1024; r.N = 672; r.Npad = 768; r.ldt = 768; r.mode = MODE_ROPELAT; break;
    case 1: r.src = INF(8); r.g = INF(6); r.dst = WSP(bf16_t, W_UQ); r.Ksrc = r.Kdst = 384; r.N = r.Npad = 1536; r.ldt = 1536; r.mode = MODE_ROPEQ; r.scale = 0.10206207261596575f * 1.4426950408889634f; break;
    case 2: r.src = INF(9); r.g = INF(7); r.dst = WSP(bf16_t, W_UKV); r.Ksrc = r.Kdst = 256; r.N = r.Npad = 2048; r.ldt = 2048; break;
    case 3: r.src = INF(10); r.dst = WSP(bf16_t, W_O); r.Ksrc = r.Kdst = 1024; r.N = r.Npad = 1024; r.ldt = 1024; break;
    case 4: r.src = INF(11); r.g = norm_mix + 1024; r.dst = WSP(bf16_t, W_LRU_IN); r.Ksrc = r.Kdst = 1024; r.N = r.Npad = 2048; r.ldt = 2048; break;
    case 5: case 6: r.src = INF(f == 5 ? 14 : 16) + (size_t)j * 16384; r.dst = WSP(bf16_t, W_LRU_G) + (size_t)j * (btile_bytes(256) / 2); r.Ksrc = 128; r.Kdst = 256; r.N = r.Npad = 128; r.ldt = 256; r.row_off = (f == 6) ? 128 : 0; r.ksrc_off = (j & 1) * 128; break;
    case 7: r.src = INF(19); r.dst = WSP(bf16_t, W_LRU_OUT); r.Ksrc = r.Kdst = 1024; r.N = r.Npad = 1024; r.ldt = 1024; break;
    case 8: r.src = INF(20) + (size_t)j * 65536; r.dst = WSP(bf16_t, W_POOL) + (size_t)j * (btile_bytes(256) / 2); r.Ksrc = r.Kdst = 256; r.N = r.Npad = 256; r.ldt = 256; break;
    case 9: r.src = INF(22); r.g = norm_mix + 3072; r.dst = WSP(bf16_t, W_GM_IN); r.Ksrc = r.Kdst = 1024; r.N = r.Npad = 2048; r.ldt = 2048; break;
    case 10: r.src = INF(27); r.dst = WSP(bf16_t, W_GM_OUT); r.Ksrc = r.Kdst = 1024; r.N = r.Npad = 1024; r.ldt = 1024; break;
    case 11: case 12: r.src = INF(f == 11 ? 28 : 29) + (size_t)j * D * FF; r.g = norm_ffn + 2048 * j; r.dst = (bf16_t*)(F.ws + W_FFN + (size_t)j * WSTRIDE); r.Ksrc = r.Kdst = 1024; r.N = r.Npad = FF; r.ldt = 2 * FF; r.mode = MODE_GU; r.row_off = (f == 12) ? 128 : 0; if (ffn_f8(j)) { r.f8 = 1; r.scale = F8_SW; } break;
    case 13: r.src = INF(30) + (size_t)j * D * FF; r.dst = (bf16_t*)(F.ws + W_FFN + (size_t)j * WSTRIDE + WDOWN_OFF); r.Ksrc = r.Kdst = FF; r.N = r.Npad = 1024; r.ldt = 1024; if (ffn_f8(j)) { r.f8 = 1; r.scale = F8_SW; } break;
    case 14: case 15: r.src = INF(f == 14 ? 32 : 33) + (size_t)j * D * FF; r.g = norm_ffn + 1024 + 2048 * (j >> 3); r.dst = (bf16_t*)(F.ws + W_MOE + (size_t)j * WSTRIDE); r.Ksrc = r.Kdst = 1024; r.N = r.Npad = FF; r.ldt = 2 * FF; r.mode = MODE_GU; r.row_off = (f == 15) ? 128 : 0; if (moe_f8(j >> 3)) { r.f8 = 1; r.scale = F8_SW; } break;
    default: r.src = INF(34) + (size_t)j * D * FF; r.dst = (bf16_t*)(F.ws + W_MOE + (size_t)j * WSTRIDE + WDOWN_OFF); r.Ksrc = r.Kdst = FF; r.N = r.Npad = 1024; r.ldt = 1024; if (moe_f8(j >> 3)) { r.f8 = 1; r.scale = F8_SW; } break;
    }
#if !WLAYOUT
    r.ldt = r.Kdst + BPAD;
#endif
    return r;
}
__device__ __forceinline__ void stats_row(const Frame& F, const float* src, int row, float* rstd_out) {
    const f32x4* xr = (const f32x4*)(src + (size_t)row * D) + F.lane; f32x4 v[4]; float s = 0.f;
#pragma unroll
    for (int j = 0; j < 4; ++j) { v[j] = xr[64 * j]; s += sumsq4(v[j]); }
    s = wave_sum(s);
    bf16_t* hb = WSP(bf16_t, WS_HB) + (size_t)row * D + 4 * F.lane;
#pragma unroll
    for (int j = 0; j < 4; ++j) st_bf16x4(hb + 256 * j, v[j]);
    if (F.lane < 16) WSP(float, WS_SSQ)[(size_t)row * 16 + F.lane] = F.lane == 0 ? s : 0.f;
    if (rstd_out && F.lane == 0) rstd_out[row] = 1.0f / sqrtf(s * (1.0f / 1024.0f) + RMS_EPS);
}
__device__ __forceinline__ void phase_prologue(const Frame& F, unsigned wmask, unsigned lmask, const float* hsrc) {
#if WLAYOUT
    int base = 0;
    for (int f = 0; f < NFAM; ++f) { if (!((wmask >> f) & 1u)) continue;
        const int cnt = fam_count(f);
        for (int j = 0; j < cnt; ++j) {
            if (f >= 11 && f <= 13 && !((lmask >> j) & 1u)) continue;
            if (f >= 14 && !((lmask >> (2 + (j >> 3))) & 1u)) continue;
            const Fam fm = get_fam(F, f, j); const int nitems = (fm.Kdst / 64) * ((fm.Npad + 63) >> 6);
            for (int it = (F.gw + F.NGW - base % F.NGW) % F.NGW; it < nitems; it += F.NGW) conv_item(fm, it, F.lane);
            base += nitems; } }
#else
    { LAS float* scr = (LAS float*)(F.lds + F.wave * 16640);
      int cf = -1, cj = 0, cbase = 0, cn = 0; Fam cfm;
      auto seek = [&](int g) -> bool {
          while (cf < NFAM && (cf < 0 || g >= cbase + cn)) {
              if (cf >= 0) { cbase += cn; ++cj; if (cj >= fam_count(NFAM - 1 - cf)) { ++cf; cj = 0; } } else { cf = 0; cj = 0; }
              cn = 0;
              while (cf < NFAM) { const int rf = NFAM - 1 - cf;
                  const bool en = ((wmask >> rf) & 1u) && !(rf >= 11 && rf <= 13 && !((lmask >> cj) & 1u)) && !(rf >= 14 && !((lmask >> (2 + (cj >> 3))) & 1u));
                  if (en) break; ++cj; if (cj >= fam_count(rf)) { ++cf; cj = 0; } }
              if (cf < NFAM) { cfm = get_fam(F, NFAM - 1 - cf, cj); cn = (cfm.Kdst / 64) * (cfm.Npad / 64); } }
          return cf < NFAM; };
      f32x4 va[16], vb[16]; Fam fa, fb; int ia = 0, ib = 0; int p = F.gw;
      bool ha = seek(2 * p); if (ha) { fa = cfm; ia = 2 * p - cbase; conv_load(fa, ia, F.lane, va); }
      while (ha) {
          const bool hb = seek(2 * p + 1); if (hb) { fb = cfm; ib = 2 * p + 1 - cbase; conv_load(fb, ib, F.lane, vb); }
          conv_store(fa, scr, ia, F.lane, va);
          p += F.NGW;
          ha = seek(2 * p); if (ha) { fa = cfm; ia = 2 * p - cbase; conv_load(fa, ia, F.lane, va); }
          if (hb) conv_store(fb, scr, ib, F.lane, vb); } }
#endif
    const int gt = F.vcu * NTHR + F.tid, NT = F.G * NTHR;
    if ((wmask >> 17) & 1u) {
        for (int i = gt; i < M * 16; i += NT) { const int row = i >> 4, j = i & 15; const float inv = powf(10000.0f, -(float)j / 16.0f); const float ang = (float)((const int*)F.in[1])[row] * inv;
            WSP(float, WS_ROPE)[2 * i] = cosf(ang); WSP(float, WS_ROPE)[2 * i + 1] = sinf(ang); }
        for (int i = gt; i < D; i += NT) WSP(float, WS_SP8)[i] = 8.0f * log1pf(expf(-INF(18)[i]));
        for (int i = gt; i < 2 * D * NE; i += NT) { const int l = i / (D * NE), c = (i / NE) % D; WSP(float, WS_ROUTW)[i] = INF(3)[(1 + 2 * l) * D + c] * INF(31)[i]; }
        for (int i = gt; i < 4 * 128 * 128; i += NT) { const int t = (i >> 7) & 127, s = i & 127; WSP(bf16_t, W_GM_S)[i] = (bf16_t)(pk2(s <= t ? INF(25)[i] : 0.f, 0.f) & 0xffffu); }
    }
    if (hsrc) for (int rb = F.gw; rb < M; rb += 4 * F.NGW) {
        f32x4 v[4][4];
#pragma unroll
        for (int q = 0; q < 4; ++q) { const int row = (rb + q * F.NGW) < M ? (rb + q * F.NGW) : rb; const f32x4* xr = (const f32x4*)(hsrc + (size_t)row * D) + F.lane;
#pragma unroll
            for (int jj = 0; jj < 4; ++jj) v[q][jj] = __builtin_nontemporal_load(xr + 64 * jj); }
#pragma unroll
        for (int q = 0; q < 4; ++q) { const int row = rb + q * F.NGW; if (row < M) { float sq = 0.f;
#pragma unroll
            for (int jj = 0; jj < 4; ++jj) sq += sumsq4(v[q][jj]);
            sq = wave_sum(sq);
            bf16_t* hb = WSP(bf16_t, WS_HB) + (size_t)row * D + 4 * F.lane;
#pragma unroll
            for (int jj = 0; jj < 4; ++jj) st_bf16x4(hb + 256 * jj, v[q][jj]);
            if (F.lane < 16) WSP(float, WS_SSQ)[(size_t)row * 16 + F.lane] = F.lane == 0 ? sq : 0.f;
            if (F.lane == 0) WSP(float, WS_RSTD)[row] = 1.0f / sqrtf(sq * (1.0f / 1024.0f) + RMS_EPS); } } }
}

__device__ __forceinline__ void phase_conv(const Frame& F) {
    const bf16_t* xbr = WSP(bf16_t, B_XBR); bf16_t* xcb = WSP(bf16_t, B_XCB); const float* cw = INF(12); const float* cb = INF(13);
    const int gt = F.vcu * NTHR + F.tid, NT = F.G * NTHR;
    for (int i = gt; i < (M / 4) * (D / 8); i += NT) { const int r0 = (i >> 7) * 4, c = (i & 127) * 8, t0 = r0 & (S - 1);
        u32x4 w[7];
#pragma unroll
        for (int q = 0; q < 7; ++q) { w[q] = (u32x4){0u, 0u, 0u, 0u}; if (t0 - 3 + q >= 0) w[q] = *(const u32x4*)(xbr + (size_t)(r0 - 3 + q) * D + c); }
        f32x4 wv[4][2]; const f32x4 b0 = *(const f32x4*)(cb + c), b1 = *(const f32x4*)(cb + c + 4);
#pragma unroll
        for (int jj = 0; jj < 4; ++jj) { wv[jj][0] = *(const f32x4*)(cw + jj * D + c); wv[jj][1] = *(const f32x4*)(cw + jj * D + c + 4); }
#pragma unroll
        for (int rr = 0; rr < 4; ++rr) { f32x4 a0 = b0, a1 = b1;
#pragma unroll
            for (int jj = 0; jj < 4; ++jj) { const u32x4 x = w[rr + jj];
                a0 += wv[jj][0] * (f32x4){bflo(x.x), bfhi(x.x), bflo(x.y), bfhi(x.y)}; a1 += wv[jj][1] * (f32x4){bflo(x.z), bfhi(x.z), bflo(x.w), bfhi(x.w)}; }
            u32x4 o; o.x = pk2(a0[0], a0[1]); o.y = pk2(a0[2], a0[3]); o.z = pk2(a1[0], a1[1]); o.w = pk2(a1[2], a1[3]);
            *(u32x4*)(xcb + (size_t)(r0 + rr) * D + c) = o; } }
}
__device__ __forceinline__ void phase_scan1(const Frame& F) {
    const unsigned* ab = WSP(unsigned, B_AF); f32x2* carry = WSP(f32x2, WS_CARRY);
    const int gt = F.vcu * NTHR + F.tid, NT = F.G * NTHR;
    for (int i = gt; i < NB * 64 * D; i += NT) { const int c = i & (D - 1), ch = (i >> 10) & 63, b = i >> 16; const size_t r0 = ((size_t)b * S + ch * 64) * D + c;
        float A = 1.f, H = 0.f;
#pragma unroll 8
        for (int t = 0; t < 64; ++t) { const unsigned w = ab[r0 + (size_t)t * D]; const float a = fast_exp2(bflo(w)), bb = bfhi(w); A *= a; H = a * H + bb; }
        carry[i] = (f32x2){A, H}; }
}
__device__ __forceinline__ void phase_scan2(const Frame& F) {
    const u32x2* ab = WSP(u32x2, B_AF); const f32x4* carry = WSP(f32x4, WS_CARRY);
    const unsigned* gate = WSP(unsigned, B_GATEB); unsigned* yb = WSP(unsigned, B_YB);
    const int gt = F.vcu * NTHR + F.tid, NT = F.G * NTHR;
    for (int i = gt; i < NB * 64 * (D / 2); i += NT) { const int c2 = i & (D / 2 - 1), ch = (i >> 9) & 63, b = i >> 15; const size_t r0 = (((size_t)b * S + ch * 64) * D) / 2 + c2;
        float H0 = 0.f, H1 = 0.f;
        for (int k0 = 0; k0 < ch; k0 += 16) { f32x4 cv[16];
#pragma unroll
            for (int q = 0; q < 16; ++q) { const int k = (k0 + q) < 63 ? (k0 + q) : 63; cv[q] = carry[((size_t)(b * 64 + k) * D) / 2 + c2]; }
#pragma unroll
            for (int q = 0; q < 16; ++q) if (k0 + q < ch) { H0 = cv[q][0] * H0 + cv[q][1]; H1 = cv[q][2] * H1 + cv[q][3]; } }
#pragma unroll 1
        for (int t0 = 0; t0 < 64; t0 += 16) { u32x2 w[16]; unsigned g[16];
#pragma unroll
            for (int q = 0; q < 16; ++q) { const size_t o = r0 + (size_t)(t0 + q) * (D / 2); w[q] = ab[o]; g[q] = gate[o]; }
#pragma unroll
            for (int q = 0; q < 16; ++q) { const size_t o = r0 + (size_t)(t0 + q) * (D / 2);
                H0 = fast_exp2(bflo(w[q].x)) * H0 + bfhi(w[q].x); H1 = fast_exp2(bflo(w[q].y)) * H1 + bfhi(w[q].y);
                yb[o] = pk2(H0 * bflo(g[q]), H1 * bfhi(g[q])); } }
    }
}
__device__ __forceinline__ void phase_router(const Frame& F, int l) {
    const float* rw = WSP(float, WS_ROUTW) + (size_t)l * D * NE; const bf16_t* hhi = WSP(bf16_t, WS_HB); const bf16_t* hlo = WSP(bf16_t, WS_LO);
    LAS int* se = (LAS int*)F.lds;
    unsigned* gcnt = WSP(unsigned, WS_CTL) + CW_MOECNT + 64 * l;
    const int tpw = (M + F.G - 1) / F.G;
    const int t0 = (int)blockIdx.x * tpw;
    f32x4 w0[4][4], w1[4][4];
#pragma unroll
    for (int j = 0; j < 4; ++j)
#pragma unroll
        for (int i = 0; i < 4; ++i) { const int c = 256 * j + 4 * F.lane + i; w0[j][i] = *(const f32x4*)(rw + (size_t)c * 8); w1[j][i] = *(const f32x4*)(rw + (size_t)c * 8 + 4); }
    for (int kb = F.wave; kb < tpw; kb += 4 * NWAVES) {
        f32x4 xs[4][4];
#pragma unroll
        for (int q = 0; q < 4; ++q) { const int k = kb + q * NWAVES; const int tok = (k < tpw && t0 + k < M) ? t0 + k : t0;
#pragma unroll
            for (int j = 0; j < 4; ++j) xs[q][j] = hilo_ld(hhi, hlo, (size_t)tok * D + 256 * j + 4 * F.lane); }
#pragma unroll
        for (int q = 0; q < 4; ++q) { const int k = kb + q * NWAVES; const int tok = t0 + k; if (k < tpw && tok < M) {
        float s[8];
#pragma unroll
        for (int e = 0; e < 8; ++e) s[e] = 0.f;
        float ss = 0.f;
#pragma unroll
        for (int j = 0; j < 4; ++j) { const f32x4 x = xs[q][j]; ss += sumsq4(x);
#pragma unroll
            for (int i = 0; i < 4; ++i) { const f32x4 a0 = w0[j][i], a1 = w1[j][i];
                s[0] += x[i] * a0[0]; s[1] += x[i] * a0[1]; s[2] += x[i] * a0[2]; s[3] += x[i] * a0[3]; s[4] += x[i] * a1[0]; s[5] += x[i] * a1[1]; s[6] += x[i] * a1[2]; s[7] += x[i] * a1[3]; } }
        ss = wave_sum(ss);
#pragma unroll
        for (int e = 0; e < 8; ++e) s[e] = wave_sum(s[e]);
        const float rs = 1.0f / sqrtf(ss * (1.0f / 1024.0f) + RMS_EPS);
        int e1 = 0; float v1 = s[0];
#pragma unroll
        for (int e = 1; e < 8; ++e) if (s[e] > v1) { v1 = s[e]; e1 = e; }
        int e2 = 0; float v2 = -INFINITY;
#pragma unroll
        for (int e = 0; e < 8; ++e) if (e != e1 && s[e] > v2) { v2 = s[e]; e2 = e; }
        const float g1 = 1.0f / (1.0f + expf((v2 - v1) * rs));
        if (F.lane == 0) { se[2 * k] = e1; se[2 * k + 1] = e2; WSP(f32x2, WS_TOKG)[tok] = (f32x2){g1, 1.0f - g1}; WSP(float, WS_RSTD)[tok] = rs; }
        } }
    }
    __syncthreads();
    if (F.wave == 0) { const int tok = t0 + F.lane; const bool valid = F.lane < tpw && tok < M;
        const int e1 = valid ? se[2 * F.lane] : -1, e2 = valid ? se[2 * F.lane + 1] : -1; int lr1 = 0, lr2 = 0;
        const unsigned long long lt = (1ull << F.lane) - 1ull;
#pragma unroll
        for (int e = 0; e < 8; ++e) { const unsigned long long m1 = __ballot(e1 == e), m2 = __ballot(e2 == e);
            const int before = __popcll(m1 & lt) + __popcll(m2 & lt); if (e1 == e) lr1 = before; if (e2 == e) lr2 = before;
            const int tot = __popcll(m1) + __popcll(m2);
            if (F.lane == e) { if (tot) (void)__hip_atomic_fetch_add(gcnt + e, (unsigned)tot, __ATOMIC_RELAXED, __HIP_MEMORY_SCOPE_AGENT); WSP(int, WS_WGBASE)[blockIdx.x * 8 + e] = tot; } }
        if (valid) { int* ti = WSP(int, WS_TOKINFO) + 4 * (size_t)tok; ti[0] = e1; ti[1] = lr1; ti[2] = e2; ti[3] = lr2; }
    }
    __syncthreads();
}
__device__ __forceinline__ int moe_layout(const Frame& F, int l, int* pstart_rows, int* pend) {
    const unsigned* gcnt = WSP(unsigned, WS_CTL) + CW_MOECNT + 64 * l; int p = 0;
#pragma unroll
    for (int e = 0; e < NE; ++e) { const int c = (int)__hip_atomic_load(gcnt + e, __ATOMIC_RELAXED, __HIP_MEMORY_SCOPE_AGENT); pstart_rows[e] = p * 256; p += (c + 255) >> 8; pend[e] = p; }
    return p;
}
__device__ __forceinline__ void phase_gather(const Frame& F, int l) {
    int ps[NE], pe[NE]; (void)moe_layout(F, l, ps, pe);
    const int tpw = (M + F.G - 1) / F.G;
    LAS int* lbase = (LAS int*)F.lds;
    { const int e = F.wave; int v[4]; int run = 0;
#pragma unroll
      for (int q = 0; q < 4; ++q) { const int w = 4 * F.lane + q; v[q] = w < F.G ? WSP(int, WS_WGBASE)[w * 8 + e] : 0; }
      const int tot4 = (v[0] + v[1]) + (v[2] + v[3]); int incl = tot4;
#pragma unroll
      for (int o = 1; o < 64; o <<= 1) { const int t = __shfl_up(incl, o); if (F.lane >= o) incl += t; }
      run = incl - tot4;
#pragma unroll
      for (int q = 0; q < 4; ++q) { const int w = 4 * F.lane + q; if (w < F.G) lbase[w * 8 + e] = run; run += v[q]; } }
    __syncthreads();
    int* rowtok = WSP(int, WS_ROWTOK);
    constexpr int NTB = 4;
    for (int tb = F.gw; tb < M; tb += NTB * F.NGW) {
        int e1v[NTB], l1v[NTB], e2v[NTB], l2v[NTB];
#pragma unroll
        for (int q = 0; q < NTB; ++q) { const int tok = (tb + q * F.NGW) < M ? (tb + q * F.NGW) : tb; const int* ti = WSP(int, WS_TOKINFO) + 4 * (size_t)tok; e1v[q] = ti[0]; l1v[q] = ti[1]; e2v[q] = ti[2]; l2v[q] = ti[3]; }
        u32x4 av[NTB], bv[NTB]; float rsv[NTB]; f32x2 gv[NTB];
#pragma unroll
        for (int q = 0; q < NTB; ++q) { const int tok = (tb + q * F.NGW) < M ? (tb + q * F.NGW) : tb;
            const u32x4* src = (const u32x4*)(WSP(bf16_t, WS_HB) + (size_t)tok * D) + F.lane; av[q] = src[0]; bv[q] = src[64]; rsv[q] = WSP(float, WS_RSTD)[tok]; gv[q] = WSP(f32x2, WS_TOKG)[tok]; }
#pragma unroll
        for (int q = 0; q < NTB; ++q) { const int tok = tb + q * F.NGW; if (tok < M) { const int wg = tok / tpw;
        const int e1 = e1v[q], lr1 = l1v[q], e2 = e2v[q], lr2 = l2v[q];
        int d1 = 0, d2 = 0;
#pragma unroll
        for (int e = 0; e < NE; ++e) { const int b = lbase[wg * 8 + e]; if (e == e1) d1 = ps[e] + b + lr1; if (e == e2) d2 = ps[e] + b + lr2; }
#if !MUP_GATHER
        { const u32x4 a = av[q], b = bv[q]; bf16_t* xg = WSP(bf16_t, B_XG);
          if (moe_f8(l)) {
              const float qs = rsv[q] * F8_SX; u32x2 pa, pb;
              pa.x = pk_fp8x4(bflo(a.x) * qs, bfhi(a.x) * qs, bflo(a.y) * qs, bfhi(a.y) * qs); pa.y = pk_fp8x4(bflo(a.z) * qs, bfhi(a.z) * qs, bflo(a.w) * qs, bfhi(a.w) * qs);
              pb.x = pk_fp8x4(bflo(b.x) * qs, bfhi(b.x) * qs, bflo(b.y) * qs, bfhi(b.y) * qs); pb.y = pk_fp8x4(bflo(b.z) * qs, bfhi(b.z) * qs, bflo(b.w) * qs, bfhi(b.w) * qs);
              u32x2* o1 = (u32x2*)((char*)xg + (size_t)d1 * D) + F.lane; u32x2* o2 = (u32x2*)((char*)xg + (size_t)d2 * D) + F.lane; o1[0] = pa; o1[64] = pb; o2[0] = pa; o2[64] = pb;
          } else {
          u32x4* o1 = (u32x4*)(xg + (size_t)d1 * D) + F.lane; u32x4* o2 = (u32x4*)(xg + (size_t)d2 * D) + F.lane; o1[0] = a; o1[64] = b; o2[0] = a; o2[64] = b; } }
#endif
        if (F.lane == 0) { const f32x2 g = gv[q]; const float rs = rsv[q];
            rowtok[d1] = tok; rowtok[d2] = tok;
            const float rsc = moe_f8(l) ? 1.f / (F8_SX * F8_SW) : rs, gsc = moe_f8(l) ? 1.f / (F8_SA * F8_SW) : 1.f;
            WSP(float, WS_ROWSCALE)[d1] = rsc; WSP(float, WS_ROWSCALE)[d2] = rsc; WSP(float, WS_ROWGATE)[d1] = g.x * gsc; WSP(float, WS_ROWGATE)[d2] = g.y * gsc;
            WSP(int, WS_DEST)[2 * tok] = d1; WSP(int, WS_DEST)[2 * tok + 1] = d2; }
        } }
    }
    if (blockIdx.x < NE) {
        const int e = (int)blockIdx.x; const int cnt = (int)__hip_atomic_load(WSP(unsigned, WS_CTL) + CW_MOECNT + 64 * l + e, __ATOMIC_RELAXED, __HIP_MEMORY_SCOPE_AGENT);
        int pse = 0, pee = 0;
#pragma unroll
        for (int k = 0; k < NE; ++k) if (k == e) { pse = ps[k]; pee = pe[k] * 256; }
        for (int r = pse + cnt + F.tid; r < pee; r += NTHR) { rowtok[r] = 0; WSP(float, WS_ROWSCALE)[r] = 0.f; WSP(float, WS_ROWGATE)[r] = 0.f; } }
}
__device__ __forceinline__ unsigned sk_split_mask(const Frame& F, int l) {
#if MDN_STREAMK
    if (F.G != 256) return 0u;
    int ps[NE], pe[NE]; const int NP = moe_layout(F, l, ps, pe); const int P = moe_f8(l) ? FF / 256 : FF / 128, T = ((NP + 7) >> 3) * P; unsigned m = 0u;
#pragma unroll
    for (int x = 1; x < 8; ++x) { const int s = (x * T) >> 3; if (s % P) m |= 1u << (s / P); }
    return m;
#else
    return 0u;
#endif
}
template <bool FINAL> __device__ __forceinline__ void phase_combine(const Frame& F, const float oscale, const int l) {
    const bf16_t* om = WSP(bf16_t, B_OUTM); const bf16_t* om2 = (const bf16_t*)(F.ws + WS_SK); const float* gfin = INF(4);
#ifdef SK_E1
    const unsigned smask = 0u; (void)l;
#else
    const unsigned smask = sk_split_mask(F, l);
#endif
    constexpr int NTB = 4; static_assert(HB_ONLY, "the batched combine reads the stream as the bf16 half alone");
    f32x4 gf[4];
#pragma unroll
    for (int jj = 0; jj < 4; ++jj) gf[jj] = FINAL ? *(const f32x4*)(gfin + 256 * jj + 4 * F.lane) : (f32x4){0.f, 0.f, 0.f, 0.f};
    for (int tb = F.gw; tb < M; tb += NTB * F.NGW) {
        int d1[NTB], d2[NTB]; bool s1[NTB], s2[NTB];
#pragma unroll
        for (int q = 0; q < NTB; ++q) { const int tok = (tb + q * F.NGW) < M ? (tb + q * F.NGW) : tb;
            const int* ti = WSP(int, WS_TOKINFO) + 4 * (size_t)tok; const int e1 = ti[0], e2 = ti[2]; int a = WSP(int, WS_DEST)[2 * tok], b = WSP(int, WS_DEST)[2 * tok + 1];
            if (e2 < e1) { const int t = a; a = b; b = t; }
            d1[q] = a; d2[q] = b; s1[q] = ((smask >> (a >> 11)) & 1u) != 0u; s2[q] = ((smask >> (b >> 11)) & 1u) != 0u; }
        u32x2 xr[NTB][4], ar[NTB][4], br[NTB][4], a2r[NTB][4], b2r[NTB][4];
#pragma unroll
        for (int q = 0; q < NTB; ++q) { const int tok = (tb + q * F.NGW) < M ? (tb + q * F.NGW) : tb;
            const bf16_t* pa2 = s1[q] ? om2 : om; const bf16_t* pb2 = s2[q] ? om2 : om;
#pragma unroll
            for (int jj = 0; jj < 4; ++jj) { const int c = 256 * jj + 4 * F.lane;
                xr[q][jj] = *(const u32x2*)(WSP(bf16_t, WS_HB) + (size_t)tok * D + c);
                ar[q][jj] = *(const u32x2*)(om + (size_t)d1[q] * D + c); br[q][jj] = *(const u32x2*)(om + (size_t)d2[q] * D + c);
                a2r[q][jj] = *(const u32x2*)(pa2 + (size_t)d1[q] * D + c); b2r[q][jj] = *(const u32x2*)(pb2 + (size_t)d2[q] * D + c); } }
#pragma unroll
        for (int q = 0; q < NTB; ++q) { const int tok = tb + q * F.NGW; if (tok < M) {
            f32x4 v[4]; float s = 0.f;
#pragma unroll
            for (int jj = 0; jj < 4; ++jj) { const u32x2 x = xr[q][jj], a = ar[q][jj], b = br[q][jj], a2 = s1[q] ? a2r[q][jj] : (u32x2){0u, 0u}, b2 = s2[q] ? b2r[q][jj] : (u32x2){0u, 0u};
                const f32x4 ya = (f32x4){bflo(a.x), bfhi(a.x), bflo(a.y), bfhi(a.y)} + (f32x4){bflo(a2.x), bfhi(a2.x), bflo(a2.y), bfhi(a2.y)};
                const f32x4 yb = (f32x4){bflo(b.x), bfhi(b.x), bflo(b.y), bfhi(b.y)} + (f32x4){bflo(b2.x), bfhi(b2.x), bflo(b2.y), bfhi(b2.y)};
                v[jj] = (f32x4){bflo(x.x), bfhi(x.x), bflo(x.y), bfhi(x.y)} + (ya + yb); s += sumsq4(v[jj]); }
            s = wave_sum(s); const float rs = 1.0f / sqrtf(s * (1.0f / 1024.0f) + RMS_EPS);
            if (FINAL) {
#pragma unroll
                for (int jj = 0; jj < 4; ++jj) { const int c = 256 * jj + 4 * F.lane; __builtin_nontemporal_store(v[jj] * (rs * oscale) * gf[jj], (f32x4*)(F.h + (size_t)tok * D + c)); }
            } else {
#pragma unroll
                for (int jj = 0; jj < 4; ++jj) { const int c = 256 * jj + 4 * F.lane; hilo_st(WSP(bf16_t, WS_HB), WSP(bf16_t, WS_LO), (size_t)tok * D + c, v[jj]); }
                if (F.lane < 16) WSP(float, WS_SSQ)[(size_t)tok * 16 + F.lane] = F.lane == 0 ? s : 0.f;
                if (F.lane == 0) WSP(float, WS_RSTD)[tok] = rs;
            } } }
    }
}
__device__ __forceinline__ void phase_pool(const Frame& F) {
    const float* rstd = WSP(float, WS_RSTD); const float* g = INF(2) + 2 * D; bf16_t* po = WSP(bf16_t, B_POOLED);
    const int gt = F.vcu * NTHR + F.tid, NT = F.G * NTHR;
    for (int i = gt; i < (M / 32) * (D / 4); i += NT) { const int c = (i & 255) * 4, rb = (i >> 8) * 32, t0 = rb & (S - 1); const int w = 2 << (c >> 8);
        const f32x4 gv = *(const f32x4*)(g + c); f32x4 sum = {0.f, 0.f, 0.f, 0.f};
        const int warm = t0 < w - 1 ? t0 : w - 1;
        const bf16_t* hhi = WSP(bf16_t, WS_HB); const bf16_t* hlo = WSP(bf16_t, WS_LO);
        for (int k = warm; k >= 1; --k) sum += hilo_ld(hhi, hlo, (size_t)(rb - k) * D + c) * rstd[rb - k];
#pragma unroll 1
        for (int r0 = 0; r0 < 32; r0 += 8) { f32x4 sv[8], ov[8];
#pragma unroll
            for (int q = 0; q < 8; ++q) { const int row = rb + r0 + q; const bool has = t0 + r0 + q + 1 >= w; const int ro = has ? row - w + 1 : row;
                sv[q] = hilo_ld(hhi, hlo, (size_t)row * D + c) * rstd[row]; ov[q] = hilo_ld(hhi, hlo, (size_t)ro * D + c) * (has ? rstd[ro] : 0.f); }
#pragma unroll
            for (int q = 0; q < 8; ++q) { const int row = rb + r0 + q, t = t0 + r0 + q; sum += sv[q];
                const int n = t + 1 < w ? t + 1 : w;
                const f32x4 o = (sum * (1.0f / (float)n) - sv[q]) * gv; st_bf16x4(po + (size_t)row * D + c, o);
                sum -= ov[q]; } }
    }
}
typedef short v4i16_t __attribute__((ext_vector_type(4)));
__device__ __forceinline__ int crow(int r, int hi) { return (r & 3) + 8 * (r >> 2) + 4 * hi; }
__device__ __forceinline__ s16x4 vtr(const LAS unsigned char* p) { return __builtin_bit_cast(s16x4, __builtin_amdgcn_ds_read_tr16_b64_v4i16((LAS v4i16_t*)p)); }
__device__ __forceinline__ bf16x8 pack8(const f32x16& p, int b) { u32x4 w; w.x = pk2(p[b], p[b + 1]); w.y = pk2(p[b + 2], p[b + 3]); w.z = pk2(p[b + 4], p[b + 5]); w.w = pk2(p[b + 6], p[b + 7]); return __builtin_bit_cast(bf16x8, w); }
__device__ __forceinline__ void glds16s(const char* base  , unsigned voff, unsigned lds_dst  ) { unsigned keep;
    asm volatile("s_mov_b32 %0, m0\n\ts_mov_b32 m0, %3\n\ts_nop 0\n\tglobal_load_lds_dwordx4 %1, %2\n\ts_mov_b32 m0, %0" : "=&s"(keep) : "v"(voff), "s"(base), "s"(lds_dst) : "memory"); }
#ifndef ATT_THR
#define ATT_THR 8.0f
#endif
constexpr int AT_KROW = 208, AT_KBYTES = 13 * 1024  , AT_VBYTES = 8192, AT_KOFF = 0, AT_VOFF = 3 * AT_KBYTES, AT_WSF = 3 * AT_KBYTES + 3 * AT_VBYTES;
__device__ __forceinline__ void attn_unit(const Frame& F, int bh, int qb, const int att_var) {
    const int b = bh >> 4, h = bh & 15, lane = F.lane, r = lane & 31, hh = lane >> 5, wid = F.wave, tid = F.tid;
    const bf16_t* Q = WSP(bf16_t, B_Q); const bf16_t* KB = WSP(bf16_t, B_KB); const bf16_t* VB = WSP(bf16_t, B_VB); bf16_t* OB = WSP(bf16_t, B_OB);
    const size_t rowbase = (size_t)b * S; const int q0 = qb * 256; const int qrow = q0 + 32 * wid + r;
    bf16x8 qf[6];
    { const bf16_t* qp = Q + (rowbase + qrow) * 1536 + h * 96 + 8 * hh;
#pragma unroll
      for (int ks = 0; ks < 6; ++ks) qf[ks] = *(const bf16x8*)(qp + 16 * ks); }
    const int NT = 4 * (qb + 1);
    const int kc0 = wid * 64 + lane, kc1 = 512 + wid * 64 + lane;
    const int kr0 = kc0 / 13, kq0 = kc0 - kr0 * 13, kr1 = kc1 / 13, kq1 = kc1 - kr1 * 13; const bool has1 = wid < 5;
    const unsigned koff0 = (unsigned)(kr0 * 3072 + (kq0 < 12 ? kq0 : 11) * 16), koff1 = (unsigned)((kr1 < 64 ? kr1 : 63) * 3072 + (kq1 < 12 ? kq1 : 11) * 16);
    const int vc = wid * 64 + lane, vdh = vc >> 8, vrow = (vc >> 2) & 63, vq = vc & 3;
    const unsigned voff = (unsigned)(vrow * 2048 + vdh * 64 + vq * 16);
    const char* Kt0 = (const char*)(KB + rowbase * 1536 + h * 96); const char* Vt0 = (const char*)(VB + rowbase * 1024 + h * 64);
    LAS unsigned char* lds = F.lds; LAS float* wsf = (LAS float*)(lds + AT_WSF) + wid * 64; const unsigned lds0 = (unsigned)(size_t)lds;
#define AT_DMA_K(t, slot) do { const char* kt_ = uni_ptr(Kt0 + (size_t)(t) * (64 * 3072)); const unsigned kl_ = (unsigned)__builtin_amdgcn_readfirstlane((int)(lds0 + (slot) * AT_KBYTES + wid * 1024)); glds16s(kt_, koff0, kl_); \
        if (has1) glds16s(kt_, koff1, kl_ + 8192u); } while (0)
#define AT_DMA_V(t, slot) do { const char* vt_ = uni_ptr(Vt0 + (size_t)(t) * (64 * 2048)); glds16s(vt_, voff, (unsigned)__builtin_amdgcn_readfirstlane((int)(lds0 + AT_VOFF + (slot) * AT_VBYTES + wid * 1024))); } while (0)
    AT_DMA_K(0, 0); AT_DMA_V(0, 0); AT_DMA_K(1, 1); AT_DMA_V(1, 1); AT_DMA_K(2, 2);
    asm volatile("s_waitcnt vmcnt(0)" ::: "memory"); __builtin_amdgcn_s_barrier(); asm volatile("" ::: "memory");
    asm volatile("" : "+v"(qf[0]), "+v"(qf[1]), "+v"(qf[2]), "+v"(qf[3]), "+v"(qf[4]), "+v"(qf[5]));
    f32x16 o0, o1;
#pragma unroll
    for (int i = 0; i < 16; ++i) { o0[i] = 0.f; o1[i] = 0.f; }
    float mrun = 0.f, lsum = 0.f;
    f32x16 zz = {0.f, 0.f, 0.f, 0.f, 0.f, 0.f, 0.f, 0.f, 0.f, 0.f, 0.f, 0.f, 0.f, 0.f, 0.f, 0.f};
    const bf16x8 ones = {0x3F80, 0x3F80, 0x3F80, 0x3F80, 0x3F80, 0x3F80, 0x3F80, 0x3F80};
    const int kfrag = AT_KOFF + r * AT_KROW + hh * 16;
    const int vfrag = AT_VOFF + ((lane >> 4) & 1) * 32 + (lane & 3) * 8 + (4 * hh + ((lane & 15) >> 2)) * 64;
    const int wmax = q0 + 32 * wid + 31;
#define AT_QK(P0, P1, slot) do { const LAS unsigned char* kb_ = lds + (slot) * AT_KBYTES + kfrag; \
        { const bf16x8 a0 = *(const LAS bf16x8*)(kb_), a1 = *(const LAS bf16x8*)(kb_ + 32 * AT_KROW); \
          P0 = __builtin_amdgcn_mfma_f32_32x32x16_bf16(a0, qf[0], zz, 0, 0, 0); P1 = __builtin_amdgcn_mfma_f32_32x32x16_bf16(a1, qf[0], zz, 0, 0, 0); } \
        _Pragma("unroll") for (int ks = 1; ks < 6; ++ks) { const bf16x8 a0 = *(const LAS bf16x8*)(kb_ + ks * 32), a1 = *(const LAS bf16x8*)(kb_ + 32 * AT_KROW + ks * 32); \
            P0 = __builtin_amdgcn_mfma_f32_32x32x16_bf16(a0, qf[ks], P0, 0, 0, 0); P1 = __builtin_amdgcn_mfma_f32_32x32x16_bf16(a1, qf[ks], P1, 0, 0, 0); } } while (0)
#define AT_PV1(o, d0, ks, pa) do { const s16x4 lo = vtr(vb + d0 * 4096 + ks * 1024), hi = vtr(vb + d0 * 4096 + ks * 1024 + 512); \
        o = __builtin_amdgcn_mfma_f32_32x32x16_bf16(pa, (bf16x8){lo[0], lo[1], lo[2], lo[3], hi[0], hi[1], hi[2], hi[3]}, o, 0, 0, 0); } while (0)
#define AT_SOFT(P0, P1, t) do { \
        if ((t) >= NT - 4) { const int kb0 = (t) * 64; _Pragma("unroll") for (int i = 0; i < 16; ++i) { const int kv = kb0 + crow(i, hh); if (kv > qrow) P0[i] = -INFINITY; if (kv + 32 > qrow) P1[i] = -INFINITY; } } \
        float mx = fmaxf(fmaxf(P0[0], P1[0]), fmaxf(P0[1], P1[1])); _Pragma("unroll") for (int i = 2; i < 16; i += 2) mx = fmaxf(mx, fmaxf(fmaxf(P0[i], P1[i]), fmaxf(P0[i + 1], P1[i + 1]))); \
        mx = fmaxf(mx, __shfl_xor(mx, 32));                                    \
        if ((t) == 0 || __any(mx > ATT_THR)) { const float dl = (t) == 0 ? mx : fmaxf(mx, 0.f); mrun += dl; { const float nm_ = -mrun; _Pragma("unroll") for (int i = 0; i < 16; ++i) zz[i] = nm_; } \
            _Pragma("unroll") for (int i = 0; i < 16; ++i) { P0[i] -= dl; P1[i] -= dl; } \
            if ((t) != 0) { const float alpha = fast_exp2(-dl); lsum *= alpha; if (hh == 0) wsf[r] = alpha; \
                _Pragma("unroll") for (int i = 0; i < 16; ++i) { const float al = wsf[crow(i, hh)]; o0[i] *= al; o1[i] *= al; } } } \
        { float sa = 0.f, sb = 0.f; _Pragma("unroll") for (int i = 0; i < 16; ++i) { P0[i] = fast_exp2(P0[i]); P1[i] = fast_exp2(P1[i]); sa += P0[i]; sb += P1[i]; } lsum += sa + sb; } \
        pk0 = pack8(P0, 0); pk1 = pack8(P0, 8); pk2_ = pack8(P1, 0); pk3 = pack8(P1, 8); } while (0)
#define AT_PV(sv) do { const LAS unsigned char* vb = lds + (sv) * AT_VBYTES + vfrag; \
        AT_PV1(o0, 0, 0, pk0); AT_PV1(o1, 1, 0, pk0); \
        AT_PV1(o0, 0, 1, pk1); AT_PV1(o1, 1, 1, pk1); \
        AT_PV1(o0, 0, 2, pk2_); AT_PV1(o1, 1, 2, pk2_); \
        AT_PV1(o0, 0, 3, pk3); AT_PV1(o1, 1, 3, pk3); } while (0)
#define AT_VF(i) (bf16x8){vl_[i][0], vl_[i][1], vl_[i][2], vl_[i][3], vh_[i][0], vh_[i][1], vh_[i][2], vh_[i][3]}
#define AT_KRD(ks) do { ka_[2 * (ks)] = *(const LAS bf16x8*)(kb_ + (ks) * 32); ka_[2 * (ks) + 1] = *(const LAS bf16x8*)(kb_ + 32 * AT_KROW + (ks) * 32); } while (0)
#define AT_VRD(i) do { vl_[2 * (i)] = vtr(vb + (i) * 1024); vh_[2 * (i)] = vtr(vb + (i) * 1024 + 512); vl_[2 * (i) + 1] = vtr(vb + 4096 + (i) * 1024); vh_[2 * (i) + 1] = vtr(vb + 4096 + (i) * 1024 + 512); } while (0)
#define AT_PVP(i, pk) do { o0 = __builtin_amdgcn_mfma_f32_32x32x16_bf16(pk, AT_VF(2 * (i)), o0, 0, 0, 0); o1 = __builtin_amdgcn_mfma_f32_32x32x16_bf16(pk, AT_VF(2 * (i) + 1), o1, 0, 0, 0); } while (0)
#define AT_QKP(A0, A1, ks) do { A0 = __builtin_amdgcn_mfma_f32_32x32x16_bf16(ka_[2 * (ks)], qf[ks], A0, 0, 0, 0); A1 = __builtin_amdgcn_mfma_f32_32x32x16_bf16(ka_[2 * (ks) + 1], qf[ks], A1, 0, 0, 0); } while (0)
#define AT_SB __builtin_amdgcn_sched_barrier(0)
#define AT_PVQK(P0, P1, sv, sk) do { const LAS unsigned char* vb = lds + (sv) * AT_VBYTES + vfrag; const LAS unsigned char* kb_ = lds + (sk) * AT_KBYTES + kfrag; \
        s16x4 vl_[8], vh_[8]; bf16x8 ka_[12]; \
        AT_VRD(0); AT_VRD(1); AT_VRD(2); AT_SB;                        \
        AT_PVP(0, pk0); AT_VRD(3); AT_SB; \
        AT_PVP(1, pk1); AT_KRD(0); AT_SB; \
        AT_PVP(2, pk2_); AT_KRD(1); AT_SB; \
        AT_PVP(3, pk3); AT_KRD(2); AT_SB; \
        P0 = __builtin_amdgcn_mfma_f32_32x32x16_bf16(ka_[0], qf[0], zz, 0, 0, 0); P1 = __builtin_amdgcn_mfma_f32_32x32x16_bf16(ka_[1], qf[0], zz, 0, 0, 0); AT_KRD(3); AT_SB; \
        AT_QKP(P0, P1, 1); AT_KRD(4); AT_SB; \
        AT_QKP(P0, P1, 2); AT_KRD(5); AT_SB; \
        AT_QKP(P0, P1, 3); AT_QKP(P0, P1, 4); AT_QKP(P0, P1, 5); } while (0)
#define AT_PVR(sv) do { const LAS unsigned char* vb = lds + (sv) * AT_VBYTES + vfrag; s16x4 vl_[8], vh_[8]; \
        AT_VRD(0); AT_VRD(1); AT_VRD(2); AT_SB; AT_PVP(0, pk0); AT_VRD(3); AT_SB; AT_PVP(1, pk1); AT_PVP(2, pk2_); AT_PVP(3, pk3); } while (0)
#define AT_QKR(P0, P1, sk) do { const LAS unsigned char* kb_ = lds + (sk) * AT_KBYTES + kfrag; bf16x8 ka_[12]; \
        AT_KRD(0); AT_KRD(1); AT_KRD(2); AT_SB; \
        P0 = __builtin_amdgcn_mfma_f32_32x32x16_bf16(ka_[0], qf[0], zz, 0, 0, 0); P1 = __builtin_amdgcn_mfma_f32_32x32x16_bf16(ka_[1], qf[0], zz, 0, 0, 0); AT_KRD(3); AT_SB; \
        AT_QKP(P0, P1, 1); AT_KRD(4); AT_SB; AT_QKP(P0, P1, 2); AT_KRD(5); AT_SB; AT_QKP(P0, P1, 3); AT_QKP(P0, P1, 4); AT_QKP(P0, P1, 5); } while (0)
#define AT_H0(SQ0, SQ1, t) do { \
        const bool dK = (t) + 4 >= 3 && (t) + 4 < NT, dV = (t) + 2 >= 2 && (t) + 2 < NT; \
        if (dK) AT_DMA_K((t) + 4, s_b); \
        if (dV) AT_DMA_V((t) + 2, s_c); \
        { const bool doPV = (t) >= 0 && (t) * 64 <= wmax, doQK = (t) + 2 < NT && ((t) + 2) * 64 <= wmax; \
          if (doPV && doQK) AT_PVQK(SQ0, SQ1, s_a, s_c); else { if (doPV) AT_PV(s_a); if (doQK) AT_QK(SQ0, SQ1, s_c); } } \
        } while (0)
#define AT_H1(SS0, SS1, t) do { \
        if ((t) + 1 >= 0 && (t) + 1 < NT && ((t) + 1) * 64 <= wmax) AT_SOFT(SS0, SS1, (t) + 1); \
        { const bool dK = (t) + 4 >= 3 && (t) + 4 < NT, dV = (t) + 2 >= 2 && (t) + 2 < NT;        \
          if (dK && dV) { if (has1) asm volatile("s_waitcnt vmcnt(3) lgkmcnt(0)" ::: "memory"); else asm volatile("s_waitcnt vmcnt(2) lgkmcnt(0)" ::: "memory"); } \
          else asm volatile("s_waitcnt vmcnt(0) lgkmcnt(0)" ::: "memory"); } \
        __builtin_amdgcn_s_barrier(); asm volatile("" ::: "memory"); \
        { const int tmp_ = s_a; s_a = s_b; s_b = s_c; s_c = tmp_; } } while (0)
    f32x16 pA0, pA1, pB0, pB1; bf16x8 pk0, pk1, pk2_, pk3;
    pk0 = ones; pk1 = ones; pk2_ = ones; pk3 = ones;
    int s_a = 1, s_b = 2, s_c = 0;
#define AT_PIN(x) asm volatile("" : "+v"(x))
#define AT_EXP8(X, b) do { _Pragma("unroll") for (int i_ = (b); i_ < (b) + 8; ++i_) X[i_] = fast_exp2(X[i_]); AT_PIN(X); } while (0)
#define AT_SUM8(X, b) do { sacc_ += ((X[(b)] + X[(b) + 1]) + (X[(b) + 2] + X[(b) + 3])) + ((X[(b) + 4] + X[(b) + 5]) + (X[(b) + 6] + X[(b) + 7])); AT_PIN(sacc_); } while (0)
#define AT_STEPS(SQ0, SQ1, SS0, SS1, t) do { \
        AT_DMA_K((t) + 4, s_b); AT_DMA_V((t) + 2, s_c); \
        { const LAS unsigned char* vb = lds + s_a * AT_VBYTES + vfrag; const LAS unsigned char* kb_ = lds + s_c * AT_KBYTES + kfrag; \
        s16x4 vl_[8], vh_[8]; bf16x8 ka_[12]; bool mv_ = false; float sacc_ = 0.f; \
        AT_VRD(0); AT_VRD(1); AT_VRD(2); AT_SB; \
        { float mx = fmaxf(fmaxf(SS0[0], SS1[0]), fmaxf(SS0[1], SS1[1])); _Pragma("unroll") for (int i = 2; i < 16; i += 2) mx = fmaxf(mx, fmaxf(fmaxf(SS0[i], SS1[i]), fmaxf(SS0[i + 1], SS1[i + 1]))); \
          mx = fmaxf(mx, __shfl_xor(mx, 32));                                    \
          if (__any(mx > ATT_THR)) { const float dl = fmaxf(mx, 0.f); mrun += dl; const float alpha = fast_exp2(-dl); lsum *= alpha; if (hh == 0) wsf[r] = alpha; mv_ = true; \
              { const float nm_ = -mrun; _Pragma("unroll") for (int i = 0; i < 16; ++i) zz[i] = nm_; } _Pragma("unroll") for (int i = 0; i < 16; ++i) { SS0[i] -= dl; SS1[i] -= dl; } } } \
        AT_SB; \
        AT_PVP(0, pk0); AT_VRD(3); AT_EXP8(SS0, 0); AT_SB; \
        AT_PVP(1, pk1); AT_KRD(0); AT_EXP8(SS0, 8); AT_SB; \
        AT_PVP(2, pk2_); AT_KRD(1); AT_EXP8(SS1, 0); AT_SB; \
        AT_PVP(3, pk3); AT_KRD(2); AT_EXP8(SS1, 8); AT_SB; \
        if (mv_) { _Pragma("unroll") for (int i = 0; i < 16; ++i) { const float al = wsf[crow(i, hh)]; o0[i] *= al; o1[i] *= al; } } \
        SQ0 = __builtin_amdgcn_mfma_f32_32x32x16_bf16(ka_[0], qf[0], zz, 0, 0, 0); SQ1 = __builtin_amdgcn_mfma_f32_32x32x16_bf16(ka_[1], qf[0], zz, 0, 0, 0); AT_KRD(3); AT_SUM8(SS0, 0); pk0 = pack8(SS0, 0); AT_PIN(pk0); AT_SB; \
        AT_QKP(SQ0, SQ1, 1); AT_KRD(4); AT_SUM8(SS0, 8); pk1 = pack8(SS0, 8); AT_PIN(pk1); AT_SB; \
        AT_QKP(SQ0, SQ1, 2); AT_KRD(5); AT_SUM8(SS1, 0); pk2_ = pack8(SS1, 0); AT_PIN(pk2_); AT_SB; \
        AT_QKP(SQ0, SQ1, 3); AT_SUM8(SS1, 8); pk3 = pack8(SS1, 8); AT_PIN(pk3); AT_SB; \
        AT_QKP(SQ0, SQ1, 4); AT_QKP(SQ0, SQ1, 5); lsum += sacc_; } \
        if (has1) asm volatile("s_waitcnt vmcnt(3) lgkmcnt(0)" ::: "memory"); else asm volatile("s_waitcnt vmcnt(2) lgkmcnt(0)" ::: "memory"); \
        __builtin_amdgcn_s_barrier(); asm volatile("" ::: "memory"); \
        { const int tmp_ = s_a; s_a = s_b; s_b = s_c; s_c = tmp_; } } while (0)
#define AT_STEP(SQ0, SQ1, SS0, SS1, t) do { \
        const bool dK = (t) + 4 >= 3 && (t) + 4 < NT, dV = (t) + 2 >= 2 && (t) + 2 < NT; \
        if (dK) AT_DMA_K((t) + 4, s_b); \
        if (dV) AT_DMA_V((t) + 2, s_c); \
        { const bool doPV = (t) >= 0 && (t) * 64 <= wmax, doQK = (t) + 2 < NT && ((t) + 2) * 64 <= wmax, doSM = (t) + 1 >= 0 && (t) + 1 < NT && ((t) + 1) * 64 <= wmax; \
          if (doPV) AT_PVR(s_a); if (doSM) AT_SOFT(SS0, SS1, (t) + 1); if (doQK) AT_QKR(SQ0, SQ1, s_c); } \
        if (dK && dV) { if (has1) asm volatile("s_waitcnt vmcnt(3) lgkmcnt(0)" ::: "memory"); else asm volatile("s_waitcnt vmcnt(2) lgkmcnt(0)" ::: "memory"); } \
        else asm volatile("s_waitcnt vmcnt(0) lgkmcnt(0)" ::: "memory"); \
        __builtin_amdgcn_s_barrier(); asm volatile("" ::: "memory"); \
        { const int tmp_ = s_a; s_a = s_b; s_b = s_c; s_c = tmp_; } } while (0)
    { int t = -2;
      for (int seg = 0; seg < 2; ++seg) { const int tend = seg == 0 ? 0 : NT;
          for (; t < tend; t += 2) { AT_STEP(pA0, pA1, pB0, pB1, t); AT_STEP(pB0, pB1, pA0, pA1, t + 1); }
          if (seg == 0) for (; t < NT - 6; t += 2) { AT_STEPS(pA0, pA1, pB0, pB1, t); AT_STEPS(pB0, pB1, pA0, pA1, t + 1); } } }
#undef AT_STEP
#undef AT_STEPS
#undef AT_PIN
#undef AT_EXP8
#undef AT_SUM8
#undef AT_PVR
#undef AT_QKR
#undef AT_H0
#undef AT_H1
#undef AT_SOFT
#undef AT_PVQK
#undef AT_VRD
#undef AT_PVP
#undef AT_QKP
#undef AT_SB
#undef AT_VF
#undef AT_KRD
#undef AT_PV
#undef AT_DMA_K
#undef AT_DMA_V
#undef AT_QK
#undef AT_PV1
    lsum += __shfl_xor(lsum, 32); if (hh == 0) wsf[32 + r] = lsum; asm volatile("s_waitcnt lgkmcnt(0)" ::: "memory");
    bf16_t* op = OB + (rowbase + q0 + 32 * wid) * 1024 + h * 64 + r;
#pragma unroll
    for (int i = 0; i < 16; ++i) { const int qr = crow(i, hh); const float rl = fast_rcp(wsf[32 + qr]);
        op[(size_t)qr * 1024] = (bf16_t)(pk2(o0[i] * rl, 0.f) & 0xffffu); op[(size_t)qr * 1024 + 32] = (bf16_t)(pk2(o1[i] * rl, 0.f) & 0xffffu); }
    __syncthreads();
}
__device__ __forceinline__ void phase_attn(const Frame& F, const int att_var) {
    for (int pi = F.vcu; pi < 512; pi += F.G) { const int bh = pi >> 3, j = pi & 7; attn_unit(F, bh, j, att_var); attn_unit(F, bh, 15 - j, att_var); }
}

__device__ __forceinline__ void gmlp_unit(const Frame& F, int chunk, int g) {
    const int lane = F.lane, wid = F.wave, tid = F.tid, r = lane & 31, hh = lane >> 5;
    const bf16_t* vsrc = WSP(bf16_t, B_VB2); const bf16_t* usrc = WSP(bf16_t, B_UB); bf16_t* uv = WSP(bf16_t, B_UVB); const bf16_t* wsb = WSP(bf16_t, W_GM_S) + (size_t)g * 16384;
    const float* lng = INF(23); const float* lnb = INF(24); const float* bs = INF(26) + g * 128;
    LAS unsigned char* lds = F.lds; LAS f32x2* stat = (LAS f32x2*)(lds + 65536);
    const size_t row0 = (size_t)chunk * 128;
    if (tid < 128) { const f32x4* ps = (const f32x4*)(WSP(float, WS_SLOT24) + (row0 + tid) * 16); const f32x4* pq = (const f32x4*)(WSP(float, WS_SLOT24) + (size_t)M * 16 + (row0 + tid) * 16);
        const f32x4 a0 = ps[0], a1 = ps[1], a2 = ps[2], a3 = ps[3], q0 = pq[0], q1 = pq[1], q2 = pq[2], q3 = pq[3];
        const float mu = ((hsum4(a0) + hsum4(a1)) + (hsum4(a2) + hsum4(a3))) * (1.0f / 1024.0f); const float var = fmaxf(((hsum4(q0) + hsum4(q1)) + (hsum4(q2) + hsum4(q3))) * (1.0f / 1024.0f) - mu * mu, 0.f);
        stat[tid] = (f32x2){mu, __builtin_amdgcn_rsqf(var + LN_EPS)}; }
    __syncthreads();
#pragma unroll
    for (int k = 0; k < 8; ++k) { const int idx = tid + k * NTHR, s = idx >> 5, ch = idx & 31, c = g * 256 + ch * 8;
        const u32x4 w = *(const u32x4*)(vsrc + (row0 + s) * D + c); const f32x2 st = stat[s];
        const f32x4 g0 = *(const f32x4*)(lng + c), g1 = *(const f32x4*)(lng + c + 4), b0 = *(const f32x4*)(lnb + c), b1 = *(const f32x4*)(lnb + c + 4);
        f32x4 v0 = {bflo(w.x), bfhi(w.x), bflo(w.y), bfhi(w.y)}, v1 = {bflo(w.z), bfhi(w.z), bflo(w.w), bfhi(w.w)};
        v0 = (v0 - st.x) * st.y * g0 + b0; v1 = (v1 - st.x) * st.y * g1 + b1;
        u32x4 o; o.x = pk2(v0[0], v0[1]); o.y = pk2(v0[2], v0[3]); o.z = pk2(v1[0], v1[1]); o.w = pk2(v1[2], v1[3]);
        *(LAS u32x4*)(lds + (ch >> 2) * 8192 + s * 64 + (ch & 3) * 16) = o; }
    __syncthreads();
    bf16x8 bfr[8];
    { const LAS unsigned char* vb = lds + wid * 8192 + ((lane >> 4) & 1) * 32 + (lane & 3) * 8 + (8 * hh + ((lane & 15) >> 2)) * 64;
#pragma unroll
      for (int ks = 0; ks < 8; ++ks) { const s16x4 lo = vtr(vb + ks * 1024), hi = vtr(vb + ks * 1024 + 256); bfr[ks] = (bf16x8){lo[0], lo[1], lo[2], lo[3], hi[0], hi[1], hi[2], hi[3]}; } }
    __syncthreads();
    LAS bf16_t* ost = (LAS bf16_t*)(lds + wid * 8192);
#pragma unroll
    for (int mt = 0; mt < 4; ++mt) { f32x16 acc;
#pragma unroll
        for (int i = 0; i < 16; ++i) acc[i] = 0.f;
        const bf16_t* wp = wsb + (size_t)(32 * mt + r) * 128 + 8 * hh;
#pragma unroll
        for (int ks = 0; ks < 8; ++ks) if (ks <= 2 * mt + 1) { const bf16x8 a = *(const bf16x8*)(wp + 16 * ks); acc = __builtin_amdgcn_mfma_f32_32x32x16_bf16(a, bfr[ks], acc, 0, 0, 0); }
#pragma unroll
        for (int i = 0; i < 16; ++i) { const int t = 32 * mt + crow(i, hh); ost[t * 32 + r] = (bf16_t)(pk2(acc[i] + bs[t], 0.f) & 0xffffu); } }
    asm volatile("s_waitcnt lgkmcnt(0)" ::: "memory");
#pragma unroll
    for (int k = 0; k < 8; ++k) { const int t = 16 * k + (lane >> 2), ch = lane & 3; const size_t off = (row0 + t) * D + g * 256 + wid * 32 + ch * 8;
        const u32x4 v2 = *(const LAS u32x4*)(ost + t * 32 + ch * 8); const u32x4 uu = *(const u32x4*)(usrc + off); u32x4 o;
        o.x = pk2(bflo(uu.x) * bflo(v2.x), bfhi(uu.x) * bfhi(v2.x)); o.y = pk2(bflo(uu.y) * bflo(v2.y), bfhi(uu.y) * bfhi(v2.y));
        o.z = pk2(bflo(uu.z) * bflo(v2.z), bfhi(uu.z) * bfhi(v2.z)); o.w = pk2(bflo(uu.w) * bflo(v2.w), bfhi(uu.w) * bfhi(v2.w));
        *(u32x4*)(uv + off) = o; }
    __syncthreads();
}
__device__ __forceinline__ void phase_gmlp(const Frame& F) { for (int u = F.vcu; u < 512; u += F.G) gmlp_unit(F, u >> 2, u & 3); }
constexpr int PH_PRO = 0, PH_LAT = 1, PH_QKV = 2, PH_ATTN = 3, PH_WO = 4, PH_FUP0 = 5, PH_FDN0 = 6, PH_LIN = 7, PH_CONV = 8, PH_LGATE = 9, PH_SCAN1 = 10, PH_SCAN2 = 11, PH_LOUT = 12,
              PH_ROUT0 = 13, PH_GATH0 = 14, PH_MUP0 = 15, PH_MDN0 = 16, PH_COMB0 = 17, PH_POOL = 18, PH_PGEMM = 19, PH_FUP1 = 20, PH_FDN1 = 21, PH_GIN = 22, PH_GGATE = 23, PH_GOUT = 24,
              PH_ROUT1 = 25, PH_GATH1 = 26, PH_MUP1 = 27, PH_MDN1 = 28, PH_FINAL = 29, PH_N = 30;

__device__ __forceinline__ DenseSched dense_sched(const Frame& F, const void* A, int lda, const void* B, int ldb, int nM, int nN) {
    DenseSched s; s.nM = nM; s.nN = nN; s.G = F.G; s.c = (int)blockIdx.x; s.A = (const char*)A; s.B = (const char*)B; s.astep = (size_t)256 * lda * 2; s.bstep = btile_bytes(ldb); return s;
}
template <int L> __device__ __forceinline__ void phase_ffn_up(const Frame& F, bf16_t* actout, int var) {
    if constexpr (ffn_f8(L)) {
        const DenseSched s = dense_sched(F, F.ws + WS_X8, D / 2, F.ws + W_FFN + (size_t)L * WSTRIDE, D / 2, M / 256, 2 * FF / 256);
        EpiSwiglu<false, true> e{actout, WSP(float, WS_SSQ), var, 1.f / F8_SW};
        gemm_phase<EpiSwiglu<false, true>, DenseSched, false, true, false, true>(F.lds, D / 2, D / 2, D / 2, s, e);
        return;
    }
    const DenseSched s = dense_sched(F, WSP(bf16_t, WS_HB), D, F.ws + W_FFN + (size_t)L * WSTRIDE, D, M / 256, 2 * FF / 256);
    EpiSwiglu<false> e{actout, WSP(float, WS_SSQ), var, 1.f};
#if defined(REP_PHASE) && REP_VAR == 3
    if (var == 3) { gemm_phase<EpiSwiglu<false>, DenseSched, false, false>(F.lds, D, D, D, s, e); return; }
#endif
    gemm_phase(F.lds, D, D, D, s, e);
}
template <int L> __device__ __forceinline__ void phase_ffn_down(const Frame& F) {
    constexpr bool F8 = ffn_f8(L); constexpr int KD = F8 ? FF / 2 : FF;
    const DenseSched s = dense_sched(F, WSP(bf16_t, B_ACT), KD, F.ws + W_FFN + (size_t)L * WSTRIDE + WDOWN_OFF, KD, M / 256, D / 256);
    EpiRes e{nullptr, WSP(bf16_t, WS_HB), WSP(bf16_t, WS_LO), WSP(float, WS_SSQ), nullptr, nullptr, F8 ? 1.f / (F8_SA * F8_SW) : 1.f};
    gemm_phase<EpiRes, DenseSched, false, true, false, F8>(F.lds, 128, KD, KD, s, e, SKCtx{nullptr, nullptr, nullptr}, 65536);
}
__device__ __forceinline__ MoeSched moe_sched(const Frame& F, int l, const void* A, int lda, size_t wofs, int ldb, int nN) {
    MoeSched s; int ps[NE]; s.nM = moe_layout(F, l, ps, s.pend); s.nN = nN; s.G = F.G; s.c = (int)blockIdx.x; s.A = (const char*)A; s.B = (const char*)(F.ws + W_MOE + (size_t)l * 8 * WSTRIDE + wofs);
    s.astep = (size_t)256 * lda * 2; s.bstep = btile_bytes(ldb); s.estep = WSTRIDE; return s;
}
template <int L> __device__ __forceinline__ void phase_moe_up(const Frame& F, const int var) {
    if constexpr (moe_f8(L)) {
        EpiSwiglu<true, true> e{WSP(bf16_t, B_ACTM), WSP(float, WS_ROWSCALE), var, 1.f};
        const MoeSched s = moe_sched(F, L, WSP(bf16_t, B_XG), D / 2, 0, D / 2, 2 * FF / 256);
        gemm_phase<EpiSwiglu<true, true>, MoeSched, false, true, false, true>(F.lds, D / 2, D / 2, D / 2, s, e);
        return;
    }
    EpiSwiglu<true> e{WSP(bf16_t, B_ACTM), WSP(float, WS_ROWSCALE), var, 1.f};
#if MUP_GATHER
    MoeSched s = moe_sched(F, L, WSP(bf16_t, WS_HB), D, 0, D, 2 * FF / 256); s.astep = 0;
    gemm_phase<EpiSwiglu<true>, MoeSched, false, true, true>(F.lds, D, D, D, s, e, SKCtx{nullptr, nullptr, nullptr}, 256, WSP(int, WS_ROWTOK));
#else
    const MoeSched s = moe_sched(F, L, WSP(bf16_t, B_XG), D, 0, D, 2 * FF / 256);
    gemm_phase(F.lds, D, D, D, s, e);
#endif
}
template <int L> __device__ __forceinline__ void phase_moe_down(const Frame& F) {
    EpiMoeDown e{WSP(bf16_t, B_OUTM), WSP(float, WS_ROWGATE), (bf16_t*)(F.ws + WS_SK)};
#if MDN_STREAMK
    if (F.G == 256) {
        constexpr bool F8 = moe_f8(L); constexpr int KD = F8 ? FF / 2 : FF;
        SKSched s; int ps[NE]; s.NP = moe_layout(F, L, ps, s.pend); s.P = KD / 128; const int T = ((s.NP + 7) >> 3) * s.P;
        s.x = F.vcu >> 5; s.r = (F.vcu >> 2) & 7; s.j = F.vcu & 3; s.s0 = (s.x * T) >> 3; s.s1 = ((s.x + 1) * T) >> 3;
#ifdef SK_NOSPLIT
        s.s0 = (s.s0 / s.P) * s.P; s.s1 = (s.x == 7) ? T : (s.s1 / s.P) * s.P;
#endif
        s.A = (const char*)WSP(bf16_t, B_ACTM); s.B = (const char*)(F.ws + W_MOE + (size_t)L * 8 * WSTRIDE + WDOWN_OFF); s.astep = (size_t)256 * KD * 2; s.bstep = btile_bytes(KD); s.estep = WSTRIDE;
        const SKCtx sk{F.ws + WS_SK, WSP(unsigned, WS_CTL) + CW_SK + L * 4096, WSP(unsigned, WS_CTL) + CW_TMO};
        gemm_phase<EpiMoeDown, SKSched, true, true, false, F8>(F.lds, 128, KD, KD, s, e, sk, 65536);
        return;
    }
#endif
    { constexpr bool F8 = moe_f8(L); constexpr int KD = F8 ? FF / 2 : FF;
    const MoeSched s = moe_sched(F, L, WSP(bf16_t, B_ACTM), KD, WDOWN_OFF, KD, D / 256);
    gemm_phase<EpiMoeDown, MoeSched, false, true, false, F8>(F.lds, 128, KD, KD, s, e, SKCtx{nullptr, nullptr, nullptr}, 65536); }
}

__global__ void __launch_bounds__(NTHR, 2) fused_fwd(Args args) {
    extern __shared__ __attribute__((aligned(16))) unsigned char lds_raw[];
    Frame F;
    F.lds = (LAS unsigned char*)lds_raw; F.ws = args.ws; F.in = args.in; F.h = args.out;
    F.tid = threadIdx.x; F.lane = F.tid & 63; F.wave = __builtin_amdgcn_readfirstlane(F.tid >> 6);
    F.G = gridDim.x; { const int bx = blockIdx.x; F.vcu = (F.G % 8 == 0) ? (bx % 8) * (F.G / 8) + bx / 8 : bx; }
    F.gw = F.vcu * NWAVES + F.wave; F.NGW = F.G * NWAVES;
    volatile LAS unsigned* MISC = (volatile LAS unsigned*)(F.lds + MISC_OFF);
    if (F.tid < 64) MISC[F.tid] = 0u;
    __syncthreads();
    XcdBarrier bar = xcd_barrier_post(WSP(unsigned, WS_CTL) + CW_BAR, MISC + 8);
    const int lo = args.ph_lo, hi = args.ph_hi;
#ifdef TS_LO
#define TS_MARK(k, which) do { if (blockIdx.x == 0 && F.tid == 0 && (k) == (which ? TS_HI : TS_LO)) { const unsigned long long t_ = __builtin_amdgcn_s_memrealtime(); \
        if (which) { unsigned long long t0_ = ((unsigned long long*)(F.ws + WS_CTL))[1024]; __hip_atomic_store(WSP(unsigned, WS_CTL) + 2060, (unsigned)(t_ - t0_), __ATOMIC_RELAXED, __HIP_MEMORY_SCOPE_AGENT); } \
        else ((unsigned long long*)(F.ws + WS_CTL))[1024] = t_; } } while (0)
#else
#define TS_MARK(k, which)
#endif
#ifdef ONLY_PHASE
#define IN(k) ((k) == ONLY_PHASE && lo <= (k) && (k) < hi)
#else
#define IN(k) (lo <= (k) && (k) < hi)
#endif
#define SEAM(k) do { if (IN(k) && IN((k) + 1)) xcd_barrier(bar); } while (0)
#ifdef REP_PHASE
#define REP_LOOP(k) for (int _r = 0, _nr = ((k) == REP_PHASE ? args.nrep : 1); _r < _nr; ++_r)
#define REP_SEAM(k) if ((k) == REP_PHASE && _r + 1 < _nr) xcd_barrier(bar);
#define REP_H(k) (((k) == REP_PHASE && _r + 1 < _nr) ? (float*)(F.ws + WS_SK) : F.h)
#define REP_X(k) ((k) == REP_PHASE && _r + 1 < _nr)
#ifndef REP_VAR
#define REP_VAR 0
#endif
#else
#define REP_LOOP(k)
#define REP_SEAM(k)
#define REP_H(k) F.h
#define REP_X(k) false
#define REP_VAR 0
#endif

    TS_MARK(PH_PRO, 0); if (IN(PH_PRO)) { REP_LOOP(PH_PRO) { phase_prologue(F, args.wmask, args.lmask, args.hsrc);  REP_SEAM(PH_PRO) } } SEAM(PH_PRO); TS_MARK(PH_PRO, 1);
#ifdef EXTRA_BARRIERS
#ifdef EXTRA_LIGHT
    for (int q_ = 0; q_ < EXTRA_BARRIERS; ++q_) xcd_barrier_light(bar);
#else
    for (int q_ = 0; q_ < EXTRA_BARRIERS; ++q_) xcd_barrier(bar);
#endif
#endif
    TS_MARK(PH_LAT, 0); if (IN(PH_LAT)) { REP_LOOP(PH_LAT) { const DenseSched s = dense_sched(F, WSP(bf16_t, WS_HB), D, WSP(bf16_t, W_MLA_IN), D, M / 256, 3);
        EpiLat e{WSP(bf16_t, B_LAT), WSP(float, WS_SLOT24), WSP(float, WS_SSQ), WSP(bf16_t, B_KB), WSP(float, WS_ROPE)};
        gemm_phase(F.lds, D, D, D, s, e);  REP_SEAM(PH_LAT) } } SEAM(PH_LAT); TS_MARK(PH_LAT, 1);
    TS_MARK(PH_QKV, 0); if (IN(PH_QKV)) { REP_LOOP(PH_QKV) {
#ifndef SKIP_Q
        { const DenseSched s = dense_sched(F, WSP(bf16_t, B_LAT), 768, WSP(bf16_t, W_UQ), 384, M / 256, 6);
          EpiQ e{WSP(bf16_t, B_Q), WSP(float, WS_SLOT24), WSP(float, WS_ROPE)};
          gemm_phase(F.lds, 768, 384, 384, s, e); }
#endif
#ifndef SKIP_KV
        { const DenseSched s = dense_sched(F, WSP(bf16_t, B_LAT) + 384, 768, WSP(bf16_t, W_UKV), 256, M / 256, 8);
          EpiKV e{WSP(bf16_t, B_KB), WSP(bf16_t, B_VB), WSP(float, WS_SLOT24)};
          gemm_phase(F.lds, 768, 256, 256, s, e); }
#endif
         REP_SEAM(PH_QKV) } } SEAM(PH_QKV); TS_MARK(PH_QKV, 1);
    TS_MARK(PH_ATTN, 0); if (IN(PH_ATTN)) { REP_LOOP(PH_ATTN) { phase_attn(F, REP_X(PH_ATTN) ? REP_VAR : 0);  REP_SEAM(PH_ATTN) } } SEAM(PH_ATTN); TS_MARK(PH_ATTN, 1);
    TS_MARK(PH_WO, 0); if (IN(PH_WO)) { REP_LOOP(PH_WO) { const DenseSched s = dense_sched(F, WSP(bf16_t, B_OB), D, WSP(bf16_t, W_O), D, M / 256, 4);
        EpiRes e{HB_ONLY ? nullptr : INF(0), WSP(bf16_t, WS_HB), WSP(bf16_t, WS_LO), WSP(float, WS_SSQ), nullptr, ffn_f8(0) ? F.ws + WS_X8 : nullptr, 1.f};
        gemm_phase(F.lds, D, D, D, s, e);  REP_SEAM(PH_WO) } } SEAM(PH_WO); TS_MARK(PH_WO, 1);
    TS_MARK(PH_FUP0, 0); if (IN(PH_FUP0)) { REP_LOOP(PH_FUP0) { phase_ffn_up<0>(F, REP_X(PH_FUP0) ? (bf16_t*)(F.ws + WS_BIG + 128 * MiB) : WSP(bf16_t, B_ACT), REP_X(PH_FUP0) ? REP_VAR : 0);  REP_SEAM(PH_FUP0) } } SEAM(PH_FUP0); TS_MARK(PH_FUP0, 1);
    TS_MARK(PH_FDN0, 0); if (IN(PH_FDN0)) { REP_LOOP(PH_FDN0) { phase_ffn_down<0>(F);  REP_SEAM(PH_FDN0) } } SEAM(PH_FDN0); TS_MARK(PH_FDN0, 1);
    TS_MARK(PH_LIN, 0); if (IN(PH_LIN)) { REP_LOOP(PH_LIN) { const DenseSched s = dense_sched(F, WSP(bf16_t, WS_HB), D, WSP(bf16_t, W_LRU_IN), D, M / 256, 8);
        EpiSplit2<true, false> e{WSP(bf16_t, B_GATEB), WSP(bf16_t, B_XBR), WSP(float, WS_SSQ), nullptr};
        gemm_phase(F.lds, D, D, D, s, e);  REP_SEAM(PH_LIN) } } SEAM(PH_LIN); TS_MARK(PH_LIN, 1);
    TS_MARK(PH_CONV, 0); if (IN(PH_CONV)) { REP_LOOP(PH_CONV) { phase_conv(F);  REP_SEAM(PH_CONV) } } SEAM(PH_CONV); TS_MARK(PH_CONV, 1);
    TS_MARK(PH_LGATE, 0); if (IN(PH_LGATE)) { REP_LOOP(PH_LGATE) { GroupSched s; s.nM = M / 256; s.nN = 8; s.G = F.G; s.c = (int)blockIdx.x; s.A = (const char*)WSP(bf16_t, B_XCB); s.B = (const char*)WSP(bf16_t, W_LRU_G);
        s.astep = (size_t)256 * D * 2; s.bstep = btile_bytes(256); s.acol_bytes = 512; s.acol_shift = 1;
        EpiLruGate e{WSP(unsigned, B_AF), WSP(bf16_t, B_XCB), INF(15), INF(17), WSP(float, WS_SP8), WSP(f32x2, WS_CARRY)};
        gemm_phase(F.lds, D, 256, 256, s, e);  REP_SEAM(PH_LGATE) } } SEAM(PH_LGATE); TS_MARK(PH_LGATE, 1);
    TS_MARK(PH_SCAN2, 0); if (IN(PH_SCAN2)) { REP_LOOP(PH_SCAN2) { phase_scan2(F);  REP_SEAM(PH_SCAN2) } } SEAM(PH_SCAN2); TS_MARK(PH_SCAN2, 1);
    TS_MARK(PH_LOUT, 0); if (IN(PH_LOUT)) { REP_LOOP(PH_LOUT) { const DenseSched s = dense_sched(F, WSP(bf16_t, B_YB), D, WSP(bf16_t, W_LRU_OUT), D, M / 256, 4);
        EpiRes e{nullptr, WSP(bf16_t, WS_HB), WSP(bf16_t, WS_LO), WSP(float, WS_SSQ), nullptr, nullptr, 1.f};
        gemm_phase(F.lds, D, D, D, s, e);  REP_SEAM(PH_LOUT) } } SEAM(PH_LOUT); TS_MARK(PH_LOUT, 1);
    TS_MARK(PH_ROUT0, 0); if (IN(PH_ROUT0)) { REP_LOOP(PH_ROUT0) { phase_router(F, 0);  REP_SEAM(PH_ROUT0) } } SEAM(PH_ROUT0); TS_MARK(PH_ROUT0, 1);
    TS_MARK(PH_GATH0, 0); if (IN(PH_GATH0)) { REP_LOOP(PH_GATH0) { phase_gather(F, 0);  REP_SEAM(PH_GATH0) } } SEAM(PH_GATH0); TS_MARK(PH_GATH0, 1);
    TS_MARK(PH_MUP0, 0); if (IN(PH_MUP0)) { REP_LOOP(PH_MUP0) { phase_moe_up<0>(F, REP_X(PH_MUP0) ? REP_VAR : 0);  REP_SEAM(PH_MUP0) } } SEAM(PH_MUP0); TS_MARK(PH_MUP0, 1);
    TS_MARK(PH_MDN0, 0); if (IN(PH_MDN0)) { REP_LOOP(PH_MDN0) { phase_moe_down<0>(F);  REP_SEAM(PH_MDN0) } } SEAM(PH_MDN0); TS_MARK(PH_MDN0, 1);
    TS_MARK(PH_COMB0, 0); if (IN(PH_COMB0)) { REP_LOOP(PH_COMB0) { phase_combine<false>(F, 1.0f, 0);  REP_SEAM(PH_COMB0) } } SEAM(PH_COMB0); TS_MARK(PH_COMB0, 1);
    TS_MARK(PH_POOL, 0); if (IN(PH_POOL)) { REP_LOOP(PH_POOL) { phase_pool(F);  REP_SEAM(PH_POOL) } } SEAM(PH_POOL); TS_MARK(PH_POOL, 1);
    TS_MARK(PH_PGEMM, 0); if (IN(PH_PGEMM)) { REP_LOOP(PH_PGEMM) { GroupSched s; s.nM = M / 256; s.nN = 4; s.G = F.G; s.c = (int)blockIdx.x; s.A = (const char*)WSP(bf16_t, B_POOLED); s.B = (const char*)WSP(bf16_t, W_POOL);
        s.astep = (size_t)256 * D * 2; s.bstep = btile_bytes(256); s.acol_bytes = 512; s.acol_shift = 0;
        EpiRes e{nullptr, WSP(bf16_t, WS_HB), WSP(bf16_t, WS_LO), WSP(float, WS_SSQ), INF(21), ffn_f8(1) ? F.ws + WS_X8 : nullptr, 1.f};
        gemm_phase(F.lds, D, 256, 256, s, e);  REP_SEAM(PH_PGEMM) } } SEAM(PH_PGEMM); TS_MARK(PH_PGEMM, 1);
    TS_MARK(PH_FUP1, 0); if (IN(PH_FUP1)) { REP_LOOP(PH_FUP1) { phase_ffn_up<1>(F, WSP(bf16_t, B_ACT), 0);  REP_SEAM(PH_FUP1) } } SEAM(PH_FUP1); TS_MARK(PH_FUP1, 1);
    TS_MARK(PH_FDN1, 0); if (IN(PH_FDN1)) { REP_LOOP(PH_FDN1) { phase_ffn_down<1>(F);  REP_SEAM(PH_FDN1) } } SEAM(PH_FDN1); TS_MARK(PH_FDN1, 1);
    TS_MARK(PH_GIN, 0); if (IN(PH_GIN)) { REP_LOOP(PH_GIN) { const DenseSched s = dense_sched(F, WSP(bf16_t, WS_HB), D, WSP(bf16_t, W_GM_IN), D, M / 256, 8);
        EpiSplit2<true, true> e{WSP(bf16_t, B_UB), WSP(bf16_t, B_VB2), WSP(float, WS_SSQ), WSP(float, WS_SLOT24)};
        gemm_phase(F.lds, D, D, D, s, e);  REP_SEAM(PH_GIN) } } SEAM(PH_GIN); TS_MARK(PH_GIN, 1);
    TS_MARK(PH_GGATE, 0); if (IN(PH_GGATE)) { REP_LOOP(PH_GGATE) { phase_gmlp(F);  REP_SEAM(PH_GGATE) } } SEAM(PH_GGATE); TS_MARK(PH_GGATE, 1);
    TS_MARK(PH_GOUT, 0); if (IN(PH_GOUT)) { REP_LOOP(PH_GOUT) { const DenseSched s = dense_sched(F, WSP(bf16_t, B_UVB), D, WSP(bf16_t, W_GM_OUT), D, M / 256, 4);
        EpiRes e{nullptr, WSP(bf16_t, WS_HB), WSP(bf16_t, WS_LO), WSP(float, WS_SSQ), nullptr, nullptr, 1.f};
        gemm_phase(F.lds, D, D, D, s, e);  REP_SEAM(PH_GOUT) } } SEAM(PH_GOUT); TS_MARK(PH_GOUT, 1);
    TS_MARK(PH_ROUT1, 0); if (IN(PH_ROUT1)) { REP_LOOP(PH_ROUT1) { phase_router(F, 1);  REP_SEAM(PH_ROUT1) } } SEAM(PH_ROUT1); TS_MARK(PH_ROUT1, 1);
    TS_MARK(PH_GATH1, 0); if (IN(PH_GATH1)) { REP_LOOP(PH_GATH1) { phase_gather(F, 1);  REP_SEAM(PH_GATH1) } } SEAM(PH_GATH1); TS_MARK(PH_GATH1, 1);
    TS_MARK(PH_MUP1, 0); if (IN(PH_MUP1)) { REP_LOOP(PH_MUP1) { phase_moe_up<1>(F, 0);  REP_SEAM(PH_MUP1) } } SEAM(PH_MUP1); TS_MARK(PH_MUP1, 1);
    TS_MARK(PH_MDN1, 0); if (IN(PH_MDN1)) { REP_LOOP(PH_MDN1) { phase_moe_down<1>(F);  REP_SEAM(PH_MDN1) } } SEAM(PH_MDN1); TS_MARK(PH_MDN1, 1);
#ifdef TS_LO
    float ts_scale = 1.0f; { const unsigned dt = __hip_atomic_load(WSP(unsigned, WS_CTL) + 2060, __ATOMIC_RELAXED, __HIP_MEMORY_SCOPE_AGENT); ts_scale = 1.0f + sqrtf((float)dt * 0.01f * 1e-5f); }
    if (IN(PH_FINAL)) { phase_combine<true>(F, ts_scale, 1); }
#else
    if (IN(PH_FINAL)) { phase_combine<true>(F, 1.0f, 1); }
#endif
#undef IN
#undef SEAM
}
}
extern "C" void kernel_launch(void* const* d_in, const int* in_sizes, int n_in, void* d_out, int out_size, void* d_ws, size_t ws_size, hipStream_t stream) {
    (void)in_sizes; (void)out_size;
    static int grid = 0;
    if (grid == 0) {
        int dev = 0, cus = 0;
        if (n_in != 35 || ws_size < fk::WS_SK + (size_t)fk::MOE_MAXROWS * fk::D * 2) { fprintf(stderr, "kernel_launch: unexpected inputs / workspace (%d inputs, %zu bytes)\n", n_in, ws_size); grid = -1; return; }
        if (hipGetDevice(&dev) != hipSuccess || hipDeviceGetAttribute(&cus, hipDeviceAttributeMultiprocessorCount, dev) != hipSuccess) { grid = -1; return; }
        if (hipFuncSetAttribute((const void*)fk::fused_fwd, hipFuncAttributeMaxDynamicSharedMemorySize, fk::LDS_BYTES) != hipSuccess) { grid = -1; return; }
        int per_cu = 0; (void)hipOccupancyMaxActiveBlocksPerMultiprocessor(&per_cu, (const void*)fk::fused_fwd, fk::NTHR, fk::LDS_BYTES); (void)hipGetLastError();
        if (cus != 256) { fprintf(stderr, "kernel_launch: built for a 256-CU device (got %d CUs)\n", cus); grid = -1; return; }
        grid = cus;
    }
    if (grid < 0) return;
    (void)hipMemsetAsync((char*)d_ws + fk::WS_CTL, 0, fk::CTL_ZERO_BYTES, stream);
    fk::Args a{}; for (int i = 0; i < 35; ++i) a.in[i] = d_in[i];
    a.out = (float*)d_out; a.ws = (unsigned char*)d_ws; a.hsrc = (float*)d_in[0]; a.ph_lo = 0; a.ph_hi = fk::PH_N; a.wmask = 0x3FFFFu; a.lmask = 0xFu;
#ifdef REP_PHASE
    a.nrep = REP_N;
#else
    a.nrep = 1;
#endif
    hipLaunchKernelGGL(fk::fused_fwd, dim3(grid), dim3(fk::NTHR), fk::LDS_BYTES, stream, a);
}
```
